# Optimizing an MI355X kernel written in HIP

```python
import math
import jax, jax.numpy as jnp
from jax import lax
import numpy as np

D_MODEL = 2048
BATCH = 4
SEQ = 4096
DEPTH = 2

N_EVEN = (DEPTH + 1) // 2
N_ODD = DEPTH // 2
EPS = 1e-6
NEG_INF = -1e30

ATTN_HEADS = D_MODEL // 256
ATTN_KV_HEADS = ATTN_HEADS // 4
HEAD_DIM = 128
ATTN_WIDTH = ATTN_HEADS * HEAD_DIM
KV_WIDTH = ATTN_KV_HEADS * HEAD_DIM
WINDOW = 128
BLOCK = 128
REL_BUCKETS = 32
REL_MAX_DIST = 128

SSM_WIDTH = D_MODEL - ATTN_WIDTH
SSM_GROUP = 16
SSM_GROUPS = SSM_WIDTH // SSM_GROUP
SSM_STATE = 64

EVEN_IN = ATTN_WIDTH + 2 * KV_WIDTH + SSM_WIDTH

GMLP_WIDTH = D_MODEL
GMLP_CHUNK = 128
GMLP_HEADS = 16
GMLP_HEAD_DIM = GMLP_WIDTH // GMLP_HEADS

N_EXPERTS = 16
EXPERT_FF = D_MODEL
CAPACITY_FACTOR = 2

kernel_name = 'hybrid_swa_s5_gmlp_ecmoe_encoder'


def rms_norm(x, g):
    xf = x.astype(jnp.float32)
    y = xf * lax.rsqrt(jnp.mean(xf * xf, axis=-1, keepdims=True) + EPS)
    return (y * g.astype(jnp.float32)).astype(x.dtype)


def t5_bucket(rel):
    nb = REL_BUCKETS // 2
    max_exact = nb // 2
    base = jnp.where(rel > 0, nb, 0)
    n = jnp.abs(rel)
    nf = jnp.maximum(n, 1).astype(jnp.float32)
    large = max_exact + (jnp.log(nf / max_exact) / math.log(REL_MAX_DIST / max_exact)
                         * (nb - max_exact)).astype(jnp.int32)
    large = jnp.minimum(large, nb - 1)
    return base + jnp.where(n < max_exact, n, large)


def windowed_attention(q, k, v, sink, rel_bias):
    b, s = q.shape[0], q.shape[1]
    nblk = s // BLOCK
    grp = ATTN_HEADS // ATTN_KV_HEADS
    qb = q.reshape(b, nblk, BLOCK, ATTN_KV_HEADS, grp, HEAD_DIM)

    def band(t):
        tp = jnp.pad(t, ((0, 0), (BLOCK, BLOCK), (0, 0), (0, 0)))
        tp = tp.reshape(b, nblk + 2, BLOCK, ATTN_KV_HEADS, HEAD_DIM)
        return jnp.concatenate([tp[:, :-2], tp[:, 1:-1], tp[:, 2:]], axis=2)

    kb, vb = band(k), band(v)
    scores = jnp.einsum('bnqkgd,bnckd->bnkgqc', qb, kb).astype(jnp.float32) * (HEAD_DIM ** -0.5)

    q_off = jnp.arange(BLOCK, dtype=jnp.int32)
    c_off = jnp.arange(3 * BLOCK, dtype=jnp.int32)
    rel = c_off[None, :] - BLOCK - q_off[:, None]
    bias = rel_bias.astype(jnp.float32)[t5_bucket(rel)]
    bias = jnp.transpose(bias, (2, 0, 1)).reshape(ATTN_KV_HEADS, grp, BLOCK, 3 * BLOCK)
    key_pos = jnp.arange(nblk, dtype=jnp.int32)[:, None] * BLOCK - BLOCK + c_off[None, :]
    in_range = (key_pos >= 0) & (key_pos < s)
    mask = in_range[:, None, :] & (jnp.abs(rel) <= WINDOW)[None]

    scores = jnp.where(mask[None, :, None, None], scores + bias[None, None], NEG_INF)
    sink_b = sink.astype(jnp.float32).reshape(ATTN_KV_HEADS, grp)[None, None, :, :, None, None]
    m = jnp.maximum(jnp.max(scores, axis=-1, keepdims=True), sink_b)
    p = jnp.exp(scores - m)
    denom = jnp.sum(p, axis=-1, keepdims=True) + jnp.exp(sink_b - m)
    probs = (p / denom).astype(vb.dtype)
    out = jnp.einsum('bnkgqc,bnckd->bnqkgd', probs, vb)
    return out.reshape(b, s, ATTN_WIDTH)


def s5_scan(u, a_re, a_im, log_dt, b_re, b_im, c_re, c_im):
    dt = jnp.exp(log_dt)[:, None]
    mag = jnp.exp(a_re * dt)
    lb_re = mag * jnp.cos(a_im * dt)
    lb_im = mag * jnp.sin(a_im * dt)
    den = a_re * a_re + a_im * a_im
    nr = lb_re - 1.0
    coef_re = (nr * a_re + lb_im * a_im) / den
    coef_im = (lb_im * a_re - nr * a_im) / den
    bb_re = coef_re[..., None] * b_re - coef_im[..., None] * b_im
    bb_im = coef_re[..., None] * b_im + coef_im[..., None] * b_re
    x_re = jnp.einsum('bsgh,gph->bsgp', u, bb_re)
    x_im = jnp.einsum('bsgh,gph->bsgp', u, bb_im)
    s = u.shape[1]
    la_re = jnp.broadcast_to(lb_re[None, None], (1, s) + lb_re.shape)
    la_im = jnp.broadcast_to(lb_im[None, None], (1, s) + lb_im.shape)

    def combine(e1, e2):
        a1r, a1i, b1r, b1i = e1
        a2r, a2i, b2r, b2i = e2
        return (a2r * a1r - a2i * a1i,
                a2r * a1i + a2i * a1r,
                a2r * b1r - a2i * b1i + b2r,
                a2r * b1i + a2i * b1r + b2i)

    _, _, h_re, h_im = lax.associative_scan(combine, (la_re, la_im, x_re, x_im), axis=1)
    return jnp.einsum('bsgp,ghp->bsgh', h_re, c_re) - jnp.einsum('bsgp,ghp->bsgh', h_im, c_im)


def s5_mixer(u, a_re, a_im, log_dt, b_re, b_im, c_re, c_im, d_skip, glu_w, glu_b):
    b, s, _ = u.shape
    f = lambda t: t.astype(jnp.float32)
    uf = f(u).reshape(b, s, SSM_GROUPS, SSM_GROUP)
    y_fwd = s5_scan(uf, f(a_re[0]), f(a_im[0]), f(log_dt[0]), f(b_re[0]), f(b_im[0]), f(c_re[0]), f(c_im[0]))
    y_bwd = s5_scan(uf[:, ::-1], f(a_re[1]), f(a_im[1]), f(log_dt[1]), f(b_re[1]), f(b_im[1]),
                    f(c_re[1]), f(c_im[1]))[:, ::-1]
    y = (y_fwd + y_bwd).reshape(b, s, SSM_WIDTH) + f(d_skip) * f(u)
    g = jax.nn.gelu(y)
    out = g * jax.nn.sigmoid(g @ f(glu_w) + f(glu_b))
    return out.astype(u.dtype)


def gmlp_mixer(h, w_in, ln_g, ln_b, w_s, b_s):
    b, s, _ = h.shape
    z = jax.nn.gelu(h @ w_in)
    u, v = jnp.split(z, 2, axis=-1)
    vf = v.astype(jnp.float32)
    mu = jnp.mean(vf, axis=-1, keepdims=True)
    var = jnp.mean(jnp.square(vf - mu), axis=-1, keepdims=True)
    vn = ((vf - mu) * lax.rsqrt(var + EPS) * ln_g.astype(jnp.float32) + ln_b.astype(jnp.float32)).astype(v.dtype)
    vc = vn.reshape(b, s // GMLP_CHUNK, GMLP_CHUNK, GMLP_HEADS, GMLP_HEAD_DIM)
    mixed = jnp.einsum('hts,bnshd->bnthd', w_s, vc) + b_s.T[None, None, :, :, None]
    return u * mixed.reshape(b, s, GMLP_WIDTH)


def expert_choice_ffn(h, router, w1, w3, w2):
    b, s, _ = h.shape
    cap = CAPACITY_FACTOR * s // N_EXPERTS
    aff = jax.nn.softmax((h @ router).astype(jnp.float32), axis=-1)
    gate, idx = lax.top_k(jnp.swapaxes(aff, 1, 2), cap)
    bidx = jnp.arange(b)[:, None, None]
    xs = h[bidx, idx]
    hid = jax.nn.silu(jnp.einsum('becd,edf->becf', xs, w1)) * jnp.einsum('becd,edf->becf', xs, w3)
    ys = jnp.einsum('becf,efd->becd', hid, w2) * gate[..., None].astype(h.dtype)
    return jnp.zeros_like(h).at[bidx, idx].add(ys)


def setup_inputs(seed: int = 0) -> dict:
    key = jax.random.key(seed)
    ks = jax.random.split(key, 32)
    f32 = jnp.float32

    def nrm(k, shape, scale):
        return jax.random.normal(k, shape, f32) * scale

    dir_shape = (N_EVEN, 2, SSM_GROUPS)
    n_idx = jnp.arange(SSM_STATE, dtype=f32)
    return {
        'x': nrm(ks[0], (BATCH, SEQ, D_MODEL), 1.0),
        'rel_bias': nrm(ks[1], (REL_BUCKETS, ATTN_HEADS), 0.5),
        'mix_norm': 1.0 + nrm(ks[2], (DEPTH, D_MODEL), 0.02),
        'ffn_norm': 1.0 + nrm(ks[3], (DEPTH, D_MODEL), 0.02),
        'final_norm': 1.0 + nrm(ks[4], (D_MODEL,), 0.02),
        'even_w_in': nrm(ks[5], (N_EVEN, D_MODEL, EVEN_IN), D_MODEL ** -0.5),
        'attn_sink': nrm(ks[6], (N_EVEN, ATTN_HEADS), 1.0),
        'ssm_a_re': -0.5 + nrm(ks[7], dir_shape + (SSM_STATE,), 0.01),
        'ssm_a_im': math.pi * n_idx + nrm(ks[8], dir_shape + (SSM_STATE,), 0.01),
        'ssm_log_dt': jax.random.uniform(ks[9], dir_shape, f32, math.log(1e-3), math.log(1e-1)),
        'ssm_b_re': nrm(ks[10], dir_shape + (SSM_STATE, SSM_GROUP), (2 * SSM_GROUP) ** -0.5),
        'ssm_b_im': nrm(ks[11], dir_shape + (SSM_STATE, SSM_GROUP), (2 * SSM_GROUP) ** -0.5),
        'ssm_c_re': nrm(ks[12], dir_shape + (SSM_GROUP, SSM_STATE), (2 * SSM_STATE) ** -0.5),
        'ssm_c_im': nrm(ks[13], dir_shape + (SSM_GROUP, SSM_STATE), (2 * SSM_STATE) ** -0.5),
        'ssm_d': nrm(ks[14], (N_EVEN, SSM_WIDTH), 1.0),
        'glu_w': nrm(ks[15], (N_EVEN, SSM_WIDTH, SSM_WIDTH), SSM_WIDTH ** -0.5),
        'glu_b': nrm(ks[16], (N_EVEN, SSM_WIDTH), 0.02),
        'even_w_out': nrm(ks[17], (N_EVEN, ATTN_WIDTH + SSM_WIDTH, D_MODEL), (ATTN_WIDTH + SSM_WIDTH) ** -0.5),
        'odd_w_in': nrm(ks[18], (N_ODD, D_MODEL, 2 * GMLP_WIDTH), D_MODEL ** -0.5),
        'sgu_ln_g': 1.0 + nrm(ks[19], (N_ODD, GMLP_WIDTH), 0.02),
        'sgu_ln_b': nrm(ks[20], (N_ODD, GMLP_WIDTH), 0.02),
        'sgu_w': nrm(ks[21], (N_ODD, GMLP_HEADS, GMLP_CHUNK, GMLP_CHUNK), GMLP_CHUNK ** -0.5),
        'sgu_b': 1.0 + nrm(ks[22], (N_ODD, GMLP_HEADS, GMLP_CHUNK), 0.02),
        'odd_w_out': nrm(ks[23], (N_ODD, GMLP_WIDTH, D_MODEL), GMLP_WIDTH ** -0.5),
        'router': nrm(ks[24], (DEPTH, D_MODEL, N_EXPERTS), D_MODEL ** -0.5),
        'moe_w1': nrm(ks[25], (DEPTH, N_EXPERTS, D_MODEL, EXPERT_FF), D_MODEL ** -0.5),
        'moe_w3': nrm(ks[26], (DEPTH, N_EXPERTS, D_MODEL, EXPERT_FF), D_MODEL ** -0.5),
        'moe_w2': nrm(ks[27], (DEPTH, N_EXPERTS, EXPERT_FF, D_MODEL), EXPERT_FF ** -0.5),
    }


def reference(x, rel_bias, mix_norm, ffn_norm, final_norm, even_w_in, attn_sink,
              ssm_a_re, ssm_a_im, ssm_log_dt, ssm_b_re, ssm_b_im, ssm_c_re, ssm_c_im,
              ssm_d, glu_w, glu_b, even_w_out, odd_w_in, sgu_ln_g, sgu_ln_b, sgu_w, sgu_b,
              odd_w_out, router, moe_w1, moe_w3, moe_w2):
    b, s, _ = x.shape
    for layer in range(DEPTH):
        h = rms_norm(x, mix_norm[layer])
        i = layer // 2
        if layer % 2 == 0:
            proj = h @ even_w_in[i]
            q, k, v, u = jnp.split(proj, [ATTN_WIDTH, ATTN_WIDTH + KV_WIDTH, ATTN_WIDTH + 2 * KV_WIDTH], axis=-1)
            attn = windowed_attention(q.reshape(b, s, ATTN_HEADS, HEAD_DIM),
                                      k.reshape(b, s, ATTN_KV_HEADS, HEAD_DIM),
                                      v.reshape(b, s, ATTN_KV_HEADS, HEAD_DIM),
                                      attn_sink[i], rel_bias)
            ssm = s5_mixer(u, ssm_a_re[i], ssm_a_im[i], ssm_log_dt[i], ssm_b_re[i], ssm_b_im[i],
                           ssm_c_re[i], ssm_c_im[i], ssm_d[i], glu_w[i], glu_b[i])
            x = x + jnp.concatenate([attn, ssm], axis=-1) @ even_w_out[i]
        else:
            g = gmlp_mixer(h, odd_w_in[i], sgu_ln_g[i], sgu_ln_b[i], sgu_w[i], sgu_b[i])
            x = x + g @ odd_w_out[i]
        h = rms_norm(x, ffn_norm[layer])
        x = x + expert_choice_ffn(h, router[layer], moe_w1[layer], moe_w3[layer], moe_w2[layer])
    return rms_norm(x, final_norm)
```

```cpp
#include <hip/hip_runtime.h>
#include <cstdio>
#include <cstdint>
namespace pg8 {
#define PG8_LAS __attribute__((address_space(3)))
typedef unsigned short bf16_t;
typedef short bf16x8 __attribute__((ext_vector_type(8)));
typedef float f32x4 __attribute__((ext_vector_type(4)));
typedef unsigned u32x4 __attribute__((ext_vector_type(4)));
constexpr int BM = 256, BK = 64, HALF = 128, HTB = HALF * BK * 2  , STAGE_BYTES = 8 * HTB, NXCD = 8, WGM = 8;

__host__ __device__ __forceinline__ int lds_byte(int r, int c) { const int st = (r >> 4) * 2 + (c >> 5), rr = r & 15, cc = c & 31, ob = rr * 64 + cc * 2; return st * 1024 + (ob ^ (((ob >> 9) & 1) << 5)); }
__host__ __device__ __forceinline__ void stage_rc(int b, int& R, int& C) { const int st = b / 1024, sb = b % 1024, swz = sb ^ (((sb >> 9) & 1) << 5); R = (st >> 1) * 16 + swz / 64; C = (st & 1) * 32 + (swz % 64) / 2; }
__host__ __device__ __forceinline__ int perm32(int rho) { const int n = rho >> 4, i = rho & 15; return 8 * (i >> 2) + 4 * n + (i & 3); }

struct Unit { int pm, pn; };
struct Gemm { const bf16_t* A; const bf16_t* Bt; int M, N, K; };

struct StaticOrder {
    int nM, nN, nwg, G, c;
    __host__ __device__ void init(int M, int N, int G_, int c_) { nM = M / BM; nN = N / BM; nwg = nM * nN; G = G_; c = c_; }
    __host__ __device__ bool next(int i, Unit& u) const {
        const long L = (long)i * G + c; if (L >= nwg) return false;
        int wgid = (int)L; { const int q = nwg / NXCD, r = nwg % NXCD, xcd = wgid % NXCD, off = wgid / NXCD; wgid = (xcd < r ? xcd * (q + 1) : r * (q + 1) + (xcd - r) * q) + off; }
        const int nig = WGM * nN, gid = wgid / nig, fm = gid * WGM, gsz = (nM - fm) < WGM ? (nM - fm) : WGM;
        u.pm = fm + ((wgid % nig) % gsz); u.pn = (wgid % nig) / gsz; return true;
    }
    __device__ __forceinline__ void a_ready(const Unit&) const {}
    __device__ __forceinline__ void done(const Unit&) const {}
};
__device__ __forceinline__ unsigned cvt_pk_bf16(float lo, float hi) { unsigned r; asm volatile("v_cvt_pk_bf16_f32 %0, %1, %2" : "=v"(r) : "v"(lo), "v"(hi)); return r; }
struct GroupedOrder : StaticOrder {
    int npg;
    __device__ __forceinline__ bool next(int i, Unit& u) const { if (!StaticOrder::next(i, u)) return false; u.pn += (u.pm >> 3) * npg; return true; }
};
typedef __bf16 bf16x2_t __attribute__((ext_vector_type(2)));
typedef float f32x2_t __attribute__((ext_vector_type(2)));
__device__ __forceinline__ unsigned pkbf(float a, float b) { f32x2_t v = {a, b}; bf16x2_t r = __builtin_convertvector(v, bf16x2_t); return __builtin_bit_cast(unsigned, r); }
__device__ __forceinline__ float bflo(unsigned w) { return __builtin_bit_cast(float, w << 16); }
__device__ __forceinline__ float bfhi(unsigned w) { return __builtin_bit_cast(float, w & 0xffff0000u); }
__device__ __forceinline__ float sigmoidf_(float v) { return __builtin_amdgcn_rcpf(1.f + __expf(-v)); }
__device__ __forceinline__ float gelu_tanh(float x) { const float u = x * (1.5957691216f + 0.0713548163f * x * x); return x * sigmoidf_(u); }

struct EpiStore {
    static constexpr bool PERM = true, AFTER_DRAIN = false;
    bf16_t* O; int ldc; int npn;
    __device__ __forceinline__ void operator()(const f32x4 (&acc)[2][2][4][2], const Unit& u, int wr, int wc, int fr, int fq) const {
        const int row0 = u.pm * BM + wr * 64 + fr, col0 = (u.pn % npn) * BM + wc * 32 + 8 * fq;
#pragma unroll
        for (int ai = 0; ai < 2; ++ai)
#pragma unroll
            for (int m = 0; m < 4; ++m) { bf16_t* rowp = O + (size_t)(row0 + ai * HALF + m * 16) * ldc + col0;
#pragma unroll
                for (int bj = 0; bj < 2; ++bj) { const f32x4 v0 = acc[ai][bj][m][0], v1 = acc[ai][bj][m][1];
                    u32x4 w; w.x = pkbf(v0[0], v0[1]); w.y = pkbf(v0[2], v0[3]); w.z = pkbf(v1[0], v1[1]); w.w = pkbf(v1[2], v1[3]);
                    *(u32x4*)(rowp + bj * HALF) = w; } }
    }
};
struct EpiGelu {
    static constexpr bool PERM = true, AFTER_DRAIN = false;
    bf16_t* O; int ldc; float* stat; int vtile0;
    __device__ __forceinline__ void operator()(const f32x4 (&acc)[2][2][4][2], const Unit& u, int wr, int wc, int fr, int fq) const {
        const int row0 = u.pm * BM + wr * 64 + fr, col0 = u.pn * BM + wc * 32 + 8 * fq;
        const bool isv = u.pn >= vtile0;
#pragma unroll
        for (int ai = 0; ai < 2; ++ai)
#pragma unroll
            for (int m = 0; m < 4; ++m) { const int row = row0 + ai * HALF + m * 16; bf16_t* rowp = O + (size_t)row * ldc + col0; float s1 = 0.f, s2 = 0.f;
#pragma unroll
                for (int bj = 0; bj < 2; ++bj) { f32x4 v0 = acc[ai][bj][m][0], v1 = acc[ai][bj][m][1];
#pragma unroll
                    for (int j = 0; j < 4; ++j) { v0[j] = gelu_tanh(v0[j]); v1[j] = gelu_tanh(v1[j]); s1 += v0[j] + v1[j]; s2 += v0[j] * v0[j] + v1[j] * v1[j]; }
                    u32x4 w; w.x = pkbf(v0[0], v0[1]); w.y = pkbf(v0[2], v0[3]); w.z = pkbf(v1[0], v1[1]); w.w = pkbf(v1[2], v1[3]);
                    *(u32x4*)(rowp + bj * HALF) = w; }
                if (isv) { s1 += __shfl_xor(s1, 16); s1 += __shfl_xor(s1, 32); s2 += __shfl_xor(s2, 16); s2 += __shfl_xor(s2, 32);
                    if (fq == 0) { (void)__hip_atomic_fetch_add(stat + 2 * row, s1, __ATOMIC_RELAXED, __HIP_MEMORY_SCOPE_AGENT); (void)__hip_atomic_fetch_add(stat + 2 * row + 1, s2, __ATOMIC_RELAXED, __HIP_MEMORY_SCOPE_AGENT); } } }
    }
};
struct EpiGlu {
    static constexpr bool PERM = true, AFTER_DRAIN = false;
    const bf16_t* G; int ldg; bf16_t* O; int ldo; int ocol0; const float* bias;
    __device__ __forceinline__ void operator()(const f32x4 (&acc)[2][2][4][2], const Unit& u, int wr, int wc, int fr, int fq) const {
        const int row0 = u.pm * BM + wr * 64 + fr, col0 = u.pn * BM + wc * 32 + 8 * fq;
        f32x4 bv[2][2];
#pragma unroll
        for (int bj = 0; bj < 2; ++bj)
#pragma unroll
            for (int n = 0; n < 2; ++n) bv[bj][n] = *(const f32x4*)(bias + col0 + bj * HALF + 4 * n);
#pragma unroll
        for (int ai = 0; ai < 2; ++ai)
#pragma unroll
            for (int m = 0; m < 4; ++m) { const int row = row0 + ai * HALF + m * 16;
#pragma unroll
                for (int bj = 0; bj < 2; ++bj) { const f32x4 v0 = acc[ai][bj][m][0] + bv[bj][0], v1 = acc[ai][bj][m][1] + bv[bj][1];
                    const u32x4 gw = *(const u32x4*)(G + (size_t)row * ldg + col0 + bj * HALF);
                    u32x4 w;
                    w.x = pkbf(bflo(gw.x) * sigmoidf_(v0[0]), bfhi(gw.x) * sigmoidf_(v0[1]));
                    w.y = pkbf(bflo(gw.y) * sigmoidf_(v0[2]), bfhi(gw.y) * sigmoidf_(v0[3]));
                    w.z = pkbf(bflo(gw.z) * sigmoidf_(v1[0]), bfhi(gw.z) * sigmoidf_(v1[1]));
                    w.w = pkbf(bflo(gw.w) * sigmoidf_(v1[2]), bfhi(gw.w) * sigmoidf_(v1[3]));
                    *(u32x4*)(O + (size_t)row * ldo + ocol0 + col0 + bj * HALF) = w; } }
    }
};
struct EpiSwiglu {
    static constexpr bool PERM = true, AFTER_DRAIN = false;
    bf16_t* O; int ldc; int npn;
    __device__ __forceinline__ void operator()(const f32x4 (&acc)[2][2][4][2], const Unit& u, int wr, int wc, int fr, int fq) const {
        const int row0 = u.pm * BM + wr * 64 + fr, col0 = (u.pn % npn) * HALF + wc * 32 + 8 * fq;
#pragma unroll
        for (int ai = 0; ai < 2; ++ai)
#pragma unroll
            for (int m = 0; m < 4; ++m) { const f32x4 a0 = acc[ai][0][m][0], a1 = acc[ai][0][m][1], b0 = acc[ai][1][m][0], b1 = acc[ai][1][m][1];
                u32x4 w;
                w.x = pkbf(a0[0] * sigmoidf_(a0[0]) * b0[0], a0[1] * sigmoidf_(a0[1]) * b0[1]);
                w.y = pkbf(a0[2] * sigmoidf_(a0[2]) * b0[2], a0[3] * sigmoidf_(a0[3]) * b0[3]);
                w.z = pkbf(a1[0] * sigmoidf_(a1[0]) * b1[0], a1[1] * sigmoidf_(a1[1]) * b1[1]);
                w.w = pkbf(a1[2] * sigmoidf_(a1[2]) * b1[2], a1[3] * sigmoidf_(a1[3]) * b1[3]);
                *(u32x4*)(O + (size_t)(row0 + ai * HALF + m * 16) * ldc + col0) = w; }
    }
};
struct EpiRes {
    static constexpr bool PERM = false, AFTER_DRAIN = false;
    const float* base; float* out; int ldc;
    __device__ __forceinline__ void operator()(const f32x4 (&acc)[2][2][4][2], const Unit& u, int wr, int wc, int fr, int fq) const {
        const int row0 = u.pm * BM + wr * 64 + fr, col0 = u.pn * BM + wc * 32 + 4 * fq;
#pragma unroll
        for (int ai = 0; ai < 2; ++ai)
#pragma unroll
            for (int m = 0; m < 4; ++m) { const size_t off = (size_t)(row0 + ai * HALF + m * 16) * ldc + col0;
#pragma unroll
                for (int bj = 0; bj < 2; ++bj)
#pragma unroll
                    for (int n = 0; n < 2; ++n) { const f32x4 bs = *(const f32x4*)(base + off + bj * HALF + n * 16); *(f32x4*)(out + off + bj * HALF + n * 16) = bs + acc[ai][bj][m][n]; } }
    }
};
template <class Epi, class Sched, bool ALIGN_EPI = false, bool SP2 = false>
__device__ __forceinline__ void gemm_phase(PG8_LAS unsigned char* lds, const Gemm g, const Sched& S, const Epi& E) {
    const int tid = threadIdx.x, wid = __builtin_amdgcn_readfirstlane(tid >> 6), lane = tid & 63, wr = wid >> 2, wc = wid & 3, fr = lane & 15, fq = lane >> 4;
    const int K = g.K, nt = K / BK;
    unsigned voffA[2], voffB[2];
#pragma unroll
    for (int i = 0; i < 2; ++i) { int R, C; stage_rc(tid * 16 + i * 8192, R, C); const int Rb = Epi::PERM ? ((R & ~31) + perm32(R & 31)) : R;
        voffA[i] = (unsigned)(R * K + C) * 2u; voffB[i] = (unsigned)(Rb * K + C) * 2u; }
    const size_t kstep = (size_t)(BK * 2);
    const size_t hstep = (size_t)HALF * K * 2;
    const size_t tstep = 2 * hstep;
    const unsigned ldsw = (unsigned)wid * 1024u;
    const int aoff = lds_byte(wr * 64 + fr, fq * 8), boff = lds_byte(wc * 32 + fr, fq * 8);
#define PG8_SA(b, h) (((b) * 2 + (h)) * HTB)
#define PG8_SB(b, h) ((4 + (b) * 2 + (h)) * HTB)
#define PG8_STAGE(bufoff, gbase, voff) do { _Pragma("unroll") for (int _i = 0; _i < 2; ++_i) \
        __builtin_amdgcn_global_load_lds((const unsigned*)((const char*)(gbase) + (voff)[_i]), (PG8_LAS unsigned*)(lds + (bufoff) + ldsw + _i * 8192), 16, 0, 0); } while (0)
#define PG8_LDA(dst, b, h) do { _Pragma("unroll") for (int m = 0; m < 4; ++m) _Pragma("unroll") for (int k = 0; k < 2; ++k) dst[m][k] = *(const PG8_LAS bf16x8*)(lds + PG8_SA(b, h) + aoff + m * 2048 + k * 1024); } while (0)
#define PG8_LDB(dst, b, h) do { _Pragma("unroll") for (int n = 0; n < 2; ++n) _Pragma("unroll") for (int k = 0; k < 2; ++k) dst[n][k] = *(const PG8_LAS bf16x8*)(lds + PG8_SB(b, h) + boff + n * 2048 + k * 1024); } while (0)
#define PG8_MMA(ai, bj, At, Bt) do { __builtin_amdgcn_s_setprio(1); _Pragma("unroll") for (int m = 0; m < 4; ++m) _Pragma("unroll") for (int n = 0; n < 2; ++n) _Pragma("unroll") for (int k = 0; k < 2; ++k) \
        acc[ai][bj][m][n] = __builtin_amdgcn_mfma_f32_16x16x32_bf16(Bt[n][k], At[m][k], acc[ai][bj][m][n], 0, 0, 0); __builtin_amdgcn_s_setprio(0); } while (0)
#define PG8_WAIT_V(n) asm volatile("s_waitcnt vmcnt(" #n ")" ::: "memory")
#define PG8_WAIT_L(n) asm volatile("s_waitcnt lgkmcnt(" #n ")" ::: "memory")
#define PG8_BAR __builtin_amdgcn_s_barrier()
#define PG8_SCHED __builtin_amdgcn_sched_barrier(0)
    Unit cur, nxt; int ui = 0;
    if (!S.next(0, cur)) return;
    f32x4 acc[2][2][4][2];
#pragma unroll
    for (int a = 0; a < 2; ++a)
#pragma unroll
        for (int b = 0; b < 2; ++b)
#pragma unroll
            for (int m = 0; m < 4; ++m)
#pragma unroll
                for (int n = 0; n < 2; ++n) acc[a][b][m][n] = (f32x4){0.f, 0.f, 0.f, 0.f};
    bf16x8 At[4][2], B0[2][2], B1[2][2];
    const char* cA = (const char*)g.A + (size_t)cur.pm * tstep; const char* cB = (const char*)g.Bt + (size_t)cur.pn * tstep;
    S.a_ready(cur);
    if constexpr (SP2) {
        PG8_STAGE(PG8_SB(0, 0), cB, voffB); PG8_STAGE(PG8_SB(0, 1), cB + hstep, voffB); PG8_STAGE(PG8_SA(0, 0), cA, voffA); PG8_STAGE(PG8_SA(0, 1), cA + hstep, voffA);
        if (wr == 1) PG8_BAR;
        PG8_WAIT_V(2); PG8_BAR;
        PG8_STAGE(PG8_SB(1, 0), cB + kstep, voffB); PG8_STAGE(PG8_SA(1, 0), cA + kstep, voffA); PG8_STAGE(PG8_SB(1, 1), cB + hstep + kstep, voffB);
        PG8_WAIT_V(6); PG8_BAR;
    } else {
        PG8_STAGE(PG8_SB(0, 0), cB, voffB); PG8_STAGE(PG8_SA(0, 0), cA, voffA); PG8_STAGE(PG8_SB(0, 1), cB + hstep, voffB); PG8_STAGE(PG8_SA(0, 1), cA + hstep, voffA);
        if (wr == 1) PG8_BAR;
        PG8_WAIT_V(4); PG8_BAR;
        PG8_STAGE(PG8_SB(1, 0), cB + kstep, voffB); PG8_STAGE(PG8_SA(1, 0), cA + kstep, voffA); PG8_STAGE(PG8_SB(1, 1), cB + hstep + kstep, voffB);
        PG8_WAIT_V(6); PG8_BAR;
    }
    for (;;) {
        const bool has_next = S.next(ui + 1, nxt);
        const char* nA = has_next ? (const char*)g.A + (size_t)nxt.pm * tstep : cA; const char* nB = has_next ? (const char*)g.Bt + (size_t)nxt.pn * tstep : cB;
        for (int t = 0; t < nt; t += 2) {
            const bool last = (t == nt - 2);
            const char* a1 = cA + (size_t)(t + 1) * kstep;
            const char* a2 = last ? nA : cA + (size_t)(t + 2) * kstep; const char* b2 = last ? nB : cB + (size_t)(t + 2) * kstep;
            const char* a3 = a2 + kstep; const char* b3 = b2 + kstep;
            if (last && has_next) S.a_ready(nxt);
            if constexpr (SP2) {
            PG8_LDB(B0, 0, 0); PG8_LDB(B1, 0, 1); PG8_SCHED; PG8_LDA(At, 0, 0); PG8_STAGE(PG8_SA(1, 1), a1 + hstep, voffA);
            PG8_WAIT_V(8); PG8_WAIT_L(0); PG8_BAR; PG8_MMA(0, 0, At, B0); PG8_MMA(0, 1, At, B1); PG8_BAR; PG8_SCHED;
            PG8_LDA(At, 0, 1); PG8_STAGE(PG8_SB(0, 0), b2, voffB); PG8_STAGE(PG8_SB(0, 1), b2 + hstep, voffB); PG8_STAGE(PG8_SA(0, 0), a2, voffA);
            PG8_WAIT_V(8); PG8_WAIT_L(0); PG8_BAR; PG8_MMA(1, 0, At, B0); PG8_MMA(1, 1, At, B1); PG8_BAR; PG8_SCHED;
            PG8_LDB(B0, 1, 0); PG8_LDB(B1, 1, 1); PG8_SCHED; PG8_LDA(At, 1, 0); PG8_STAGE(PG8_SA(0, 1), a2 + hstep, voffA);
            PG8_WAIT_V(8); PG8_WAIT_L(0); PG8_BAR; PG8_MMA(0, 0, At, B0); PG8_MMA(0, 1, At, B1); PG8_BAR; PG8_SCHED;
            PG8_LDA(At, 1, 1); PG8_STAGE(PG8_SB(1, 0), b3, voffB); PG8_STAGE(PG8_SB(1, 1), b3 + hstep, voffB); PG8_STAGE(PG8_SA(1, 0), a3, voffA);
            PG8_WAIT_V(8); PG8_WAIT_L(0); PG8_BAR; PG8_MMA(1, 0, At, B0); PG8_MMA(1, 1, At, B1); PG8_BAR; PG8_SCHED;
            } else {
            PG8_LDB(B0, 0, 0); PG8_SCHED; PG8_LDA(At, 0, 0); PG8_STAGE(PG8_SA(1, 1), a1 + hstep, voffA);
            PG8_WAIT_L(8); PG8_BAR; PG8_WAIT_L(0); PG8_MMA(0, 0, At, B0); PG8_BAR; PG8_SCHED;
            PG8_LDB(B1, 0, 1); PG8_STAGE(PG8_SB(0, 0), b2, voffB);
            PG8_BAR; PG8_WAIT_L(0); PG8_MMA(0, 1, At, B1); PG8_BAR;
            PG8_LDA(At, 0, 1); PG8_STAGE(PG8_SA(0, 0), a2, voffA);
            PG8_BAR; PG8_WAIT_L(0); PG8_MMA(1, 0, At, B0); PG8_BAR; PG8_SCHED;
            PG8_STAGE(PG8_SB(0, 1), b2 + hstep, voffB);
            PG8_WAIT_V(6); PG8_BAR; PG8_MMA(1, 1, At, B1); PG8_BAR;
            PG8_LDB(B0, 1, 0); PG8_SCHED; PG8_LDA(At, 1, 0); PG8_STAGE(PG8_SA(0, 1), a2 + hstep, voffA);
            PG8_WAIT_L(8); PG8_BAR; PG8_WAIT_L(0); PG8_MMA(0, 0, At, B0); PG8_BAR; PG8_SCHED;
            PG8_LDB(B1, 1, 1); PG8_STAGE(PG8_SB(1, 0), b3, voffB);
            PG8_BAR; PG8_WAIT_L(0); PG8_MMA(0, 1, At, B1); PG8_BAR;
            PG8_LDA(At, 1, 1); PG8_STAGE(PG8_SA(1, 0), a3, voffA);
            PG8_BAR; PG8_WAIT_L(0); PG8_MMA(1, 0, At, B0); PG8_BAR; PG8_SCHED;
            PG8_STAGE(PG8_SB(1, 1), b3 + hstep, voffB);
            PG8_WAIT_V(6); PG8_BAR; PG8_MMA(1, 1, At, B1); PG8_BAR;
            }
        }
        if constexpr (ALIGN_EPI) { if (wr == 0) PG8_BAR; }
        if constexpr (!Epi::AFTER_DRAIN) { E(acc, cur, wr, wc, fr, fq); S.done(cur); }
        if (!has_next) break;
#pragma unroll
        for (int a = 0; a < 2; ++a)
#pragma unroll
            for (int b = 0; b < 2; ++b)
#pragma unroll
                for (int m = 0; m < 4; ++m)
#pragma unroll
                    for (int n = 0; n < 2; ++n) acc[a][b][m][n] = (f32x4){0.f, 0.f, 0.f, 0.f};
        cur = nxt; cA = nA; cB = nB; ++ui;
        if constexpr (ALIGN_EPI) { if (wr == 1) PG8_BAR; }
    }
    PG8_WAIT_V(0);
    if constexpr (!ALIGN_EPI) { if (wr == 0) PG8_BAR; }
    PG8_BAR;
    if constexpr (Epi::AFTER_DRAIN) { E.fused(acc, cur, wr, wc, fr, fq, lds, wid, lane); S.done(cur); }
#undef PG8_SA
#undef PG8_SB
#undef PG8_STAGE
#undef PG8_LDA
#undef PG8_LDB
#undef PG8_MMA
#undef PG8_WAIT_V
#undef PG8_WAIT_L
#undef PG8_BAR
#undef PG8_SCHED
}
}

constexpr int NWAVES = 8, NT = NWAVES * 64;
#ifndef MK_N_LAUNCHES
#define MK_N_LAUNCHES 1
#endif
constexpr int BATCH = 4, SEQ = 4096, D = 2048, M = BATCH * SEQ;
constexpr int AW = 1024, KVW = 256, SW = 1024, EIN = 2560;
constexpr int QOFF = 0, KOFF = 1024, VOFF = 1280, UOFF = 1536;
constexpr int NE = 16, CAP = 512, FF = 2048, MS = NE * BATCH * CAP;
constexpr int GW = 2048, ZW = 4096;
constexpr float EPS = 1e-6f;

constexpr size_t MiB = 1u << 20, KiB = 1u << 10;
constexpr size_t WS_CTL = 0, CTL_ZERO_BYTES = 1 * MiB;
constexpr int CW_TMO = 0, CW_CODE = 1, CW_BAR = 4096;
constexpr size_t WS_STAT = 256 * KiB;
constexpr size_t WS_LUT = 1 * MiB;
constexpr size_t WS_LAM = WS_LUT + 16 * KiB;
constexpr size_t WS_LAM512 = WS_LAM + 64 * KiB;
constexpr size_t WS_BB = WS_LAM512 + 64 * KiB;
constexpr size_t WS_CM = WS_BB + 512 * KiB;
constexpr size_t WS_SGU = WS_CM + 512 * KiB;
constexpr size_t WS_E = 4 * MiB;
constexpr size_t WS_AFF = 6 * MiB;
constexpr size_t WS_IDX = 7 * MiB;
constexpr size_t WS_GATE = WS_IDX + 128 * KiB;
constexpr size_t WS_INV = 8 * MiB;
constexpr size_t WS_WIN0 = 16 * MiB, WS_GLU = 26 * MiB, WS_WOUT0 = 28 * MiB, WS_WIN1 = 36 * MiB, WS_WOUT1 = 52 * MiB;
constexpr size_t WS_W13 = 64 * MiB, WS_W2 = 576 * MiB;
constexpr size_t WS_H = 832 * MiB, WS_XA = 896 * MiB, WS_XB = 1024 * MiB;
constexpr size_t WS_XS = 1152 * MiB, WS_HID = 1280 * MiB, WS_YS = 1408 * MiB;
constexpr size_t WS_PROJ = 1536 * MiB, WS_CAT = 1616 * MiB, WS_G = 1680 * MiB, WS_YF = 1712 * MiB;
constexpr size_t WS_Z = 1536 * MiB, WS_G2 = 1664 * MiB;
constexpr size_t WS_END = 1776 * MiB;

constexpr int SCR_BYTES = 139264;
constexpr int LDSCTL_OFF = SCR_BYTES, MISC_OFF = LDSCTL_OFF + 320;
constexpr int LDS_BYTES = 147456;

#define GAS __attribute__((address_space(1)))
#define LAS __attribute__((address_space(3)))
typedef unsigned short bf16;
typedef unsigned v4u __attribute__((ext_vector_type(4)));
typedef unsigned v2u __attribute__((ext_vector_type(2)));
typedef float f32x4 __attribute__((ext_vector_type(4)));
typedef float f32x16 __attribute__((ext_vector_type(16)));
typedef short bf16x8 __attribute__((ext_vector_type(8)));
typedef short s16x4 __attribute__((ext_vector_type(4)));
typedef GAS unsigned gu32;
#define RLX_AGENT __ATOMIC_RELAXED, __HIP_MEMORY_SCOPE_AGENT
#define LDS_WAIT() asm volatile("s_waitcnt lgkmcnt(0)" ::: "memory")
#define VM_WAIT() asm volatile("s_waitcnt vmcnt(0)" ::: "memory")
using pg8::pkbf; using pg8::bflo; using pg8::bfhi; using pg8::gelu_tanh;
__device__ __forceinline__ bf16 f2bf1(float f) { return (bf16)(pkbf(f, 0.f) & 0xffffu); }
__device__ __forceinline__ float bf2f(bf16 b) { return __builtin_bit_cast(float, ((unsigned)b) << 16); }
#define MFMA32(a, b, c) __builtin_amdgcn_mfma_f32_32x32x16_bf16((a), (b), (c), 0, 0, 0)
#define MFMA16(a, b, c) __builtin_amdgcn_mfma_f32_16x16x32_bf16((a), (b), (c), 0, 0, 0)
__device__ __forceinline__ int crow(int reg, int h) { return (reg & 3) + 8 * (reg >> 2) + 4 * h; }
__device__ __forceinline__ float wave_sum(float v) {
#pragma unroll
    for (int o = 1; o < 64; o <<= 1) v += __shfl_xor(v, o);
    return v;
}
#define XB_TMO      128
#define XB_XCNT(j)  (256  + 64 * (j))
#define XB_XSUB(j)  (1280 + 64 * (j))
#define XB_XGEN(j)  (2304 + 64 * (j))
#define XB_TOP      3328
#define XB_TOPGEN   3392
#define XCD_BAR_WORDS 3456
#define XB_SPIN_CAP (1u << 18)

__device__ __forceinline__ unsigned xb_ld(unsigned* p)              { return __hip_atomic_load(p, __ATOMIC_RELAXED, __HIP_MEMORY_SCOPE_AGENT); }
__device__ __forceinline__ unsigned xb_add(unsigned* p, unsigned v) { return __hip_atomic_fetch_add(p, v, __ATOMIC_RELAXED, __HIP_MEMORY_SCOPE_AGENT); }
__device__ __forceinline__ unsigned xb_xcc_id() { return (unsigned)__builtin_amdgcn_s_getreg((3 << 11) | 20) & 0xFu; }
#define XB_SPIN(cond, bar) do { unsigned _sp = 0; while (cond) { __builtin_amdgcn_s_sleep(1); \
    if ((++_sp & 255u) == 0u) { if (xb_ld(&(bar)[XB_TMO])) break; if (_sp > XB_SPIN_CAP) { atomicAdd(&(bar)[XB_TMO], 1u); break; } } } } while (0)

struct XcdBarrier {
    unsigned* bar; unsigned x;
    volatile LAS unsigned* st;
};

__device__ __forceinline__ XcdBarrier xcd_barrier_post(unsigned* bar, volatile LAS unsigned* st) {
    XcdBarrier b; b.bar = bar; b.x = xb_xcc_id(); b.st = st;
    if (threadIdx.x == 0) (void)xb_add(&bar[XB_XCNT(b.x)], 1u);
    return b;
}
__device__ __forceinline__ void xcd_barrier_complete(unsigned* bar, unsigned x, unsigned& nloc, unsigned& nx) {
    const unsigned G = gridDim.x * gridDim.y * gridDim.z;
    unsigned sum, cnt, mine, sp = 0u;
    for (;;) {
        sum = 0u; cnt = 0u; mine = 0u;
#pragma unroll
        for (unsigned j = 0; j < 16; ++j) { const unsigned c = xb_ld(&bar[XB_XCNT(j)]); sum += c; cnt += (c > 0u) ? 1u : 0u; mine = (j == x) ? c : mine; }
        if (sum == G) break;
        __builtin_amdgcn_s_sleep(1);
        if ((++sp & 255u) == 0u) { if (xb_ld(&bar[XB_TMO])) break; if (sp > XB_SPIN_CAP) { atomicAdd(&bar[XB_TMO], 1u); break; } }
    }
    nloc = mine > 0u ? mine : 1u; nx = cnt > 0u ? cnt : 1u;
}

__device__ __forceinline__ void xcd_barrier(const XcdBarrier& b) {
    asm volatile("s_waitcnt vmcnt(0)" ::: "memory");
    __syncthreads();
    if (threadIdx.x == 0) {
        unsigned* bar = b.bar;
        __builtin_amdgcn_s_waitcnt(0);
        unsigned nloc = b.st[0], nx = b.st[1];
        if (nloc == 0u) { xcd_barrier_complete(bar, b.x, nloc, nx); b.st[0] = nloc; b.st[1] = nx; }
        const unsigned old = xb_add(&bar[XB_XSUB(b.x)], 1u);
        const unsigned gen = old / nloc;
        if (old + 1u == (gen + 1u) * nloc) {
            __builtin_amdgcn_fence(__ATOMIC_RELEASE, "agent");
            asm volatile("s_waitcnt vmcnt(0)" ::: "memory");
            const unsigned og = xb_add(&bar[XB_TOP], 1u);
            const unsigned tg = og / nx;
            if (og + 1u == (tg + 1u) * nx) xb_add(&bar[XB_TOPGEN], 1u);
            else XB_SPIN(xb_ld(&bar[XB_TOPGEN]) == tg, bar);
            __builtin_amdgcn_fence(__ATOMIC_ACQUIRE, "agent");
            xb_add(&bar[XB_XGEN(b.x)], 1u);
            asm volatile("s_waitcnt vmcnt(0)" ::: "memory");
        } else {
            XB_SPIN(xb_ld(&bar[XB_XGEN(b.x)]) == gen, bar);
            __builtin_amdgcn_fence(__ATOMIC_ACQUIRE, "agent");
            asm volatile("s_waitcnt vmcnt(0)" ::: "memory");
        }
    }
    __syncthreads();
}

struct Frame {
    LAS unsigned char* lds;
    volatile LAS unsigned* MISC;
    gu32* ctl;
    unsigned char* ws;
    int tid, lane, wave, vcu, G;
    const float* in[28];
    float* out;
};
enum { I_X = 0, I_RELB, I_MIXN, I_FFNN, I_FINN, I_EWIN, I_SINK, I_ARE, I_AIM, I_LDT, I_BRE, I_BIM, I_CRE, I_CIM, I_SSMD, I_GLUW, I_GLUB, I_EWOUT,
       I_OWIN, I_LNG, I_LNB, I_SGUW, I_SGUB, I_OWOUT, I_ROUTER, I_W1, I_W3, I_W2 };

__device__ __forceinline__ void p0_transpose_item(const float* W, int K, int N, bf16* WT, int row_base, LAS float* scr, int k0, int n0, int lane) {
#pragma unroll 8
    for (int i = 0; i < 32; ++i) { const int kk = 2 * i + (lane >> 5); scr[kk * 33 + (lane & 31)] = W[(size_t)(k0 + kk) * N + n0 + (lane & 31)]; }
    LDS_WAIT(); asm volatile("" ::: "memory");
    const int c = lane & 7;
#pragma unroll
    for (int j = 0; j < 4; ++j) { const int n = (lane >> 3) + 8 * j; const LAS float* s = scr + (8 * c) * 33 + n;
        v4u o; o.x = pkbf(s[0 * 33], s[1 * 33]); o.y = pkbf(s[2 * 33], s[3 * 33]); o.z = pkbf(s[4 * 33], s[5 * 33]); o.w = pkbf(s[6 * 33], s[7 * 33]);
        *(GAS v4u*)(WT + (size_t)(row_base + n) * K + k0 + 8 * c) = o; }
    LDS_WAIT(); asm volatile("" ::: "memory");
}
__device__ __forceinline__ void rms_row(const float* xrow, const float* gain, bf16* hb, float* of, int lane) {
    const GAS f32x4* xr = (const GAS f32x4*)xrow + lane; const GAS f32x4* gr = (const GAS f32x4*)gain + lane;
    f32x4 v[8]; float s = 0.f;
#pragma unroll
    for (int j = 0; j < 8; ++j) { v[j] = xr[64 * j]; s += (v[j].x * v[j].x + v[j].y * v[j].y) + (v[j].z * v[j].z + v[j].w * v[j].w); }
    const float rstd = 1.0f / sqrtf(wave_sum(s) * (1.f / D) + EPS);
#pragma unroll
    for (int j = 0; j < 8; ++j) { const f32x4 g = gr[64 * j]; const f32x4 o = v[j] * rstd * g;
        if (hb) { v2u w; w.x = pkbf(o.x, o.y); w.y = pkbf(o.z, o.w); *((GAS v2u*)hb + lane + 64 * j) = w; }
        if (of) *((GAS f32x4*)of + lane + 64 * j) = o; }
}
__device__ __forceinline__ int t5_bucket(int rel) {
    const int n = rel < 0 ? -rel : rel; int b;
    if (n < 8) b = n; else { b = 8 + (31 - __clz(n * n)) - 6; if (b > 15) b = 15; }
    return b + (rel > 0 ? 16 : 0);
}
__device__ __forceinline__ void sincos_d(double x, double& s, double& c) {
    const double q = __builtin_rint(x * 0.63661977236758134308);
    const double r = (x - q * 1.57079632673412561417) - q * 6.07710050650619224932e-11;
    const double r2 = r * r;
    const double sp = r * (1.0 + r2 * (-1.0 / 6 + r2 * (1.0 / 120 + r2 * (-1.0 / 5040 + r2 * (1.0 / 362880 + r2 * (-1.0 / 39916800 + r2 * (1.0 / 6227020800.0)))))));
    const double cp = 1.0 + r2 * (-0.5 + r2 * (1.0 / 24 + r2 * (-1.0 / 720 + r2 * (1.0 / 40320 + r2 * (-1.0 / 3628800 + r2 * (1.0 / 479001600.0 + r2 * (-1.0 / 87178291200.0)))))));
    const int qi = (int)((long long)q & 3);
    s = (qi == 0) ? sp : (qi == 1) ? cp : (qi == 2) ? -sp : -cp;
    c = (qi == 0) ? cp : (qi == 1) ? -sp : (qi == 2) ? -cp : sp;
}
__device__ __forceinline__ void p0_prologue(Frame& F) {
    LAS float* scr = (LAS float*)(F.lds + F.wave * 16384);
    const int gw = F.vcu * NWAVES + F.wave, NGW = F.G * NWAVES;
    bf16* WIN0 = (bf16*)(F.ws + WS_WIN0); bf16* GLU = (bf16*)(F.ws + WS_GLU); bf16* WOUT0 = (bf16*)(F.ws + WS_WOUT0); bf16* WIN1 = (bf16*)(F.ws + WS_WIN1); bf16* WOUT1 = (bf16*)(F.ws + WS_WOUT1);
    bf16* W13 = (bf16*)(F.ws + WS_W13); bf16* W2 = (bf16*)(F.ws + WS_W2);
    constexpr int I0 = (D / 64) * (EIN / 32), I1 = (SW / 64) * (SW / 32), I2 = (D / 64) * (D / 32), I3 = (D / 64) * (ZW / 32), I4 = I2;
    constexpr int NSM = I0 + I1 + I2 + I3 + I4;
    for (int it = gw; it < NSM; it += NGW) {
        int r = it;
        if (r < I0) { const int nb = EIN / 32; p0_transpose_item(F.in[I_EWIN], D, EIN, WIN0, 32 * (r % nb), scr, 64 * (r / nb), 32 * (r % nb), F.lane); continue; } r -= I0;
        if (r < I1) { const int nb = SW / 32; p0_transpose_item(F.in[I_GLUW], SW, SW, GLU, 32 * (r % nb), scr, 64 * (r / nb), 32 * (r % nb), F.lane); continue; } r -= I1;
        if (r < I2) { const int nb = D / 32; p0_transpose_item(F.in[I_EWOUT], D, D, WOUT0, 32 * (r % nb), scr, 64 * (r / nb), 32 * (r % nb), F.lane); continue; } r -= I2;
        if (r < I3) { const int nb = ZW / 32; p0_transpose_item(F.in[I_OWIN], D, ZW, WIN1, 32 * (r % nb), scr, 64 * (r / nb), 32 * (r % nb), F.lane); continue; } r -= I3;
        { const int nb = D / 32; p0_transpose_item(F.in[I_OWOUT], D, D, WOUT1, 32 * (r % nb), scr, 64 * (r / nb), 32 * (r % nb), F.lane); }
    }
    constexpr int IPM = (D / 64) * (FF / 32);
    for (int it = gw; it < 3 * 32 * IPM; it += NGW) {
        const int which = it / (32 * IPM), r0 = it % (32 * IPM), mat = r0 / IPM, r = r0 % IPM, nb = FF / 32, k0 = 64 * (r / nb), n0 = 32 * (r % nb);
        const size_t moff = (size_t)mat * D * FF;
        if (which == 0) p0_transpose_item(F.in[I_W1] + moff, D, FF, W13 + (size_t)mat * 2 * FF * D, (n0 >> 7) * 256 + (n0 & 127), scr, k0, n0, F.lane);
        else if (which == 1) p0_transpose_item(F.in[I_W3] + moff, D, FF, W13 + (size_t)mat * 2 * FF * D, (n0 >> 7) * 256 + 128 + (n0 & 127), scr, k0, n0, F.lane);
        else p0_transpose_item(F.in[I_W2] + moff, FF, D, W2 + (size_t)mat * FF * D, n0, scr, k0, n0, F.lane);
    }
    { bf16* SG = (bf16*)(F.ws + WS_SGU); const float* sw = F.in[I_SGUW];
      for (int i = (F.vcu * NT + F.tid) * 4; i < 16 * 128 * 128; i += F.G * NT * 4) { const f32x4 v = *(const f32x4*)(sw + i); v2u w; w.x = pkbf(v.x, v.y); w.y = pkbf(v.z, v.w); *(v2u*)(SG + i) = w; } }
    { float* LUT = (float*)(F.ws + WS_LUT); const float* rb = F.in[I_RELB];
      for (int i = F.vcu * NT + F.tid; i < 8 * 512; i += F.G * NT) { const int hd = i >> 9, rel = (i & 511) - 256; float v = -1e30f; if (rel >= -128 && rel <= 128) v = rb[t5_bucket(rel) * 8 + hd]; LUT[i] = v; } }
    { float* LAM = (float*)(F.ws + WS_LAM); float* LAM512 = (float*)(F.ws + WS_LAM512); bf16* BB = (bf16*)(F.ws + WS_BB); bf16* CM = (bf16*)(F.ws + WS_CM);
      for (int i = F.vcu * NT + F.tid; i < 2 * 64 * 64; i += F.G * NT) {
          const int p = i & 63, dg = i >> 6;
          const double dt = (double)expf(F.in[I_LDT][dg]); const double ar = (double)F.in[I_ARE][i], ai = (double)F.in[I_AIM][i];
          const double mag = (double)expf((float)(ar * dt)); double sn, cs; sincos_d(ai * dt, sn, cs);
          const double lbr = mag * cs, lbi = mag * sn, den = ar * ar + ai * ai, nr = lbr - 1.0;
          const double cr = (nr * ar + lbi * ai) / den, ci = (lbi * ar - nr * ai) / den;
          LAM[2 * i] = (float)lbr; LAM[2 * i + 1] = (float)lbi;
          const double mag5 = (double)expf((float)(512.0 * ar * dt)); double s5, c5; sincos_d(512.0 * ai * dt, s5, c5);
          LAM512[2 * i] = (float)(mag5 * c5); LAM512[2 * i + 1] = (float)(mag5 * s5);
#pragma unroll
          for (int c = 0; c < 16; ++c) { const double br = (double)F.in[I_BRE][(size_t)i * 16 + c], bi = (double)F.in[I_BIM][(size_t)i * 16 + c];
              BB[((size_t)dg * 128 + p) * 16 + c] = f2bf1((float)(cr * br - ci * bi)); BB[((size_t)dg * 128 + 64 + p) * 16 + c] = f2bf1((float)(cr * bi + ci * br));
              CM[((size_t)dg * 16 + c) * 128 + p] = f2bf1(F.in[I_CRE][((size_t)dg * 16 + c) * 64 + p]); CM[((size_t)dg * 16 + c) * 128 + 64 + p] = f2bf1(-F.in[I_CIM][((size_t)dg * 16 + c) * 64 + p]); }
      } }
    { bf16* H = (bf16*)(F.ws + WS_H);
      for (int m = gw; m < M; m += NGW) rms_row(F.in[I_X] + (size_t)m * D, F.in[I_MIXN], H + (size_t)m * D, nullptr, F.lane); }
}

constexpr int AT_P = 272;
constexpr int AT_K = 0, AT_VT = 128 * AT_P, AT_LUT = 2 * 128 * AT_P;
__device__ __forceinline__ void attn_unit(Frame& F, int unit) {
    const bf16* PROJ = (const bf16*)(F.ws + WS_PROJ); bf16* CAT = (bf16*)(F.ws + WS_CAT); const float* LUTG = (const float*)(F.ws + WS_LUT);
    const int hp = unit & 1, kvh = (unit >> 1) & 1, blk = (unit >> 2) & 31, b = unit >> 7;
    const int lane = F.lane, r = lane & 31, h = lane >> 5, hh = F.wave >> 2, head = kvh * 4 + hp * 2 + hh, qrow0 = (F.wave & 3) * 32;
    LAS unsigned char* lds = F.lds; LAS float* LUT = (LAS float*)(lds + AT_LUT);
    __syncthreads();
    for (int i = F.tid; i < 1024; i += NT) LUT[i] = LUTG[(kvh * 4 + hp * 2 + (i >> 9)) * 512 + (i & 511)];
    const size_t tq = (size_t)b * SEQ + blk * 128 + qrow0 + r;
    bf16x8 qf[8];
#pragma unroll
    for (int s = 0; s < 8; ++s) qf[s] = *(const bf16x8*)(PROJ + tq * EIN + QOFF + head * 128 + 16 * s + 8 * h);
    float mrun = F.in[I_SINK][head], lrun = 1.0f;
    f32x16 oacc[4];
#pragma unroll
    for (int dt = 0; dt < 4; ++dt)
#pragma unroll
        for (int i = 0; i < 16; ++i) oacc[dt][i] = 0.f;
    for (int jb = 0; jb < 3; ++jb) {
        const int kb = blk - 1 + jb; if (kb < 0 || kb >= SEQ / 128) continue;
        __syncthreads();
        const size_t tok0 = (size_t)b * SEQ + kb * 128;
#pragma unroll
        for (int i = 0; i < 4; ++i) { const int c = F.tid + NT * i, row = c >> 4, ch = c & 15;
            const v4u kv = *(const v4u*)(PROJ + (tok0 + row) * EIN + KOFF + kvh * 128 + ch * 8);
            const v4u vv = *(const v4u*)(PROJ + (tok0 + row) * EIN + VOFF + kvh * 128 + ch * 8);
            *(LAS v4u*)(lds + AT_K + row * AT_P + ch * 16) = kv;
            LAS bf16* vt = (LAS bf16*)(lds + AT_VT + (ch * 8) * AT_P + row * 2);
            vt[0 * (AT_P / 2)] = (bf16)(vv.x & 0xffffu); vt[1 * (AT_P / 2)] = (bf16)(vv.x >> 16); vt[2 * (AT_P / 2)] = (bf16)(vv.y & 0xffffu); vt[3 * (AT_P / 2)] = (bf16)(vv.y >> 16);
            vt[4 * (AT_P / 2)] = (bf16)(vv.z & 0xffffu); vt[5 * (AT_P / 2)] = (bf16)(vv.z >> 16); vt[6 * (AT_P / 2)] = (bf16)(vv.w & 0xffffu); vt[7 * (AT_P / 2)] = (bf16)(vv.w >> 16); }
        __syncthreads();
#pragma unroll 1
        for (int kt = 0; kt < 4; ++kt) {
            f32x16 sacc;
#pragma unroll
            for (int i = 0; i < 16; ++i) sacc[i] = 0.f;
#pragma unroll
            for (int s = 0; s < 8; ++s) { const bf16x8 a = *(const LAS bf16x8*)(lds + AT_K + (32 * kt + r) * AT_P + (16 * s + 8 * h) * 2); sacc = MFMA32(a, qf[s], sacc); }
            const int relbase = (kb - blk) * 128 + 32 * kt + 4 * h - qrow0 - r + 256 + hh * 512;
            float x[16]; float tmax = -3.0e38f;
#pragma unroll
            for (int i = 0; i < 16; ++i) { x[i] = sacc[i] * 0.08838834764831845f + LUT[relbase + (i & 3) + 8 * (i >> 2)]; tmax = fmaxf(tmax, x[i]); }
            tmax = fmaxf(tmax, __shfl_xor(tmax, 32));
            const float mnew = fmaxf(mrun, tmax), alpha = __expf(mrun - mnew); mrun = mnew;
            float psum = 0.f;
#pragma unroll
            for (int i = 0; i < 16; ++i) { x[i] = __expf(x[i] - mnew); psum += x[i]; }
            psum += __shfl_xor(psum, 32);
            lrun = lrun * alpha + psum;
#pragma unroll
            for (int dt = 0; dt < 4; ++dt)
#pragma unroll
                for (int i = 0; i < 16; ++i) oacc[dt][i] *= alpha;
            bf16x8 pb[2];
#pragma unroll
            for (int s2 = 0; s2 < 2; ++s2) { v4u w; w.x = pkbf(x[8 * s2 + 0], x[8 * s2 + 1]); w.y = pkbf(x[8 * s2 + 2], x[8 * s2 + 3]); w.z = pkbf(x[8 * s2 + 4], x[8 * s2 + 5]); w.w = pkbf(x[8 * s2 + 6], x[8 * s2 + 7]); pb[s2] = __builtin_bit_cast(bf16x8, w); }
#pragma unroll
            for (int dt = 0; dt < 4; ++dt)
#pragma unroll
                for (int s2 = 0; s2 < 2; ++s2) { const LAS unsigned char* vp = lds + AT_VT + (32 * dt + r) * AT_P + (32 * kt + 16 * s2 + 4 * h) * 2;
                    const s16x4 lo = *(const LAS s16x4*)vp, hi = *(const LAS s16x4*)(vp + 16);
                    const bf16x8 a = __builtin_shufflevector(lo, hi, 0, 1, 2, 3, 4, 5, 6, 7);
                    oacc[dt] = MFMA32(a, pb[s2], oacc[dt]); }
        }
    }
    __syncthreads();
    const float inv = 1.0f / lrun;
    LAS unsigned char* ob = lds + F.wave * (32 * AT_P);
#pragma unroll
    for (int dt = 0; dt < 4; ++dt)
#pragma unroll
        for (int i = 0; i < 16; ++i) *(LAS bf16*)(ob + r * AT_P + (32 * dt + crow(i, h)) * 2) = f2bf1(oacc[dt][i] * inv);
    LDS_WAIT(); asm volatile("" ::: "memory");
    const size_t trow0 = (size_t)b * SEQ + blk * 128 + qrow0;
#pragma unroll
    for (int i = 0; i < 8; ++i) { const int c = lane + 64 * i, row = c >> 4, ch = c & 15;
        const v4u v = *(const LAS v4u*)(ob + row * AT_P + ch * 16);
        *(GAS v4u*)(CAT + (trow0 + row) * D + head * 128 + ch * 8) = v; }
}

constexpr int SS_XP = 129;
constexpr int SS_HP = 272;
constexpr int SS_WAVE_BYTES = 32 * SS_XP * 4;
static_assert(NWAVES * SS_WAVE_BYTES <= SCR_BYTES, "S5 scratch");
template <int DIR, int MODE>
__device__ __forceinline__ void ssm_superchunk(Frame& F, int b, int g, int sc, float& hre, float& him) {
    const bf16* PROJ = (const bf16*)(F.ws + WS_PROJ);
    const int lane = F.lane, r = lane & 31, h = lane >> 5, dg = DIR * 64 + g;
    LAS float* XS = (LAS float*)(F.lds + F.wave * SS_WAVE_BYTES); LAS unsigned char* HS = (LAS unsigned char*)XS;
    const float2 lam = ((const float2*)(F.ws + WS_LAM))[dg * 64 + lane];
    bf16x8 bbf[4];
#pragma unroll
    for (int t = 0; t < 4; ++t) bbf[t] = *(const bf16x8*)((const bf16*)(F.ws + WS_BB) + ((size_t)dg * 128 + 32 * t + r) * 16 + 8 * h);
    bf16x8 cmf[4];
    if (MODE != 0) {
#pragma unroll
        for (int ks = 0; ks < 4; ++ks) cmf[ks] = *(const bf16x8*)((const bf16*)(F.ws + WS_CM) + ((size_t)dg * 16 + (lane & 15)) * 128 + 32 * ks + 8 * (lane >> 4));
    }
    const size_t tsc = (size_t)b * SEQ + sc * 512;
#pragma unroll 1
    for (int ci = 0; ci < 16; ++ci) {
        const int ch = DIR ? 15 - ci : ci; const size_t t0 = tsc + ch * 32;
        const bf16x8 uf = *(const bf16x8*)(PROJ + (t0 + r) * EIN + UOFF + g * 16 + 8 * h);
#pragma unroll
        for (int t = 0; t < 4; ++t) { f32x16 xa;
#pragma unroll
            for (int i = 0; i < 16; ++i) xa[i] = 0.f;
            xa = MFMA32(bbf[t], uf, xa);
#pragma unroll
            for (int i = 0; i < 16; ++i) XS[r * SS_XP + 32 * t + crow(i, h)] = xa[i]; }
        LDS_WAIT(); asm volatile("" ::: "memory");
        float xr[32], xi[32];
#pragma unroll
        for (int s = 0; s < 32; ++s) { xr[s] = XS[s * SS_XP + lane]; xi[s] = XS[s * SS_XP + 64 + lane]; }
        LDS_WAIT(); asm volatile("" ::: "memory");
#pragma unroll
        for (int st = 0; st < 32; ++st) { const int s = DIR ? 31 - st : st;
            const float nr = lam.x * hre - lam.y * him + xr[s], ni = lam.x * him + lam.y * hre + xi[s]; hre = nr; him = ni;
            if (MODE != 0) { *(LAS bf16*)(HS + s * SS_HP + lane * 2) = f2bf1(nr); *(LAS bf16*)(HS + s * SS_HP + (64 + lane) * 2) = f2bf1(ni); } }
        if (MODE != 0) {
            LDS_WAIT(); asm volatile("" ::: "memory");
            f32x4 y[2];
#pragma unroll
            for (int rt = 0; rt < 2; ++rt) { y[rt] = (f32x4){0.f, 0.f, 0.f, 0.f};
#pragma unroll
                for (int ks = 0; ks < 4; ++ks) { const bf16x8 a = *(const LAS bf16x8*)(HS + (16 * rt + (lane & 15)) * SS_HP + (32 * ks + 8 * (lane >> 4)) * 2); y[rt] = MFMA16(a, cmf[ks], y[rt]); } }
            LDS_WAIT(); asm volatile("" ::: "memory");
            const int cc = g * 16 + (lane & 15);
            float* YF = (float*)(F.ws + WS_YF);
            if (MODE == 1) {
#pragma unroll
                for (int rt = 0; rt < 2; ++rt)
#pragma unroll
                    for (int j = 0; j < 4; ++j) YF[(t0 + 16 * rt + 4 * (lane >> 4) + j) * SW + cc] = y[rt][j];
            } else {
                bf16* G = (bf16*)(F.ws + WS_G); const float dsk = F.in[I_SSMD][cc];
#pragma unroll
                for (int rt = 0; rt < 2; ++rt)
#pragma unroll
                    for (int j = 0; j < 4; ++j) { const size_t tk = t0 + 16 * rt + 4 * (lane >> 4) + j;
                        const float v = y[rt][j] + YF[tk * SW + cc] + dsk * bf2f(PROJ[tk * EIN + UOFF + cc]);
                        G[tk * SW + cc] = f2bf1(gelu_tanh(v)); }
            }
        }
    }
}
__device__ __forceinline__ void ssm_pass1(Frame& F) {
    float* E = (float*)(F.ws + WS_E);
    for (int task = F.vcu * NWAVES + F.wave; task < BATCH * 64 * 2 * 8; task += F.G * NWAVES) {
        const int sc = task & 7, dir = (task >> 3) & 1, g = (task >> 4) & 63, b = task >> 10;
        float hre = 0.f, him = 0.f;
        if (dir == 0) ssm_superchunk<0, 0>(F, b, g, sc, hre, him); else ssm_superchunk<1, 0>(F, b, g, sc, hre, him);
        E[(size_t)task * 128 + F.lane] = hre; E[(size_t)task * 128 + 64 + F.lane] = him;
    }
}
__device__ __forceinline__ void ssm_pass2(Frame& F) {
    const float* E = (const float*)(F.ws + WS_E);
    for (int task = F.vcu * NWAVES + F.wave; task < BATCH * 64 * 8; task += F.G * NWAVES) {
        const int sc = task & 7, g = (task >> 3) & 63, b = task >> 9;
        { const float2 l5 = ((const float2*)(F.ws + WS_LAM512))[(0 * 64 + g) * 64 + F.lane]; float cr = 0.f, ci = 0.f;
          for (int s2 = 0; s2 < sc; ++s2) { const float* e = E + ((size_t)(((b * 64 + g) * 2 + 0) * 8 + s2)) * 128; const float er = e[F.lane], ei = e[64 + F.lane];
              const float nr = l5.x * cr - l5.y * ci + er, ni = l5.x * ci + l5.y * cr + ei; cr = nr; ci = ni; }
          ssm_superchunk<0, 1>(F, b, g, sc, cr, ci); }
        { const float2 l5 = ((const float2*)(F.ws + WS_LAM512))[(1 * 64 + g) * 64 + F.lane]; float cr = 0.f, ci = 0.f;
          for (int s2 = 7; s2 > sc; --s2) { const float* e = E + ((size_t)(((b * 64 + g) * 2 + 1) * 8 + s2)) * 128; const float er = e[F.lane], ei = e[64 + F.lane];
              const float nr = l5.x * cr - l5.y * ci + er, ni = l5.x * ci + l5.y * cr + ei; cr = nr; ci = ni; }
          ssm_superchunk<1, 2>(F, b, g, sc, cr, ci); }
    }
}

__device__ __forceinline__ void router_phase(Frame& F, const float* X, const float* gain, const float* router) {
    bf16* H = (bf16*)(F.ws + WS_H); float* AFF = (float*)(F.ws + WS_AFF);
    LAS f32x4* RL = (LAS f32x4*)F.lds;
    __syncthreads();
    for (int q = F.tid; q < 2048 * 4; q += NT) { const int d = q >> 2, e4 = q & 3; const f32x4 v = *(const f32x4*)(router + d * 16 + e4 * 4);
        RL[(((d >> 8) * 4 + (d & 3)) * 4 + e4) * 64 + ((d & 255) >> 2)] = v; }
    __syncthreads();
    const int lane = F.lane;
    f32x4 gn[8];
#pragma unroll
    for (int j = 0; j < 8; ++j) gn[j] = *((const GAS f32x4*)gain + lane + 64 * j);
    for (int pr = F.vcu * NWAVES + F.wave; pr < M / 2; pr += F.G * NWAVES) {
        const size_t t0 = (size_t)pr * 2;
        f32x4 v0[8], v1[8]; float s0 = 0.f, s1 = 0.f;
#pragma unroll
        for (int j = 0; j < 8; ++j) { v0[j] = *((const GAS f32x4*)(X + t0 * D) + lane + 64 * j); v1[j] = *((const GAS f32x4*)(X + (t0 + 1) * D) + lane + 64 * j);
            s0 += (v0[j].x * v0[j].x + v0[j].y * v0[j].y) + (v0[j].z * v0[j].z + v0[j].w * v0[j].w); s1 += (v1[j].x * v1[j].x + v1[j].y * v1[j].y) + (v1[j].z * v1[j].z + v1[j].w * v1[j].w); }
        const float r0 = 1.0f / sqrtf(wave_sum(s0) * (1.f / D) + EPS), r1 = 1.0f / sqrtf(wave_sum(s1) * (1.f / D) + EPS);
        f32x4 a0[4], a1[4];
#pragma unroll
        for (int e4 = 0; e4 < 4; ++e4) { a0[e4] = (f32x4){0.f, 0.f, 0.f, 0.f}; a1[e4] = (f32x4){0.f, 0.f, 0.f, 0.f}; }
#pragma unroll
        for (int j = 0; j < 8; ++j) { v0[j] = v0[j] * r0 * gn[j]; v1[j] = v1[j] * r1 * gn[j];
            { v2u w; w.x = pkbf(v0[j].x, v0[j].y); w.y = pkbf(v0[j].z, v0[j].w); *((GAS v2u*)(H + t0 * D) + lane + 64 * j) = w; }
            { v2u w; w.x = pkbf(v1[j].x, v1[j].y); w.y = pkbf(v1[j].z, v1[j].w); *((GAS v2u*)(H + (t0 + 1) * D) + lane + 64 * j) = w; }
#pragma unroll
            for (int i = 0; i < 4; ++i) {
#pragma unroll
                for (int e4 = 0; e4 < 4; ++e4) { const f32x4 w = RL[((j * 4 + i) * 4 + e4) * 64 + lane]; a0[e4] += w * v0[j][i]; a1[e4] += w * v1[j][i]; }
                asm volatile("" ::: "memory"); } }
        float l0[16], l1[16];
#pragma unroll
        for (int e = 0; e < 16; ++e) { l0[e] = wave_sum(a0[e >> 2][e & 3]); l1[e] = wave_sum(a1[e >> 2][e & 3]); }
        float m0 = l0[0], m1 = l1[0];
#pragma unroll
        for (int e = 1; e < 16; ++e) { m0 = fmaxf(m0, l0[e]); m1 = fmaxf(m1, l1[e]); }
        float z0 = 0.f, z1 = 0.f;
#pragma unroll
        for (int e = 0; e < 16; ++e) { l0[e] = expf(l0[e] - m0); l1[e] = expf(l1[e] - m1); z0 += l0[e]; z1 += l1[e]; }
        const int bb = (int)(t0 / SEQ), ss = (int)(t0 % SEQ);
        float p0 = 0.f, p1 = 0.f;
#pragma unroll
        for (int e = 0; e < 16; ++e) { if (lane == e) { p0 = l0[e] / z0; p1 = l1[e] / z1; } }
        if (lane < 16) { AFF[((size_t)bb * NE + lane) * SEQ + ss] = p0; AFF[((size_t)bb * NE + lane) * SEQ + ss + 1] = p1; }
    }
    __syncthreads();
}

__device__ __forceinline__ void topk_unit(Frame& F, int unit) {
    const float* AFF = (const float*)(F.ws + WS_AFF) + (size_t)unit * SEQ;
    int* IDX = (int*)(F.ws + WS_IDX) + (size_t)unit * CAP; float* GATE = (float*)(F.ws + WS_GATE) + (size_t)unit * CAP; int* INV = (int*)(F.ws + WS_INV);
    const int b = unit >> 4, e = unit & 15, tid = F.tid, lane = F.lane;
    LAS unsigned* hist = (LAS unsigned*)F.lds;
    LAS unsigned* misc = hist + 256;
    unsigned v[8];
    { const v4u a = *(const v4u*)(AFF + tid * 8), c = *(const v4u*)(AFF + tid * 8 + 4); v[0] = a.x; v[1] = a.y; v[2] = a.z; v[3] = a.w; v[4] = c.x; v[5] = c.y; v[6] = c.z; v[7] = c.w; }
    unsigned prefix = 0u, need = CAP;
#pragma unroll 1
    for (int pass = 0; pass < 4; ++pass) {
        const int shift = 24 - 8 * pass;
        __syncthreads();
        if (tid < 256) hist[tid] = 0u;
        __syncthreads();
#pragma unroll
        for (int k = 0; k < 8; ++k) { const bool match = (pass == 0) || ((v[k] >> (shift + 8)) == prefix); if (match) (void)__hip_atomic_fetch_add(&hist[(v[k] >> shift) & 255u], 1u, __ATOMIC_RELAXED, __HIP_MEMORY_SCOPE_WORKGROUP); }
        __syncthreads();
        if (F.wave == 0) {
            const unsigned c0 = hist[4 * lane], c1 = hist[4 * lane + 1], c2 = hist[4 * lane + 2], c3 = hist[4 * lane + 3];
            unsigned suf = c0 + c1 + c2 + c3;
#pragma unroll
            for (int o = 1; o < 64; o <<= 1) { const unsigned t = __shfl_down(suf, o); if (lane + o < 64) suf += t; }
            const unsigned long long mask = __ballot(suf >= need);
            const int L = 63 - __builtin_clzll(mask);
            if (lane == L) { unsigned run = suf - (c0 + c1 + c2 + c3); unsigned dig, nd;
                if (run + c3 >= need) { dig = 3; nd = need - run; } else { run += c3;
                if (run + c2 >= need) { dig = 2; nd = need - run; } else { run += c2;
                if (run + c1 >= need) { dig = 1; nd = need - run; } else { run += c1; dig = 0; nd = need - run; } } }
                misc[0] = 4u * (unsigned)lane + dig; misc[1] = nd; }
        }
        __syncthreads();
        prefix = (prefix << 8) | misc[0]; need = misc[1];
    }
    const unsigned T = prefix;
    unsigned neq = 0u;
#pragma unroll
    for (int k = 0; k < 8; ++k) neq += (v[k] == T) ? 1u : 0u;
    unsigned inc = neq;
#pragma unroll
    for (int o = 1; o < 64; o <<= 1) { const unsigned t = __shfl_up(inc, o); if (lane >= o) inc += t; }
    __syncthreads();
    if (lane == 63) misc[16 + F.wave] = inc;
    __syncthreads();
    unsigned woff = 0u;
#pragma unroll
    for (int w = 0; w < NWAVES; ++w) woff += (w < F.wave) ? misc[16 + w] : 0u;
    unsigned eqrank = woff + inc - neq;
    unsigned sel = 0u; unsigned selm = 0u;
#pragma unroll
    for (int k = 0; k < 8; ++k) { bool s = v[k] > T; if (v[k] == T) { s = eqrank < need; ++eqrank; } if (s) { selm |= 1u << k; ++sel; } }
    unsigned inc2 = sel;
#pragma unroll
    for (int o = 1; o < 64; o <<= 1) { const unsigned t = __shfl_up(inc2, o); if (lane >= o) inc2 += t; }
    if (lane == 63) misc[32 + F.wave] = inc2;
    __syncthreads();
    unsigned woff2 = 0u;
#pragma unroll
    for (int w = 0; w < NWAVES; ++w) woff2 += (w < F.wave) ? misc[32 + w] : 0u;
    unsigned slot = woff2 + inc2 - sel;
#pragma unroll
    for (int k = 0; k < 8; ++k) { const int s = tid * 8 + k; int sl = -1;
        if (selm & (1u << k)) { sl = (int)slot; ++slot; IDX[sl] = s; GATE[sl] = __builtin_bit_cast(float, v[k]); }
        INV[((size_t)b * SEQ + s) * NE + e] = sl; }
}

__device__ __forceinline__ void gather_phase(Frame& F) {
    const bf16* H = (const bf16*)(F.ws + WS_H); bf16* XS = (bf16*)(F.ws + WS_XS); const int* IDX = (const int*)(F.ws + WS_IDX);
    for (int row = F.vcu * NWAVES + F.wave; row < MS; row += F.G * NWAVES) {
        const int e = row >> 11, b = (row >> 9) & 3, c = row & 511; const int s = IDX[(b * NE + e) * CAP + c];
        const GAS v4u* src = (const GAS v4u*)(H + ((size_t)b * SEQ + s) * D) + F.lane; GAS v4u* dst = (GAS v4u*)(XS + (size_t)row * D) + F.lane;
        v4u t[4];
#pragma unroll
        for (int j = 0; j < 4; ++j) t[j] = src[64 * j];
#pragma unroll
        for (int j = 0; j < 4; ++j) dst[64 * j] = t[j];
    }
}
template <bool FINAL>
__device__ __forceinline__ void combine_phase(Frame& F, const float* Xin, float* Xout, const float* gain) {
    const bf16* YS = (const bf16*)(F.ws + WS_YS); const int* INV = (const int*)(F.ws + WS_INV); const float* GATE = (const float*)(F.ws + WS_GATE);
    bf16* H = (bf16*)(F.ws + WS_H); const int lane = F.lane;
    for (int t = F.vcu * NWAVES + F.wave; t < M; t += F.G * NWAVES) {
        const int b = t / SEQ;
        f32x4 v[8];
#pragma unroll
        for (int j = 0; j < 8; ++j) v[j] = *((const GAS f32x4*)(Xin + (size_t)t * D) + lane + 64 * j);
        const int myinv = INV[(size_t)t * NE + (lane & 15)];
#pragma unroll 1
        for (int e = 0; e < NE; ++e) {
            const int sl = __shfl(myinv, e);
            if (sl >= 0) {
                const float gt = GATE[(b * NE + e) * CAP + sl]; const size_t row = (size_t)e * 2048 + b * 512 + sl;
#pragma unroll
                for (int j = 0; j < 8; ++j) { const v2u w = *((const GAS v2u*)(YS + row * D) + lane + 64 * j);
                    v[j].x += gt * bflo(w.x); v[j].y += gt * bfhi(w.x); v[j].z += gt * bflo(w.y); v[j].w += gt * bfhi(w.y); }
            }
        }
        float s = 0.f;
#pragma unroll
        for (int j = 0; j < 8; ++j) { if (!FINAL) *((GAS f32x4*)(Xout + (size_t)t * D) + lane + 64 * j) = v[j]; s += (v[j].x * v[j].x + v[j].y * v[j].y) + (v[j].z * v[j].z + v[j].w * v[j].w); }
        const float rstd = 1.0f / sqrtf(wave_sum(s) * (1.f / D) + EPS);
#pragma unroll
        for (int j = 0; j < 8; ++j) { const f32x4 g = *((const GAS f32x4*)gain + lane + 64 * j); const f32x4 o = v[j] * rstd * g;
            if (FINAL) *((GAS f32x4*)(F.out + (size_t)t * D) + lane + 64 * j) = o;
            else { v2u w; w.x = pkbf(o.x, o.y); w.y = pkbf(o.z, o.w); *((GAS v2u*)(H + (size_t)t * D) + lane + 64 * j) = w; } }
    }
}

__device__ __forceinline__ void sgu_unit(Frame& F, int unit) {
    const bf16* Z = (const bf16*)(F.ws + WS_Z); bf16* G2 = (bf16*)(F.ws + WS_G2); const float* STAT = (const float*)(F.ws + WS_STAT); const bf16* SG = (const bf16*)(F.ws + WS_SGU);
    const int hd = unit & 15, n = unit >> 4; const size_t t0 = (size_t)n * 128;
    const int lane = F.lane, r = lane & 31, h = lane >> 5;
    LAS unsigned char* lds = F.lds;
    __syncthreads();
#pragma unroll
    for (int i = 0; i < 4; ++i) { const int c = F.tid + NT * i, row = c >> 4, ch = c & 15;
        const v4u vv = *(const v4u*)(Z + (t0 + row) * ZW + GW + hd * 128 + ch * 8);
        const float s1 = STAT[2 * (t0 + row)], s2 = STAT[2 * (t0 + row) + 1]; const float mu = s1 * (1.f / GW); const float var = fmaxf(s2 * (1.f / GW) - mu * mu, 0.f); const float rstd = 1.0f / sqrtf(var + EPS);
        const f32x4 g0 = *(const f32x4*)(F.in[I_LNG] + hd * 128 + ch * 8), g1 = *(const f32x4*)(F.in[I_LNG] + hd * 128 + ch * 8 + 4);
        const f32x4 b0 = *(const f32x4*)(F.in[I_LNB] + hd * 128 + ch * 8), b1 = *(const f32x4*)(F.in[I_LNB] + hd * 128 + ch * 8 + 4);
        LAS bf16* vt = (LAS bf16*)(lds + (ch * 8) * AT_P + row * 2);
        vt[0 * (AT_P / 2)] = f2bf1((bflo(vv.x) - mu) * rstd * g0.x + b0.x); vt[1 * (AT_P / 2)] = f2bf1((bfhi(vv.x) - mu) * rstd * g0.y + b0.y);
        vt[2 * (AT_P / 2)] = f2bf1((bflo(vv.y) - mu) * rstd * g0.z + b0.z); vt[3 * (AT_P / 2)] = f2bf1((bfhi(vv.y) - mu) * rstd * g0.w + b0.w);
        vt[4 * (AT_P / 2)] = f2bf1((bflo(vv.z) - mu) * rstd * g1.x + b1.x); vt[5 * (AT_P / 2)] = f2bf1((bfhi(vv.z) - mu) * rstd * g1.y + b1.y);
        vt[6 * (AT_P / 2)] = f2bf1((bflo(vv.w) - mu) * rstd * g1.z + b1.z); vt[7 * (AT_P / 2)] = f2bf1((bfhi(vv.w) - mu) * rstd * g1.w + b1.w); }
    __syncthreads();
    const int rt = F.wave >> 1, dt0 = (F.wave & 1) * 2;
    f32x16 acc[2];
#pragma unroll
    for (int q = 0; q < 2; ++q)
#pragma unroll
        for (int i = 0; i < 16; ++i) acc[q][i] = 0.f;
#pragma unroll
    for (int ks = 0; ks < 8; ++ks) { const bf16x8 a = *(const bf16x8*)(SG + ((size_t)hd * 128 + 32 * rt + r) * 128 + 16 * ks + 8 * h);
#pragma unroll
        for (int q = 0; q < 2; ++q) { const bf16x8 bv = *(const LAS bf16x8*)(lds + (32 * (dt0 + q) + r) * AT_P + (16 * ks + 8 * h) * 2); acc[q] = MFMA32(a, bv, acc[q]); } }
#pragma unroll
    for (int q = 0; q < 2; ++q)
#pragma unroll
        for (int i = 0; i < 16; ++i) { const int t = 32 * rt + crow(i, h), d = hd * 128 + 32 * (dt0 + q) + r;
            const float mixed = acc[q][i] + F.in[I_SGUB][hd * 128 + t]; const float u = bf2f(Z[(t0 + t) * ZW + d]);
            G2[(t0 + t) * GW + d] = f2bf1(u * mixed); }
}

constexpr int N_PHASES = 21;
struct Args { const float* in[28]; float* out; unsigned char* ws; int ph_lo, ph_hi; };
static_assert(sizeof(Args) == 28 * 8 + 8 + 8 + 8, "Args has no padding");

__global__ void __launch_bounds__(NT, 2) enc_fwd(Args args) {
    extern __shared__ __attribute__((aligned(16))) unsigned char lds[];
    Frame F;
    F.lds = (LAS unsigned char*)lds;
    F.MISC = (volatile LAS unsigned*)(F.lds + MISC_OFF);
    F.tid = threadIdx.x; F.lane = F.tid & 63; F.wave = __builtin_amdgcn_readfirstlane(F.tid >> 6);
    F.G = gridDim.x; { const int bx = blockIdx.x; F.vcu = (F.G % 8 == 0) ? (bx % 8) * (F.G / 8) + bx / 8 : bx; }
    F.ws = args.ws; F.ctl = (gu32*)(args.ws + WS_CTL); F.out = args.out;
#pragma unroll
    for (int i = 0; i < 28; ++i) F.in[i] = args.in[i];
    for (int u = F.tid; u < (LDS_BYTES - LDSCTL_OFF) / 4; u += NT) ((LAS unsigned*)(F.lds + LDSCTL_OFF))[u] = 0u;
    __syncthreads();
    const int lo = args.ph_lo, hi = args.ph_hi;
    const bool multi = (hi - lo) > 1;
    XcdBarrier bar; bar.bar = (unsigned*)(F.ctl + CW_BAR); bar.x = 0; bar.st = nullptr;
    if (multi) bar = xcd_barrier_post((unsigned*)(F.ctl + CW_BAR), F.MISC + 8);
#ifdef ONLY_PHASE
#define IN(k) ((k) == ONLY_PHASE && lo <= (k) && (k) < hi)
#else
#define IN(k) (lo <= (k) && (k) < hi)
#endif
#define SEAM(k) do { if (IN((k) + 1)) xcd_barrier(bar); } while (0)
    LAS unsigned char* ring = F.lds;
    bf16* const H = (bf16*)(F.ws + WS_H); float* const XA = (float*)(F.ws + WS_XA); float* const XB = (float*)(F.ws + WS_XB);
    bf16* const XS = (bf16*)(F.ws + WS_XS); bf16* const HID = (bf16*)(F.ws + WS_HID); bf16* const YS = (bf16*)(F.ws + WS_YS);

    if (IN(0)) { p0_prologue(F); SEAM(0); }
    if (IN(1)) {
        pg8::Gemm g{H, (const bf16*)(F.ws + WS_WIN0), M, EIN, D}; pg8::StaticOrder S; S.init(M, EIN, F.G, (int)blockIdx.x);
        pg8::EpiStore E{(bf16*)(F.ws + WS_PROJ), EIN, EIN / 256};
        pg8::gemm_phase<pg8::EpiStore, pg8::StaticOrder, true, true>(ring, g, S, E);
        SEAM(1);
    }
    if (IN(2)) {
        for (int u = blockIdx.x; u < BATCH * 32 * 2 * 2; u += F.G) attn_unit(F, u);
        __syncthreads();
        ssm_pass1(F);
        SEAM(2);
    }
    if (IN(3)) { ssm_pass2(F); SEAM(3); }
    if (IN(4)) {
        pg8::Gemm g{(const bf16*)(F.ws + WS_G), (const bf16*)(F.ws + WS_GLU), M, SW, SW}; pg8::StaticOrder S; S.init(M, SW, F.G, (int)blockIdx.x);
        pg8::EpiGlu E{(const bf16*)(F.ws + WS_G), SW, (bf16*)(F.ws + WS_CAT), D, AW, F.in[I_GLUB]};
        pg8::gemm_phase<pg8::EpiGlu, pg8::StaticOrder, true, true>(ring, g, S, E);
        SEAM(4);
    }
    if (IN(5)) {
        pg8::Gemm g{(const bf16*)(F.ws + WS_CAT), (const bf16*)(F.ws + WS_WOUT0), M, D, D}; pg8::StaticOrder S; S.init(M, D, F.G, (int)blockIdx.x);
        pg8::EpiRes E{F.in[I_X], XA, D};
        pg8::gemm_phase<pg8::EpiRes, pg8::StaticOrder, true, true>(ring, g, S, E);
        SEAM(5);
    }
    if (IN(6)) { router_phase(F, XA, F.in[I_FFNN], F.in[I_ROUTER]); SEAM(6); }
    if (IN(7)) { for (int u = blockIdx.x; u < BATCH * NE; u += F.G) topk_unit(F, u); SEAM(7); }
    if (IN(8)) { gather_phase(F); SEAM(8); }
    if (IN(9)) {
        pg8::Gemm g{XS, (const bf16*)(F.ws + WS_W13), MS, 2 * FF, D}; pg8::GroupedOrder S; S.init(MS, 2 * FF, F.G, (int)blockIdx.x); S.npg = 2 * FF / 256;
        pg8::EpiSwiglu E{HID, FF, 2 * FF / 256};
        pg8::gemm_phase<pg8::EpiSwiglu, pg8::GroupedOrder, true, true>(ring, g, S, E);
        SEAM(9);
    }
    if (IN(10)) {
        pg8::Gemm g{HID, (const bf16*)(F.ws + WS_W2), MS, D, FF}; pg8::GroupedOrder S; S.init(MS, D, F.G, (int)blockIdx.x); S.npg = D / 256;
        pg8::EpiStore E{YS, D, D / 256};
        pg8::gemm_phase<pg8::EpiStore, pg8::GroupedOrder, true, true>(ring, g, S, E);
        SEAM(10);
    }
    if (IN(11)) { combine_phase<false>(F, XA, XB, F.in[I_MIXN] + D); SEAM(11); }
    if (IN(12)) {
        pg8::Gemm g{H, (const bf16*)(F.ws + WS_WIN1), M, ZW, D}; pg8::StaticOrder S; S.init(M, ZW, F.G, (int)blockIdx.x);
        pg8::EpiGelu E{(bf16*)(F.ws + WS_Z), ZW, (float*)(F.ws + WS_STAT), GW / 256};
        pg8::gemm_phase<pg8::EpiGelu, pg8::StaticOrder, true, true>(ring, g, S, E);
        SEAM(12);
    }
    if (IN(13)) { for (int u = blockIdx.x; u < (M / 128) * 16; u += F.G) sgu_unit(F, u); SEAM(13); }
    if (IN(14)) {
        pg8::Gemm g{(const bf16*)(F.ws + WS_G2), (const bf16*)(F.ws + WS_WOUT1), M, D, GW}; pg8::StaticOrder S; S.init(M, D, F.G, (int)blockIdx.x);
        pg8::EpiRes E{XB, XA, D};
        pg8::gemm_phase<pg8::EpiRes, pg8::StaticOrder, true, true>(ring, g, S, E);
        SEAM(14);
    }
    if (IN(15)) { router_phase(F, XA, F.in[I_FFNN] + D, F.in[I_ROUTER] + D * NE); SEAM(15); }
    if (IN(16)) { for (int u = blockIdx.x; u < BATCH * NE; u += F.G) topk_unit(F, u); SEAM(16); }
    if (IN(17)) { gather_phase(F); SEAM(17); }
    if (IN(18)) {
        pg8::Gemm g{XS, (const bf16*)(F.ws + WS_W13) + (size_t)NE * 2 * FF * D, MS, 2 * FF, D}; pg8::GroupedOrder S; S.init(MS, 2 * FF, F.G, (int)blockIdx.x); S.npg = 2 * FF / 256;
        pg8::EpiSwiglu E{HID, FF, 2 * FF / 256};
        pg8::gemm_phase<pg8::EpiSwiglu, pg8::GroupedOrder, true, true>(ring, g, S, E);
        SEAM(18);
    }
    if (IN(19)) {
        pg8::Gemm g{HID, (const bf16*)(F.ws + WS_W2) + (size_t)NE * FF * D, MS, D, FF}; pg8::GroupedOrder S; S.init(MS, D, F.G, (int)blockIdx.x); S.npg = D / 256;
        pg8::EpiStore E{YS, D, D / 256};
        pg8::gemm_phase<pg8::EpiStore, pg8::GroupedOrder, true, true>(ring, g, S, E);
        SEAM(19);
    }
    if (IN(20)) { combine_phase<true>(F, XA, nullptr, F.in[I_FINN]); }
#undef IN
#undef SEAM
}

extern "C" void kernel_launch(void* const* d_in, const int* in_sizes, int n_in, void* d_out, int out_size, void* d_ws, size_t ws_size, hipStream_t stream) {
    static int grid = 0;
    if (grid == 0) {
        if (n_in != 28 || in_sizes[0] != M * D || out_size != M * D || ws_size < WS_END) { fprintf(stderr, "kernel_launch: shape/workspace mismatch (n_in %d, in0 %d, out %d, ws %zu, need %zu)\n", n_in, n_in > 0 ? in_sizes[0] : -1, out_size, ws_size, (size_t)WS_END); grid = -1; return; }
        int dev = 0, cus = 0, per_cu = 0;
        if (hipGetDevice(&dev) != hipSuccess || hipDeviceGetAttribute(&cus, hipDeviceAttributeMultiprocessorCount, dev) != hipSuccess) { grid = -1; return; }
        if (hipFuncSetAttribute((const void*)enc_fwd, hipFuncAttributeMaxDynamicSharedMemorySize, LDS_BYTES) != hipSuccess) { fprintf(stderr, "kernel_launch: hipFuncSetAttribute failed\n"); grid = -1; return; }
        if (hipOccupancyMaxActiveBlocksPerMultiprocessor(&per_cu, (const void*)enc_fwd, NT, LDS_BYTES) != hipSuccess || per_cu < 1) fprintf(stderr, "kernel_launch: occupancy query reports %d\n", per_cu);
        (void)hipGetLastError();
        grid = cus;
    }
    if (grid < 0) return;
    (void)hipMemsetAsync((char*)d_ws + WS_CTL, 0, CTL_ZERO_BYTES, stream);
    Args a{};
    for (int i = 0; i < 28; ++i) a.in[i] = (const float*)d_in[i];
    a.out = (float*)d_out; a.ws = (unsigned char*)d_ws;
#if MK_N_LAUNCHES == 1
    a.ph_lo = 0; a.ph_hi = N_PHASES;
    hipLaunchKernelGGL(enc_fwd, dim3(grid), dim3(NT), LDS_BYTES, stream, a);
#else
    for (int p = 0; p < N_PHASES; ++p) { a.ph_lo = p; a.ph_hi = p + 1; hipLaunchKernelGGL(enc_fwd, dim3(grid), dim3(NT), LDS_BYTES, stream, a); }
#endif
}
```

```cpp
#include <hip/hip_runtime.h>
#include <cstdio>
#include <cstdint>
namespace pg8 {
#define PG8_LAS __attribute__((address_space(3)))
typedef unsigned short bf16_t;
typedef short bf16x8 __attribute__((ext_vector_type(8)));
typedef float f32x4 __attribute__((ext_vector_type(4)));
typedef unsigned u32x4 __attribute__((ext_vector_type(4)));
constexpr int BM = 256, BK = 64, HALF = 128, HTB = HALF * BK * 2  , STAGE_BYTES = 8 * HTB, NXCD = 8, WGM = 8;

__host__ __device__ __forceinline__ int lds_byte(int r, int c) { const int st = (r >> 4) * 2 + (c >> 5), rr = r & 15, cc = c & 31, ob = rr * 64 + cc * 2; return st * 1024 + (ob ^ (((ob >> 9) & 1) << 5)); }
__host__ __device__ __forceinline__ void stage_rc(int b, int& R, int& C) { const int st = b / 1024, sb = b % 1024, swz = sb ^ (((sb >> 9) & 1) << 5); R = (st >> 1) * 16 + swz / 64; C = (st & 1) * 32 + (swz % 64) / 2; }
__host__ __device__ __forceinline__ int perm32(int rho) { const int n = rho >> 4, i = rho & 15; return 8 * (i >> 2) + 4 * n + (i & 3); }

struct Unit { int pm, pn; };
struct Gemm { const bf16_t* A; const bf16_t* Bt; int M, N, K; const int* rowtok; };

struct StaticOrder {
    int nM, nN, nwg, G, c;
    __host__ __device__ void init(int M, int N, int G_, int c_) { nM = M / BM; nN = N / BM; nwg = nM * nN; G = G_; c = c_; }
    __host__ __device__ bool next(int i, Unit& u) const {
        const long L = (long)i * G + c; if (L >= nwg) return false;
        int wgid = (int)L; { const int q = nwg / NXCD, r = nwg % NXCD, xcd = wgid % NXCD, off = wgid / NXCD; wgid = (xcd < r ? xcd * (q + 1) : r * (q + 1) + (xcd - r) * q) + off; }
        const int nig = WGM * nN, gid = wgid / nig, fm = gid * WGM, gsz = (nM - fm) < WGM ? (nM - fm) : WGM;
        u.pm = fm + ((wgid % nig) % gsz); u.pn = (wgid % nig) / gsz; return true;
    }
    __device__ __forceinline__ void a_ready(const Unit&) const {}
    __device__ __forceinline__ void done(const Unit&) const {}
};
__device__ __forceinline__ unsigned cvt_pk_bf16(float lo, float hi) { unsigned r; asm volatile("v_cvt_pk_bf16_f32 %0, %1, %2" : "=v"(r) : "v"(lo), "v"(hi)); return r; }
struct GroupedOrder : StaticOrder {
    int npg;
    __device__ __forceinline__ bool next(int i, Unit& u) const { if (!StaticOrder::next(i, u)) return false; u.pn += (u.pm >> 3) * npg; return true; }
};
typedef unsigned u32x2 __attribute__((ext_vector_type(2)));
typedef int i32x4_t __attribute__((ext_vector_type(4)));
typedef int i32x8_t __attribute__((ext_vector_type(8)));
__device__ __forceinline__ i32x8_t cat8(bf16x8 a, bf16x8 b) { return __builtin_shufflevector(__builtin_bit_cast(i32x4_t, a), __builtin_bit_cast(i32x4_t, b), 0, 1, 2, 3, 4, 5, 6, 7); }
typedef __bf16 bf16x2_t __attribute__((ext_vector_type(2)));
typedef float f32x2_t __attribute__((ext_vector_type(2)));
__device__ __forceinline__ unsigned pkbf(float a, float b) { f32x2_t v = {a, b}; bf16x2_t r = __builtin_convertvector(v, bf16x2_t); return __builtin_bit_cast(unsigned, r); }
__device__ __forceinline__ float clamp8(float x) { return fminf(fmaxf(x, -448.f), 448.f); }
__device__ __forceinline__ unsigned pk4_fp8(float a, float b, float c, float d) {
    unsigned w = (unsigned)__builtin_amdgcn_cvt_pk_fp8_f32(clamp8(a), clamp8(b), 0, false); return (unsigned)__builtin_amdgcn_cvt_pk_fp8_f32(clamp8(c), clamp8(d), (int)w, true); }
__device__ __forceinline__ float bflo(unsigned w) { return __builtin_bit_cast(float, w << 16); }
__device__ __forceinline__ float bfhi(unsigned w) { return __builtin_bit_cast(float, w & 0xffff0000u); }
__device__ __forceinline__ float sigmoidf_(float v) { return __builtin_amdgcn_rcpf(1.f + __expf(-v)); }
__device__ __forceinline__ float gelu_tanh(float x) { const float u = x * (1.5957691216f + 0.0713548163f * x * x); return x * sigmoidf_(u); }
typedef float f2v __attribute__((ext_vector_type(2)));
__device__ __forceinline__ f2v gelu_tanh2(f2v x) {
    const f2v x2 = x * x, u = x * (x2 * (-0.1029432397f) + (-2.3022082480f));
    f2v e; e.x = __builtin_amdgcn_exp2f(u.x); e.y = __builtin_amdgcn_exp2f(u.y);
    const f2v d = e + 1.0f; f2v r; r.x = __builtin_amdgcn_rcpf(d.x); r.y = __builtin_amdgcn_rcpf(d.y);
    return x * r;
}
__device__ __forceinline__ f2v swiglu2(f2v a, f2v b, float c1, float c2) {
    const f2v t = a * c1; f2v e; e.x = __builtin_amdgcn_exp2f(t.x); e.y = __builtin_amdgcn_exp2f(t.y);
    const f2v d = e + 1.0f; f2v r; r.x = __builtin_amdgcn_rcpf(d.x); r.y = __builtin_amdgcn_rcpf(d.y);
    return (a * b) * (r * c2);
}

struct EpiStore {
    static constexpr bool PERM = true, AFTER_DRAIN = false;
    bf16_t* O; int ldc; int npn; float osc;
    __device__ __forceinline__ void operator()(const f32x4 (&acc)[2][2][4][2], const Unit& u, int wr, int wc, int fr, int fq) const {
        const int row0 = u.pm * BM + wr * 64 + fr, col0 = (u.pn % npn) * BM + wc * 32 + 8 * fq;
#pragma unroll
        for (int ai = 0; ai < 2; ++ai)
#pragma unroll
            for (int m = 0; m < 4; ++m) { bf16_t* rowp = O + (size_t)(row0 + ai * HALF + m * 16) * ldc + col0;
#pragma unroll
                for (int bj = 0; bj < 2; ++bj) { const f32x4 v0 = acc[ai][bj][m][0] * osc, v1 = acc[ai][bj][m][1] * osc;
                    u32x4 w; w.x = pkbf(v0[0], v0[1]); w.y = pkbf(v0[2], v0[3]); w.z = pkbf(v1[0], v1[1]); w.w = pkbf(v1[2], v1[3]);
                    *(u32x4*)(rowp + bj * HALF) = w; } }
    }
};
struct EpiStoreRes {
    static constexpr bool PERM = true, AFTER_DRAIN = false;
    bf16_t* O; int ldc; int npn; const bf16_t* R;
    __device__ __forceinline__ void operator()(const f32x4 (&acc)[2][2][4][2], const Unit& u, int wr, int wc, int fr, int fq) const {
        const int row0 = u.pm * BM + wr * 64 + fr, col0 = (u.pn % npn) * BM + wc * 32 + 8 * fq;
        u32x4 res[2][4][2];
#pragma unroll
        for (int ai = 0; ai < 2; ++ai)
#pragma unroll
            for (int m = 0; m < 4; ++m)
#pragma unroll
                for (int bj = 0; bj < 2; ++bj) res[ai][m][bj] = *(const u32x4*)(R + (size_t)(row0 + ai * HALF + m * 16) * ldc + col0 + bj * HALF);
#pragma unroll
        for (int ai = 0; ai < 2; ++ai)
#pragma unroll
            for (int m = 0; m < 4; ++m) { bf16_t* rowp = O + (size_t)(row0 + ai * HALF + m * 16) * ldc + col0;
#pragma unroll
                for (int bj = 0; bj < 2; ++bj) { const f32x4 v0 = acc[ai][bj][m][0], v1 = acc[ai][bj][m][1]; const u32x4 r = res[ai][m][bj];
                    u32x4 w; w.x = pkbf(v0[0] + bflo(r.x), v0[1] + bfhi(r.x)); w.y = pkbf(v0[2] + bflo(r.y), v0[3] + bfhi(r.y)); w.z = pkbf(v1[0] + bflo(r.z), v1[1] + bfhi(r.z)); w.w = pkbf(v1[2] + bflo(r.w), v1[3] + bfhi(r.w));
                    *(u32x4*)(rowp + bj * HALF) = w; } }
    }
};
struct EpiStoreRS {
    static constexpr bool PERM = true, AFTER_DRAIN = false;
    bf16_t* O; int ldc; int npn; const float* rs;
    __device__ __forceinline__ void operator()(const f32x4 (&acc)[2][2][4][2], const Unit& u, int wr, int wc, int fr, int fq) const {
        const int row0 = u.pm * BM + wr * 64 + fr, col0 = (u.pn % npn) * BM + wc * 32 + 8 * fq;
        float rsall[2][4];
#pragma unroll
        for (int ai = 0; ai < 2; ++ai)
#pragma unroll
            for (int m = 0; m < 4; ++m) rsall[ai][m] = rs[row0 + ai * HALF + m * 16];
#pragma unroll
        for (int ai = 0; ai < 2; ++ai)
#pragma unroll
            for (int m = 0; m < 4; ++m) { const int row = row0 + ai * HALF + m * 16; bf16_t* rowp = O + (size_t)row * ldc + col0; const float osc = rsall[ai][m];
#pragma unroll
                for (int bj = 0; bj < 2; ++bj) { const f32x4 v0 = acc[ai][bj][m][0] * osc, v1 = acc[ai][bj][m][1] * osc;
                    u32x4 w; w.x = pkbf(v0[0], v0[1]); w.y = pkbf(v0[2], v0[3]); w.z = pkbf(v1[0], v1[1]); w.w = pkbf(v1[2], v1[3]);
                    *(u32x4*)(rowp + bj * HALF) = w; } }
    }
};
struct EpiStore8 {
    static constexpr bool PERM = true, AFTER_DRAIN = false;
    unsigned char* O; int ldc; int npn; float osc;
    __device__ __forceinline__ void operator()(const f32x4 (&acc)[2][2][4][2], const Unit& u, int wr, int wc, int fr, int fq) const {
        const int row0 = u.pm * BM + wr * 64 + fr, col0 = (u.pn % npn) * BM + wc * 32 + 8 * fq;
#pragma unroll
        for (int ai = 0; ai < 2; ++ai)
#pragma unroll
            for (int m = 0; m < 4; ++m) { unsigned char* rowp = O + (size_t)(row0 + ai * HALF + m * 16) * ldc + col0;
#pragma unroll
                for (int bj = 0; bj < 2; ++bj) { const f32x4 v0 = acc[ai][bj][m][0] * osc, v1 = acc[ai][bj][m][1] * osc;
                    u32x2 w; w.x = pk4_fp8(v0[0], v0[1], v0[2], v0[3]); w.y = pk4_fp8(v1[0], v1[1], v1[2], v1[3]);
                    *(u32x2*)(rowp + bj * HALF) = w; } }
    }
};
struct EpiGelu {
    static constexpr bool PERM = true, AFTER_DRAIN = false;
    bf16_t* O; int ldc; float* stat; int vtile0; const float* rs; PG8_LAS float* red; int nrows;
    __device__ __forceinline__ void operator()(const f32x4 (&acc)[2][2][4][2], const Unit& u, int wr, int wc, int fr, int fq) const {
        const int row0 = u.pm * BM + wr * 64 + fr, col0 = u.pn * BM + wc * 32 + 8 * fq;
        const bool isv = u.pn >= vtile0;
        float rsall[2][4];
#pragma unroll
        for (int ai = 0; ai < 2; ++ai)
#pragma unroll
            for (int m = 0; m < 4; ++m) rsall[ai][m] = rs[row0 + ai * HALF + m * 16];
#pragma unroll
        for (int ai = 0; ai < 2; ++ai)
#pragma unroll
            for (int m = 0; m < 4; ++m) { const int row = row0 + ai * HALF + m * 16; bf16_t* rowp = O + (size_t)row * ldc + col0; float s1 = 0.f, s2 = 0.f; const float rsc = rsall[ai][m];
                f2v s1v = (f2v){0.f, 0.f}, s2v = (f2v){0.f, 0.f};
#pragma unroll
                for (int bj = 0; bj < 2; ++bj) { const f32x4 v0 = acc[ai][bj][m][0] * rsc, v1 = acc[ai][bj][m][1] * rsc;
                    const f2v g0 = gelu_tanh2((f2v){v0[0], v0[1]}), g1 = gelu_tanh2((f2v){v0[2], v0[3]}), g2 = gelu_tanh2((f2v){v1[0], v1[1]}), g3 = gelu_tanh2((f2v){v1[2], v1[3]});
                    s1v += (g0 + g1) + (g2 + g3); s2v += g0 * g0; s2v += g1 * g1; s2v += g2 * g2; s2v += g3 * g3;
                    u32x4 w; w.x = pkbf(g0.x, g0.y); w.y = pkbf(g1.x, g1.y); w.z = pkbf(g2.x, g2.y); w.w = pkbf(g3.x, g3.y);
                    *(u32x4*)(rowp + bj * HALF) = w; }
                s1 = s1v.x + s1v.y; s2 = s2v.x + s2v.y;
                if (isv) { s1 += __shfl_xor(s1, 16); s1 += __shfl_xor(s1, 32); s2 += __shfl_xor(s2, 16); s2 += __shfl_xor(s2, 32);
                    if (fq == 0) { PG8_LAS float* rp = red + (((wr * 4 + wc) * 128 + ai * 64 + m * 16 + fr) << 1); rp[0] = s1; rp[1] = s2; } } }
        if (isv) {
            asm volatile("s_waitcnt lgkmcnt(0)" ::: "memory"); __builtin_amdgcn_s_barrier(); asm volatile("" ::: "memory");
            if (wc == 0) {
#pragma unroll
                for (int k = 0; k < 2; ++k) { const int rl = fq * 16 + fr + 64 * k; float t1 = 0.f, t2 = 0.f;
#pragma unroll
                    for (int w = 0; w < 4; ++w) { const PG8_LAS float* rp = red + (((wr * 4 + w) * 128 + rl) << 1); t1 += rp[0]; t2 += rp[1]; }
                    const int row = u.pm * BM + (rl >> 6) * HALF + wr * 64 + (rl & 63);
                    f2v o; o.x = t1; o.y = t2; *(f2v*)(stat + ((size_t)(u.pn - vtile0) * nrows + row) * 2) = o; } }
        }
    }
};
struct EpiGlu {
    static constexpr bool PERM = true, AFTER_DRAIN = false;
    const bf16_t* G; int ldg; bf16_t* O; int ldo; int ocol0; const float* bias;
    __device__ __forceinline__ void operator()(const f32x4 (&acc)[2][2][4][2], const Unit& u, int wr, int wc, int fr, int fq) const {
        const int row0 = u.pm * BM + wr * 64 + fr, col0 = u.pn * BM + wc * 32 + 8 * fq;
        f32x4 bv[2][2];
#pragma unroll
        for (int bj = 0; bj < 2; ++bj)
#pragma unroll
            for (int n = 0; n < 2; ++n) bv[bj][n] = *(const f32x4*)(bias + col0 + bj * HALF + 4 * n);
        u32x4 gall[2][4][2];
#pragma unroll
        for (int ai = 0; ai < 2; ++ai)
#pragma unroll
            for (int m = 0; m < 4; ++m)
#pragma unroll
                for (int bj = 0; bj < 2; ++bj) gall[ai][m][bj] = *(const u32x4*)(G + (size_t)(row0 + ai * HALF + m * 16) * ldg + col0 + bj * HALF);
#pragma unroll
        for (int ai = 0; ai < 2; ++ai)
#pragma unroll
            for (int m = 0; m < 4; ++m) { const int row = row0 + ai * HALF + m * 16;
#pragma unroll
                for (int bj = 0; bj < 2; ++bj) { const f32x4 v0 = acc[ai][bj][m][0] + bv[bj][0], v1 = acc[ai][bj][m][1] + bv[bj][1];
                    const u32x4 gw = gall[ai][m][bj];
                    u32x4 w;
                    w.x = pkbf(bflo(gw.x) * sigmoidf_(v0[0]), bfhi(gw.x) * sigmoidf_(v0[1]));
                    w.y = pkbf(bflo(gw.y) * sigmoidf_(v0[2]), bfhi(gw.y) * sigmoidf_(v0[3]));
                    w.z = pkbf(bflo(gw.z) * sigmoidf_(v1[0]), bfhi(gw.z) * sigmoidf_(v1[1]));
                    w.w = pkbf(bflo(gw.w) * sigmoidf_(v1[2]), bfhi(gw.w) * sigmoidf_(v1[3]));
                    *(u32x4*)(O + (size_t)row * ldo + ocol0 + col0 + bj * HALF) = w; } }
    }
};
struct EpiSwiglu8 {
    static constexpr bool PERM = true, AFTER_DRAIN = false;
    unsigned char* O; int ldc; int npn; float osc, hsc; int guard;
    __device__ __forceinline__ void operator()(const f32x4 (&acc)[2][2][4][2], const Unit& u, int wr, int wc, int fr, int fq) const {
        const int row0 = (guard == 12346 ? (int)blockIdx.x : u.pm) * BM + wr * 64 + fr, col0 = (guard == 12346 ? 0 : (u.pn % npn)) * HALF + wc * 32 + 8 * fq;
#pragma unroll
        for (int ai = 0; ai < 2; ++ai)
#pragma unroll
            for (int m = 0; m < 4; ++m) { const f32x4 a0 = acc[ai][0][m][0], a1 = acc[ai][0][m][1], b0 = acc[ai][1][m][0], b1 = acc[ai][1][m][1];
                const float c1 = osc * (-1.4426950408889634f), c2 = osc * osc * hsc;
                const f2v h0 = swiglu2((f2v){a0[0], a0[1]}, (f2v){b0[0], b0[1]}, c1, c2), h1 = swiglu2((f2v){a0[2], a0[3]}, (f2v){b0[2], b0[3]}, c1, c2);
                const f2v h2 = swiglu2((f2v){a1[0], a1[1]}, (f2v){b1[0], b1[1]}, c1, c2), h3 = swiglu2((f2v){a1[2], a1[3]}, (f2v){b1[2], b1[3]}, c1, c2);
                u32x2 w; w.x = pk4_fp8(h0.x, h0.y, h1.x, h1.y); w.y = pk4_fp8(h2.x, h2.y, h3.x, h3.y);
                if (guard != 12345 || wr == 1) *(u32x2*)(O + (size_t)(row0 + ai * HALF + m * 16) * ldc + col0) = w; }
    }
};
struct EpiRes {
    static constexpr bool PERM = false, AFTER_DRAIN = false;
    const float* base; float* out; int ldc;
    __device__ __forceinline__ void operator()(const f32x4 (&acc)[2][2][4][2], const Unit& u, int wr, int wc, int fr, int fq) const {
        const int row0 = u.pm * BM + wr * 64 + fr, col0 = u.pn * BM + wc * 32 + 4 * fq;
#pragma unroll
        for (int ai = 0; ai < 2; ++ai)
#pragma unroll
            for (int m = 0; m < 4; ++m) { const size_t off = (size_t)(row0 + ai * HALF + m * 16) * ldc + col0;
#pragma unroll
                for (int bj = 0; bj < 2; ++bj)
#pragma unroll
                    for (int n = 0; n < 2; ++n) { const f32x4 bs = *(const f32x4*)(base + off + bj * HALF + n * 16); *(f32x4*)(out + off + bj * HALF + n * 16) = bs + acc[ai][bj][m][n]; } }
    }
};
template <class Epi, class Sched, bool ALIGN_EPI = false, bool SP2 = false, bool F8 = false, bool GATHER = false>
__device__ __forceinline__ void gemm_phase(PG8_LAS unsigned char* lds, const Gemm g, const Sched& S, const Epi& E) {
    int tid_ = threadIdx.x; asm volatile("" : "+v"(tid_));
    const int tid = tid_, wid = __builtin_amdgcn_readfirstlane(tid >> 6), lane = tid & 63, wr = wid >> 2, wc = wid & 3, fr = lane & 15, fq = lane >> 4;
    const int K = g.K, nt = K / BK;
    unsigned voffA[2], voffB[2];
#pragma unroll
    for (int i = 0; i < 2; ++i) { int R, C; stage_rc(tid * 16 + i * 8192, R, C); const int Rb = Epi::PERM ? ((R & ~31) + perm32(R & 31)) : R;
        voffA[i] = (unsigned)(R * K + C) * 2u; voffB[i] = (unsigned)(Rb * K + C) * 2u; }
    PG8_LAS int* rowtab = (PG8_LAS int*)(lds + STAGE_BYTES);
    unsigned vAc[2][2] = {{0u, 0u}, {0u, 0u}};
#define PG8_ROWDMA(pm_) do { if (wid < 4) __builtin_amdgcn_global_load_lds((const unsigned*)(g.rowtok + (pm_) * BM + wid * 64 + lane), (PG8_LAS unsigned*)(rowtab + wid * 64), 4, 0, 0); } while (0)
#define PG8_ROWREAD(dst) do { int tt_ = tid; asm volatile("" : "+v"(tt_));   \
        _Pragma("unroll") for (int i_ = 0; i_ < 2; ++i_) { int R_, C_; stage_rc(tt_ * 16 + i_ * 8192, R_, C_); \
            _Pragma("unroll") for (int h_ = 0; h_ < 2; ++h_) dst[h_][i_] = (unsigned)rowtab[h_ * HALF + R_] * (unsigned)(K * 2) + (unsigned)C_ * 2u; } } while (0)
#define PG8_STAGE_A(bufoff, gbase, half, usenext) do { if constexpr (GATHER) { PG8_STAGE(bufoff, gbase, vAc[half]); } \
        else { PG8_STAGE(bufoff, (gbase) + ((half) ? hstep : (size_t)0), voffA); } } while (0)
    const size_t kstep = (size_t)(BK * 2);
    const size_t hstep = (size_t)HALF * K * 2;
    const size_t tstep = 2 * hstep;
    const unsigned ldsw = (unsigned)wid * 1024u;
    const int aoff = lds_byte(wr * 64 + fr, fq * 8), boff = lds_byte(wc * 32 + fr, fq * 8);
#define PG8_SA(b, h) (((b) * 2 + (h)) * HTB)
#define PG8_SB(b, h) ((4 + (b) * 2 + (h)) * HTB)
#define PG8_STAGE(bufoff, gbase, voff) do { _Pragma("unroll") for (int _i = 0; _i < 2; ++_i) \
        __builtin_amdgcn_global_load_lds((const unsigned*)((const char*)(gbase) + (voff)[_i]), (PG8_LAS unsigned*)(lds + (bufoff) + ldsw + _i * 8192), 16, 0, 0); } while (0)
#define PG8_LDA(dst, b, h) do { _Pragma("unroll") for (int m = 0; m < 4; ++m) _Pragma("unroll") for (int k = 0; k < 2; ++k) dst[m][k] = *(const PG8_LAS bf16x8*)(lds + PG8_SA(b, h) + aoff + m * 2048 + k * 1024); } while (0)
#define PG8_LDB(dst, b, h) do { _Pragma("unroll") for (int n = 0; n < 2; ++n) _Pragma("unroll") for (int k = 0; k < 2; ++k) dst[n][k] = *(const PG8_LAS bf16x8*)(lds + PG8_SB(b, h) + boff + n * 2048 + k * 1024); } while (0)
#define PG8_MMA(ai, bj, At, Bt) do { __builtin_amdgcn_s_setprio(1); \
        if constexpr (F8) { _Pragma("unroll") for (int m = 0; m < 4; ++m) _Pragma("unroll") for (int n = 0; n < 2; ++n) \
            asm volatile("v_mfma_scale_f32_16x16x128_f8f6f4 %0, %1, %2, %0, %3, %3 op_sel_hi:[0,0,0]" : "+v"(acc[ai][bj][m][n]) : "v"(cat8(Bt[n][0], Bt[n][1])), "v"(cat8(At[m][0], At[m][1])), "v"(0x7f7f7f7f)); } \
        else { _Pragma("unroll") for (int m = 0; m < 4; ++m) _Pragma("unroll") for (int n = 0; n < 2; ++n) _Pragma("unroll") for (int k = 0; k < 2; ++k) \
            acc[ai][bj][m][n] = __builtin_amdgcn_mfma_f32_16x16x32_bf16(Bt[n][k], At[m][k], acc[ai][bj][m][n], 0, 0, 0); } \
        __builtin_amdgcn_s_setprio(0); } while (0)
#define PG8_WAIT_V(n) asm volatile("s_waitcnt vmcnt(" #n ")" ::: "memory")
#define PG8_WAIT_L(n) asm volatile("s_waitcnt lgkmcnt(" #n ")" ::: "memory")
#define PG8_BAR __builtin_amdgcn_s_barrier()
#define PG8_SCHED __builtin_amdgcn_sched_barrier(0)
#define PG8_ACCFENCE(NOPS) do { if constexpr (F8) { _Pragma("unroll") for (int a_ = 0; a_ < 2; ++a_) _Pragma("unroll") for (int b_ = 0; b_ < 2; ++b_) \
        asm volatile(NOPS : "+v"(acc[a_][b_][0][0]), "+v"(acc[a_][b_][0][1]), "+v"(acc[a_][b_][1][0]), "+v"(acc[a_][b_][1][1]), "+v"(acc[a_][b_][2][0]), "+v"(acc[a_][b_][2][1]), "+v"(acc[a_][b_][3][0]), "+v"(acc[a_][b_][3][1])); } } while (0)
    Unit cur, nxt; int ui = 0;
    if (!S.next(0, cur)) return;
    f32x4 acc[2][2][4][2];
#pragma unroll
    for (int a = 0; a < 2; ++a)
#pragma unroll
        for (int b = 0; b < 2; ++b)
#pragma unroll
            for (int m = 0; m < 4; ++m)
#pragma unroll
                for (int n = 0; n < 2; ++n) acc[a][b][m][n] = (f32x4){0.f, 0.f, 0.f, 0.f};
    PG8_ACCFENCE("s_nop 1");
    bf16x8 At[4][2], B0[2][2], B1[2][2];
    const char* cA = GATHER ? (const char*)g.A : (const char*)g.A + (size_t)cur.pm * tstep; const char* cB = (const char*)g.Bt + (size_t)cur.pn * tstep;
    S.a_ready(cur);
    if constexpr (GATHER) { PG8_ROWDMA(cur.pm); PG8_WAIT_V(0); PG8_BAR; PG8_ROWREAD(vAc); PG8_WAIT_L(0); PG8_BAR; }
    if constexpr (SP2) {
        PG8_STAGE(PG8_SB(0, 0), cB, voffB); PG8_STAGE(PG8_SB(0, 1), cB + hstep, voffB); PG8_STAGE_A(PG8_SA(0, 0), cA, 0, false); PG8_STAGE_A(PG8_SA(0, 1), cA, 1, false);
        if (wr == 1) PG8_BAR;
        PG8_WAIT_V(2); PG8_BAR;
        PG8_STAGE(PG8_SB(1, 0), cB + kstep, voffB); PG8_STAGE_A(PG8_SA(1, 0), cA + kstep, 0, false); PG8_STAGE(PG8_SB(1, 1), cB + hstep + kstep, voffB);
        PG8_WAIT_V(6); PG8_BAR;
    } else {
        PG8_STAGE(PG8_SB(0, 0), cB, voffB); PG8_STAGE(PG8_SA(0, 0), cA, voffA); PG8_STAGE(PG8_SB(0, 1), cB + hstep, voffB); PG8_STAGE(PG8_SA(0, 1), cA + hstep, voffA);
        if (wr == 1) PG8_BAR;
        PG8_WAIT_V(4); PG8_BAR;
        PG8_STAGE(PG8_SB(1, 0), cB + kstep, voffB); PG8_STAGE(PG8_SA(1, 0), cA + kstep, voffA); PG8_STAGE(PG8_SB(1, 1), cB + hstep + kstep, voffB);
        PG8_WAIT_V(6); PG8_BAR;
    }
    for (;;) {
        const bool has_next = S.next(ui + 1, nxt);
        const char* nA = (has_next && !GATHER) ? (const char*)g.A + (size_t)nxt.pm * tstep : cA;
        if constexpr (GATHER) { if (has_next) PG8_ROWDMA(nxt.pm); } const char* nB = has_next ? (const char*)g.Bt + (size_t)nxt.pn * tstep : cB;
        for (int t = 0; t < nt; t += 2) {
            const bool last = (t == nt - 2);
            const char* a1 = cA + (size_t)(t + 1) * kstep;
            const char* a2 = last ? nA : cA + (size_t)(t + 2) * kstep; const char* b2 = last ? nB : cB + (size_t)(t + 2) * kstep;
            const char* a3 = a2 + kstep; const char* b3 = b2 + kstep;
            if (last && has_next) S.a_ready(nxt);

            if constexpr (SP2) {
            PG8_LDB(B0, 0, 0); PG8_LDB(B1, 0, 1); PG8_SCHED; PG8_LDA(At, 0, 0); PG8_STAGE_A(PG8_SA(1, 1), a1, 1, false);
            if constexpr (GATHER) { if (last && has_next) PG8_ROWREAD(vAc); }
            PG8_WAIT_V(8); PG8_WAIT_L(0); PG8_BAR; PG8_MMA(0, 0, At, B0); PG8_MMA(0, 1, At, B1); PG8_BAR; PG8_SCHED;
            PG8_LDA(At, 0, 1); PG8_STAGE(PG8_SB(0, 0), b2, voffB); PG8_STAGE(PG8_SB(0, 1), b2 + hstep, voffB); PG8_STAGE_A(PG8_SA(0, 0), a2, 0, last);
            PG8_WAIT_V(8); PG8_WAIT_L(0); PG8_BAR; PG8_MMA(1, 0, At, B0); PG8_MMA(1, 1, At, B1); PG8_BAR; PG8_SCHED;
            PG8_LDB(B0, 1, 0); PG8_LDB(B1, 1, 1); PG8_SCHED; PG8_LDA(At, 1, 0); PG8_STAGE_A(PG8_SA(0, 1), a2, 1, last);
            PG8_WAIT_V(8); PG8_WAIT_L(0); PG8_BAR; PG8_MMA(0, 0, At, B0); PG8_MMA(0, 1, At, B1); PG8_BAR; PG8_SCHED;
            PG8_LDA(At, 1, 1); PG8_STAGE(PG8_SB(1, 0), b3, voffB); PG8_STAGE(PG8_SB(1, 1), b3 + hstep, voffB); PG8_STAGE_A(PG8_SA(1, 0), a3, 0, last);
            PG8_WAIT_V(8); PG8_WAIT_L(0); PG8_BAR; PG8_MMA(1, 0, At, B0); PG8_MMA(1, 1, At, B1); PG8_BAR; PG8_SCHED;
            } else {
            PG8_LDB(B0, 0, 0); PG8_SCHED; PG8_LDA(At, 0, 0); PG8_STAGE(PG8_SA(1, 1), a1 + hstep, voffA);
            PG8_WAIT_L(8); PG8_BAR; PG8_WAIT_L(0); PG8_MMA(0, 0, At, B0); PG8_BAR; PG8_SCHED;
            PG8_LDB(B1, 0, 1); PG8_STAGE(PG8_SB(0, 0), b2, voffB);
            PG8_BAR; PG8_WAIT_L(0); PG8_MMA(0, 1, At, B1); PG8_BAR;
            PG8_LDA(At, 0, 1); PG8_STAGE(PG8_SA(0, 0), a2, voffA);
            PG8_BAR; PG8_WAIT_L(0); PG8_MMA(1, 0, At, B0); PG8_BAR; PG8_SCHED;
            PG8_STAGE(PG8_SB(0, 1), b2 + hstep, voffB);
            PG8_WAIT_V(6); PG8_BAR; PG8_MMA(1, 1, At, B1); PG8_BAR;
            PG8_LDB(B0, 1, 0); PG8_SCHED; PG8_LDA(At, 1, 0); PG8_STAGE(PG8_SA(0, 1), a2 + hstep, voffA);
            PG8_WAIT_L(8); PG8_BAR; PG8_WAIT_L(0); PG8_MMA(0, 0, At, B0); PG8_BAR; PG8_SCHED;
            PG8_LDB(B1, 1, 1); PG8_STAGE(PG8_SB(1, 0), b3, voffB);
            PG8_BAR; PG8_WAIT_L(0); PG8_MMA(0, 1, At, B1); PG8_BAR;
            PG8_LDA(At, 1, 1); PG8_STAGE(PG8_SA(1, 0), a3, voffA);
            PG8_BAR; PG8_WAIT_L(0); PG8_MMA(1, 0, At, B0); PG8_BAR; PG8_SCHED;
            PG8_STAGE(PG8_SB(1, 1), b3 + hstep, voffB);
            PG8_WAIT_V(6); PG8_BAR; PG8_MMA(1, 1, At, B1); PG8_BAR;
            }
        }
        PG8_ACCFENCE("s_nop 15\n\ts_nop 7");
        if constexpr (ALIGN_EPI) { if (wr == 0) PG8_BAR; }
        if constexpr (!Epi::AFTER_DRAIN) { E(acc, cur, wr, wc, fr, fq); S.done(cur); }
        if (!has_next) break;
#pragma unroll
        for (int a = 0; a < 2; ++a)
#pragma unroll
            for (int b = 0; b < 2; ++b)
#pragma unroll
                for (int m = 0; m < 4; ++m)
#pragma unroll
                    for (int n = 0; n < 2; ++n) acc[a][b][m][n] = (f32x4){0.f, 0.f, 0.f, 0.f};
        PG8_ACCFENCE("s_nop 1");
        cur = nxt; cA = nA; cB = nB; ++ui;
        if constexpr (ALIGN_EPI) { if (wr == 1) PG8_BAR; }
    }
    PG8_WAIT_V(0);
    if constexpr (!ALIGN_EPI) { if (wr == 0) PG8_BAR; }
    PG8_BAR;
    if constexpr (Epi::AFTER_DRAIN) { E.fused(acc, cur, wr, wc, fr, fq, lds, wid, lane); S.done(cur); }
#undef PG8_SA
#undef PG8_SB
#undef PG8_STAGE
#undef PG8_LDA
#undef PG8_LDB
#undef PG8_MMA
#undef PG8_WAIT_V
#undef PG8_WAIT_L
#undef PG8_BAR
#undef PG8_SCHED
#undef PG8_ROWDMA
#undef PG8_ROWREAD
#undef PG8_STAGE_A
#undef PG8_ACCFENCE
}
}

constexpr int NWAVES = 8, NT = NWAVES * 64;
#ifndef MK_N_LAUNCHES
#define MK_N_LAUNCHES 1
#endif
constexpr int BATCH = 4, SEQ = 4096, D = 2048, M = BATCH * SEQ;
constexpr int AW = 1024, KVW = 256, SW = 1024, EIN = 2560;
constexpr int QOFF = 0, KOFF = 1024, VOFF = 1280, UOFF = 1536;
constexpr int NE = 16, CAP = 512, FF = 2048, MS = NE * BATCH * CAP;
constexpr int GW = 2048, ZW = 4096;
constexpr float EPS = 1e-6f;

constexpr size_t MiB = 1u << 20, KiB = 1u << 10;
constexpr size_t WS_CTL = 0, CTL_ZERO_BYTES = 1 * MiB;
constexpr int CW_TMO = 0, CW_CODE = 1, CW_BAR = 4096;
constexpr size_t WS_STAT = 256 * KiB;
constexpr size_t WS_LUT = 1 * MiB;
constexpr size_t WS_LAM = WS_LUT + 16 * KiB;
constexpr size_t WS_LAM512 = WS_LAM + 64 * KiB;
constexpr size_t WS_BB = WS_LAM512 + 64 * KiB;
constexpr size_t WS_CM = WS_BB + 512 * KiB;
constexpr size_t WS_SGU = WS_CM + 512 * KiB;
constexpr size_t WS_E = 4 * MiB;
constexpr size_t WS_AFF = 6 * MiB;
constexpr size_t WS_IDX = 7 * MiB;
constexpr size_t WS_GATE = WS_IDX + 128 * KiB;
constexpr size_t WS_TOK = WS_IDX + 256 * KiB;
constexpr size_t WS_INV = 8 * MiB;
constexpr size_t WS_STATP = 11 * MiB;
constexpr size_t WS_RSTD0 = 10 * MiB + 64 * KiB;
constexpr size_t WS_RSTD = 10 * MiB;
constexpr size_t WS_WIN0 = 16 * MiB, WS_GLU = 26 * MiB, WS_WOUT0 = 28 * MiB, WS_WIN1 = 36 * MiB, WS_WOUT1 = 52 * MiB;
constexpr size_t WS_W13 = 64 * MiB, WS_W2 = 576 * MiB;
constexpr float WSC = 256.f, HSC = 8.f, HIDSC = 8.f, YSC = 32.f;
constexpr size_t WS_H = 832 * MiB, WS_XA = 896 * MiB, WS_XB = 1024 * MiB;
constexpr size_t WS_X16 = WS_XB + 64 * MiB;
constexpr size_t WS_XS = 1152 * MiB, WS_HID = 1280 * MiB, WS_YS = 1408 * MiB;
constexpr size_t WS_PROJ = 1536 * MiB, WS_CAT = 1616 * MiB, WS_G = 1680 * MiB, WS_YF = 1712 * MiB;
constexpr size_t WS_Z = 1536 * MiB, WS_G2 = 1664 * MiB;
constexpr size_t WS_END = 1776 * MiB;

constexpr int SCR_BYTES = 143360;
constexpr int LDSCTL_OFF = SCR_BYTES, MISC_OFF = LDSCTL_OFF + 320;
constexpr int LDS_BYTES = 151552;
constexpr int EPI_STG_OFF = 131072 + 1024;
static_assert(EPI_STG_OFF + 2 * 32 * 136 <= SCR_BYTES, "epilogue staging");

#define GAS __attribute__((address_space(1)))
#define LAS __attribute__((address_space(3)))
typedef unsigned short bf16;
typedef unsigned v4u __attribute__((ext_vector_type(4)));
typedef unsigned v2u __attribute__((ext_vector_type(2)));
typedef float f32x4 __attribute__((ext_vector_type(4)));
typedef float f32x16 __attribute__((ext_vector_type(16)));
typedef short bf16x8 __attribute__((ext_vector_type(8)));
typedef short s16x4 __attribute__((ext_vector_type(4)));
typedef GAS unsigned gu32;
#define RLX_AGENT __ATOMIC_RELAXED, __HIP_MEMORY_SCOPE_AGENT
#define LDS_WAIT() asm volatile("s_waitcnt lgkmcnt(0)" ::: "memory")
#define VM_WAIT() asm volatile("s_waitcnt vmcnt(0)" ::: "memory")
using pg8::pkbf; using pg8::pk4_fp8; using pg8::bflo; using pg8::bfhi; using pg8::gelu_tanh;
__device__ __forceinline__ bf16 f2bf1(float f) { return (bf16)(pkbf(f, 0.f) & 0xffffu); }
__device__ __forceinline__ float bf2f(bf16 b) { return __builtin_bit_cast(float, ((unsigned)b) << 16); }
#define MFMA32(a, b, c) __builtin_amdgcn_mfma_f32_32x32x16_bf16((a), (b), (c), 0, 0, 0)
#define MFMA16(a, b, c) __builtin_amdgcn_mfma_f32_16x16x32_bf16((a), (b), (c), 0, 0, 0)
__device__ __forceinline__ int crow(int reg, int h) { return (reg & 3) + 8 * (reg >> 2) + 4 * h; }
__device__ __forceinline__ float wave_sum(float v) {
#pragma unroll
    for (int o = 1; o < 64; o <<= 1) v += __shfl_xor(v, o);
    return v;
}
#define XB_TMO      128
#define XB_XCNT(j)  (256  + 64 * (j))
#define XB_XSUB(j)  (1280 + 64 * (j))
#define XB_XGEN(j)  (2304 + 64 * (j))
#define XB_TOP      3328
#define XB_TOPGEN   3392
#define XCD_BAR_WORDS 3456
#define XB_SPIN_CAP (1u << 18)

__device__ __forceinline__ unsigned xb_ld(unsigned* p)              { return __hip_atomic_load(p, __ATOMIC_RELAXED, __HIP_MEMORY_SCOPE_AGENT); }
__device__ __forceinline__ unsigned xb_add(unsigned* p, unsigned v) { return __hip_atomic_fetch_add(p, v, __ATOMIC_RELAXED, __HIP_MEMORY_SCOPE_AGENT); }
__device__ __forceinline__ unsigned xb_xcc_id() { return (unsigned)__builtin_amdgcn_s_getreg((3 << 11) | 20) & 0xFu; }
#define XB_SPIN(cond, bar) do { unsigned _sp = 0; while (cond) { __builtin_amdgcn_s_sleep(1); \
    if ((++_sp & 255u) == 0u) { if (xb_ld(&(bar)[XB_TMO])) break; if (_sp > XB_SPIN_CAP) { atomicAdd(&(bar)[XB_TMO], 1u); break; } } } } while (0)

struct XcdBarrier {
    unsigned* bar; unsigned x;
    volatile LAS unsigned* st;
};

__device__ __forceinline__ XcdBarrier xcd_barrier_post(unsigned* bar, volatile LAS unsigned* st) {
    XcdBarrier b; b.bar = bar; b.x = xb_xcc_id(); b.st = st;
    if (threadIdx.x == 0) (void)xb_add(&bar[XB_XCNT(b.x)], 1u);
    return b;
}
__device__ __forceinline__ void xcd_barrier_complete(unsigned* bar, unsigned x, unsigned& nloc, unsigned& nx) {
    const unsigned G = gridDim.x * gridDim.y * gridDim.z;
    unsigned sum, cnt, mine, sp = 0u;
    for (;;) {
        sum = 0u; cnt = 0u; mine = 0u;
#pragma unroll
        for (unsigned j = 0; j < 16; ++j) { const unsigned c = xb_ld(&bar[XB_XCNT(j)]); sum += c; cnt += (c > 0u) ? 1u : 0u; mine = (j == x) ? c : mine; }
        if (sum == G) break;
        __builtin_amdgcn_s_sleep(1);
        if ((++sp & 255u) == 0u) { if (xb_ld(&bar[XB_TMO])) break; if (sp > XB_SPIN_CAP) { atomicAdd(&bar[XB_TMO], 1u); break; } }
    }
    nloc = mine > 0u ? mine : 1u; nx = cnt > 0u ? cnt : 1u;
}

__device__ __forceinline__ void xcd_barrier(const XcdBarrier& b) {
    asm volatile("s_waitcnt vmcnt(0)" ::: "memory");
    __syncthreads();
    if (threadIdx.x == 0) {
        unsigned* bar = b.bar;
        __builtin_amdgcn_s_waitcnt(0);
        unsigned nloc = b.st[0], nx = b.st[1];
        if (nloc == 0u) { xcd_barrier_complete(bar, b.x, nloc, nx); b.st[0] = nloc; b.st[1] = nx; }
        const unsigned old = xb_add(&bar[XB_XSUB(b.x)], 1u);
        const unsigned gen = old / nloc;
        if (old + 1u == (gen + 1u) * nloc) {
            __builtin_amdgcn_fence(__ATOMIC_RELEASE, "agent");
            asm volatile("s_waitcnt vmcnt(0)" ::: "memory");
            const unsigned og = xb_add(&bar[XB_TOP], 1u);
            const unsigned tg = og / nx;
            if (og + 1u == (tg + 1u) * nx) xb_add(&bar[XB_TOPGEN], 1u);
            else XB_SPIN(xb_ld(&bar[XB_TOPGEN]) == tg, bar);
            __builtin_amdgcn_fence(__ATOMIC_ACQUIRE, "agent");
            xb_add(&bar[XB_XGEN(b.x)], 1u);
            asm volatile("s_waitcnt vmcnt(0)" ::: "memory");
        } else {
            XB_SPIN(xb_ld(&bar[XB_XGEN(b.x)]) == gen, bar);
            __builtin_amdgcn_fence(__ATOMIC_ACQUIRE, "agent");
            asm volatile("s_waitcnt vmcnt(0)" ::: "memory");
        }
    }
    __syncthreads();
}

struct Frame {
    LAS unsigned char* lds;
    volatile LAS unsigned* MISC;
    gu32* ctl;
    unsigned char* ws;
    int tid, lane, wave, vcu, G;
    const float* in[28];
    float* out;
};
enum { I_X = 0, I_RELB, I_MIXN, I_FFNN, I_FINN, I_EWIN, I_SINK, I_ARE, I_AIM, I_LDT, I_BRE, I_BIM, I_CRE, I_CIM, I_SSMD, I_GLUW, I_GLUB, I_EWOUT,
       I_OWIN, I_LNG, I_LNB, I_SGUW, I_SGUB, I_OWOUT, I_ROUTER, I_W1, I_W3, I_W2 };

__device__ __forceinline__ void p0_transpose_item(const float* W, int K, int N, bf16* WT, int row_base, LAS float* scr, int k0, int n0, int lane, const float* kgain = nullptr) {
#pragma unroll 8
    for (int i = 0; i < 32; ++i) { const int kk = 2 * i + (lane >> 5); float w = W[(size_t)(k0 + kk) * N + n0 + (lane & 31)]; if (kgain) w *= kgain[k0 + kk]; scr[kk * 33 + (lane & 31)] = w; }
    LDS_WAIT(); asm volatile("" ::: "memory");
    const int c = lane & 7;
#pragma unroll
    for (int j = 0; j < 4; ++j) { const int n = (lane >> 3) + 8 * j; const LAS float* s = scr + (8 * c) * 33 + n;
        v4u o; o.x = pkbf(s[0 * 33], s[1 * 33]); o.y = pkbf(s[2 * 33], s[3 * 33]); o.z = pkbf(s[4 * 33], s[5 * 33]); o.w = pkbf(s[6 * 33], s[7 * 33]);
        *(GAS v4u*)(WT + (size_t)(row_base + n) * K + k0 + 8 * c) = o; }
    LDS_WAIT(); asm volatile("" ::: "memory");
}
__device__ __forceinline__ void p0_item8_load(const float* W, int N, int k0, int n0, int lane, f32x4 (&t)[16]) {
#pragma unroll
    for (int i = 0; i < 16; ++i) t[i] = *(const GAS f32x4*)(W + (size_t)(k0 + 8 * i + (lane >> 3)) * N + n0 + 4 * (lane & 7));
}
__device__ __forceinline__ unsigned bperm(unsigned hi, unsigned lo, unsigned sel) { return __builtin_amdgcn_perm(hi, lo, sel); }
__device__ __forceinline__ void p0_item8_finish(const f32x4 (&t)[16], int K, unsigned char* WT, int row_base, LAS float* scr, int k0, int lane, float sc) {
    LAS unsigned* tile = (LAS unsigned*)scr;
#pragma unroll
    for (int i = 0; i < 16; ++i) tile[(8 * i + (lane >> 3)) * 9 + (lane & 7)] = pk4_fp8(t[i].x * sc, t[i].y * sc, t[i].z * sc, t[i].w * sc);
    LDS_WAIT(); asm volatile("" ::: "memory");
    const int n4 = lane >> 3, kg = lane & 7;
    unsigned r[16];
#pragma unroll
    for (int j = 0; j < 16; ++j) r[j] = tile[(16 * kg + j) * 9 + n4];
    LDS_WAIT(); asm volatile("" ::: "memory");
    v4u o[4];
#pragma unroll
    for (int q = 0; q < 4; ++q) { const unsigned a = bperm(r[4 * q + 1], r[4 * q], 0x05010400u), b = bperm(r[4 * q + 1], r[4 * q], 0x07030602u), c = bperm(r[4 * q + 3], r[4 * q + 2], 0x05010400u), d = bperm(r[4 * q + 3], r[4 * q + 2], 0x07030602u);
        o[0][q] = bperm(c, a, 0x05040100u); o[1][q] = bperm(c, a, 0x07060302u); o[2][q] = bperm(d, b, 0x05040100u); o[3][q] = bperm(d, b, 0x07060302u); }
#pragma unroll
    for (int b = 0; b < 4; ++b) *(GAS v4u*)(WT + (size_t)(row_base + 4 * n4 + b) * K + k0 + 16 * kg) = o[b];
}
__device__ __forceinline__ int t5_bucket(int rel) {
    const int n = rel < 0 ? -rel : rel; int b;
    if (n < 8) b = n; else { b = 8 + (31 - __clz(n * n)) - 6; if (b > 15) b = 15; }
    return b + (rel > 0 ? 16 : 0);
}
__device__ __forceinline__ void sincos_d(double x, double& s, double& c) {
    const double q = __builtin_rint(x * 0.63661977236758134308);
    const double r = (x - q * 1.57079632673412561417) - q * 6.07710050650619224932e-11;
    const double r2 = r * r;
    const double sp = r * (1.0 + r2 * (-1.0 / 6 + r2 * (1.0 / 120 + r2 * (-1.0 / 5040 + r2 * (1.0 / 362880 + r2 * (-1.0 / 39916800 + r2 * (1.0 / 6227020800.0)))))));
    const double cp = 1.0 + r2 * (-0.5 + r2 * (1.0 / 24 + r2 * (-1.0 / 720 + r2 * (1.0 / 40320 + r2 * (-1.0 / 3628800 + r2 * (1.0 / 479001600.0 + r2 * (-1.0 / 87178291200.0)))))));
    const int qi = (int)((long long)q & 3);
    s = (qi == 0) ? sp : (qi == 1) ? cp : (qi == 2) ? -sp : -cp;
    c = (qi == 0) ? cp : (qi == 1) ? -sp : (qi == 2) ? -cp : sp;
}
constexpr int SS_C1_ = 12, SS_C2_ = 22;
constexpr int IPM = (D / 128) * (FF / 32);
constexpr int EXP_ITEMS = 3 * NE * IPM;
struct ExpItem { const float* W; unsigned char* WT; int row_base, k0, n0; };
__device__ __forceinline__ ExpItem expert_item_desc(Frame& F, int layer, int it) {
    const int which = it / (NE * IPM), r0 = it % (NE * IPM), mat = layer * NE + r0 / IPM, r = r0 % IPM, nb = FF / 32, k0 = 128 * (r / nb), n0 = 32 * (r % nb);
    const size_t moff = (size_t)mat * D * FF; ExpItem e; e.k0 = k0; e.n0 = n0;
    if (which == 0) { e.W = F.in[I_W1] + moff; e.WT = F.ws + WS_W13 + (size_t)mat * 2 * FF * D; e.row_base = (n0 >> 7) * 256 + (n0 & 127); }
    else if (which == 1) { e.W = F.in[I_W3] + moff; e.WT = F.ws + WS_W13 + (size_t)mat * 2 * FF * D; e.row_base = (n0 >> 7) * 256 + 128 + (n0 & 127); }
    else { e.W = F.in[I_W2] + moff; e.WT = F.ws + WS_W2 + (size_t)mat * FF * D; e.row_base = n0; }
    return e;
}
__device__ __forceinline__ void expert_items(Frame& F, LAS float* scr, int layer, int first, int step, int end) {
    for (int it = first; it < end; it += 2 * step) { f32x4 ta[16], tb[16]; const ExpItem ea = expert_item_desc(F, layer, it); const bool hb = it + step < end;
        const ExpItem eb = expert_item_desc(F, layer, hb ? it + step : it);
        p0_item8_load(ea.W, FF, ea.k0, ea.n0, F.lane, ta);
        if (hb) p0_item8_load(eb.W, FF, eb.k0, eb.n0, F.lane, tb);
        p0_item8_finish(ta, D, ea.WT, ea.row_base, scr, ea.k0, F.lane, WSC);
        if (hb) p0_item8_finish(tb, D, eb.WT, eb.row_base, scr, eb.k0, F.lane, WSC); }
}
constexpr int CW_Q = 2048, CW_DONE9 = 2112, CW_Q0 = 2176, CW_DONE1 = 2240, CW_DONE5 = 2304, CW_DONE10 = 2368, CW_DONE12 = 2432, QBATCH = 4;
__device__ __forceinline__ void conv_bg(Frame& F, int layer, gu32* stop, unsigned stopcount) {
    LAS float* scr = (LAS float*)(F.lds + F.wave * 17408);
    for (;;) {
        if (stop) { unsigned d = 0u; if (F.lane == 0) d = __hip_atomic_load(stop, RLX_AGENT); d = (unsigned)__builtin_amdgcn_readfirstlane((int)d); if (d >= stopcount) break; }
        unsigned it0 = 0u; if (F.lane == 0) it0 = __hip_atomic_fetch_add(F.ctl + (layer ? CW_Q : CW_Q0), (unsigned)QBATCH, RLX_AGENT); it0 = (unsigned)__builtin_amdgcn_readfirstlane((int)it0);
        if (layer == 0 && F.G * NWAVES == 2048) it0 += (unsigned)((SS_C1_ + SS_C2_) * 1024);
        if (it0 >= (unsigned)EXP_ITEMS) break;
        expert_items(F, scr, layer, (int)it0, 1, (int)it0 + QBATCH);
    }
}
__device__ __forceinline__ void p0_prologue(Frame& F) {
    LAS float* scr = (LAS float*)(F.lds + F.wave * 17408);
    const int gw = F.vcu * NWAVES + F.wave, NGW = F.G * NWAVES;
    bf16* WIN0 = (bf16*)(F.ws + WS_WIN0); bf16* GLU = (bf16*)(F.ws + WS_GLU); bf16* WOUT0 = (bf16*)(F.ws + WS_WOUT0); bf16* WIN1 = (bf16*)(F.ws + WS_WIN1); bf16* WOUT1 = (bf16*)(F.ws + WS_WOUT1);
    constexpr int I0 = (D / 64) * (EIN / 32), I1 = (SW / 64) * (SW / 32), I2 = (D / 64) * (D / 32), I3 = (D / 64) * (ZW / 32), I4 = I2;
    constexpr int NSM = I0 + I1 + I2 + I3 + I4;
    for (int it = gw; it < NSM; it += NGW) {
        int r = it;
        if (r < I0) { const int nb = EIN / 32; p0_transpose_item(F.in[I_EWIN], D, EIN, WIN0, 32 * (r % nb), scr, 64 * (r / nb), 32 * (r % nb), F.lane, F.in[I_MIXN]); continue; } r -= I0;
        if (r < I1) { const int nb = SW / 32; p0_transpose_item(F.in[I_GLUW], SW, SW, GLU, 32 * (r % nb), scr, 64 * (r / nb), 32 * (r % nb), F.lane); continue; } r -= I1;
        if (r < I2) { const int nb = D / 32; p0_transpose_item(F.in[I_EWOUT], D, D, WOUT0, 32 * (r % nb), scr, 64 * (r / nb), 32 * (r % nb), F.lane); continue; } r -= I2;
        if (r < I3) { const int nb = ZW / 32; p0_transpose_item(F.in[I_OWIN], D, ZW, WIN1, 32 * (r % nb), scr, 64 * (r / nb), 32 * (r % nb), F.lane, F.in[I_MIXN] + D); continue; } r -= I3;
        { const int nb = D / 32; p0_transpose_item(F.in[I_OWOUT], D, D, WOUT1, 32 * (r % nb), scr, 64 * (r / nb), 32 * (r % nb), F.lane); }
    }
    { bf16* SG = (bf16*)(F.ws + WS_SGU); const float* sw = F.in[I_SGUW];
      for (int i = (F.vcu * NT + F.tid) * 4; i < 16 * 128 * 128; i += F.G * NT * 4) { const f32x4 v = *(const f32x4*)(sw + i); v2u w; w.x = pkbf(v.x, v.y); w.y = pkbf(v.z, v.w); *(v2u*)(SG + i) = w; } }
    { float* LUT = (float*)(F.ws + WS_LUT); const float* rb = F.in[I_RELB];
      for (int i = F.vcu * NT + F.tid; i < 8 * 512; i += F.G * NT) { const int hd = i >> 9, rel = (i & 511) - 256; float v = -1e30f; if (rel >= -128 && rel <= 128) v = rb[t5_bucket(rel) * 8 + hd]; LUT[i] = v; } }
    { float* LAM = (float*)(F.ws + WS_LAM); float* LAM512 = (float*)(F.ws + WS_LAM512); bf16* BB = (bf16*)(F.ws + WS_BB); bf16* CM = (bf16*)(F.ws + WS_CM);
      for (int i = F.vcu * NT + F.tid; i < 2 * 64 * 64; i += F.G * NT) {
          const int p = i & 63, dg = i >> 6;
          const double dt = (double)expf(F.in[I_LDT][dg]); const double ar = (double)F.in[I_ARE][i], ai = (double)F.in[I_AIM][i];
          const double mag = (double)expf((float)(ar * dt)); double sn, cs; sincos_d(ai * dt, sn, cs);
          const double lbr = mag * cs, lbi = mag * sn, den = ar * ar + ai * ai, nr = lbr - 1.0;
          const double cr = (nr * ar + lbi * ai) / den, ci = (lbi * ar - nr * ai) / den;
          LAM[2 * i] = (float)lbr; LAM[2 * i + 1] = (float)lbi;
          const double mag5 = (double)expf((float)(512.0 * ar * dt)); double s5, c5; sincos_d(512.0 * ai * dt, s5, c5);
          LAM512[2 * i] = (float)(mag5 * c5); LAM512[2 * i + 1] = (float)(mag5 * s5);
#pragma unroll
          for (int c = 0; c < 16; ++c) { const double br = (double)F.in[I_BRE][(size_t)i * 16 + c], bi = (double)F.in[I_BIM][(size_t)i * 16 + c];
              BB[((size_t)dg * 128 + 2 * p) * 16 + c] = f2bf1((float)(cr * br - ci * bi)); BB[((size_t)dg * 128 + 2 * p + 1) * 16 + c] = f2bf1((float)(cr * bi + ci * br));
              CM[((size_t)dg * 16 + c) * 128 + 2 * p] = f2bf1(F.in[I_CRE][((size_t)dg * 16 + c) * 64 + p]); CM[((size_t)dg * 16 + c) * 128 + 2 * p + 1] = f2bf1(-F.in[I_CIM][((size_t)dg * 16 + c) * 64 + p]); }
      } }
    { bf16* X16 = (bf16*)(F.ws + WS_X16); float* RS0 = (float*)(F.ws + WS_RSTD0);
      for (int m = gw; m < M; m += NGW) { const GAS f32x4* xr = (const GAS f32x4*)(F.in[I_X] + (size_t)m * D) + F.lane; f32x4 v[8]; float s = 0.f;
#pragma unroll
          for (int j = 0; j < 8; ++j) { v[j] = xr[64 * j]; s += (v[j].x * v[j].x + v[j].y * v[j].y) + (v[j].z * v[j].z + v[j].w * v[j].w); }
#pragma unroll
          for (int j = 0; j < 8; ++j) { v2u w; w.x = pkbf(v[j].x, v[j].y); w.y = pkbf(v[j].z, v[j].w); *((GAS v2u*)(X16 + (size_t)m * D) + F.lane + 64 * j) = w; }
          const float rstd = 1.0f / sqrtf(wave_sum(s) * (1.f / D) + EPS); if (F.lane == 0) RS0[m] = rstd; } }
}

constexpr int AT_P = 272;
constexpr int AT_K = 0, AT_VT = 128 * AT_P, AT_BUF = 2 * 128 * AT_P, AT_LUT = 2 * AT_BUF;
static_assert(AT_LUT + 4096 <= SCR_BYTES, "attention LDS");
__device__ __forceinline__ void attn_unit(Frame& F, int unit) {
    const bf16* PROJ = (const bf16*)(F.ws + WS_PROJ); bf16* CAT = (bf16*)(F.ws + WS_CAT); const float* LUTG = (const float*)(F.ws + WS_LUT);
    const int hp = unit & 1, kvh = (unit >> 1) & 1, blk = (unit >> 2) & 31, b = unit >> 7;
    const int lane = F.lane, r = lane & 31, h = lane >> 5, hh = F.wave >> 2, head = kvh * 4 + hp * 2 + hh, qrow0 = (F.wave & 3) * 32;
    LAS unsigned char* lds = F.lds; LAS float* LUT = (LAS float*)(lds + AT_LUT);
    __syncthreads();
    for (int i = F.tid; i < 1024; i += NT) LUT[i] = LUTG[(kvh * 4 + hp * 2 + (i >> 9)) * 512 + (i & 511)] * 1.4426950408889634f;
    const size_t tq = (size_t)b * SEQ + blk * 128 + qrow0 + r;
    bf16x8 qf[8];
#pragma unroll
    for (int s = 0; s < 8; ++s) qf[s] = *(const bf16x8*)(PROJ + tq * EIN + QOFF + head * 128 + 16 * s + 8 * h);
    float mrun = F.in[I_SINK][head] * 1.4426950408889634f, lrun = 1.0f;
    f32x16 oacc[4];
#pragma unroll
    for (int dt = 0; dt < 4; ++dt)
#pragma unroll
        for (int i = 0; i < 16; ++i) oacc[dt][i] = 0.f;
    const int kb0 = blk > 0 ? blk - 1 : 0, kb1 = blk < SEQ / 128 - 1 ? blk + 1 : SEQ / 128 - 1;
    v4u kreg[4], vreg[4];
#define AT_LOADKV(kb_) do { const size_t tok0_ = (size_t)b * SEQ + (kb_) * 128; _Pragma("unroll") for (int i = 0; i < 4; ++i) { const int c = F.tid + NT * i, row = c >> 4, ch = c & 15, row2 = c & 127, ch2 = c >> 7; \
        kreg[i] = *(const v4u*)(PROJ + (tok0_ + row) * EIN + KOFF + kvh * 128 + ch * 8); vreg[i] = *(const v4u*)(PROJ + (tok0_ + row2) * EIN + VOFF + kvh * 128 + ch2 * 8); } } while (0)
    AT_LOADKV(kb0);
#define AT_STAGE(bo_) do { _Pragma("unroll") for (int i = 0; i < 4; ++i) { const int c = F.tid + NT * i, row = c >> 4, ch = c & 15, row2 = c & 127, ch2 = c >> 7;     \
            const v4u kv = kreg[i], vv = vreg[i]; \
            *(LAS v4u*)(lds + (bo_) + AT_K + row * AT_P + ch * 16) = kv; \
            LAS bf16* vt = (LAS bf16*)(lds + (bo_) + AT_VT + (ch2 * 8) * AT_P + row2 * 2); \
            vt[0 * (AT_P / 2)] = (bf16)(vv.x & 0xffffu); vt[1 * (AT_P / 2)] = (bf16)(vv.x >> 16); vt[2 * (AT_P / 2)] = (bf16)(vv.y & 0xffffu); vt[3 * (AT_P / 2)] = (bf16)(vv.y >> 16); \
            vt[4 * (AT_P / 2)] = (bf16)(vv.z & 0xffffu); vt[5 * (AT_P / 2)] = (bf16)(vv.z >> 16); vt[6 * (AT_P / 2)] = (bf16)(vv.w & 0xffffu); vt[7 * (AT_P / 2)] = (bf16)(vv.w >> 16); } } while (0)
    AT_STAGE(0);
    if (kb0 < kb1) AT_LOADKV(kb0 + 1);
    __syncthreads();
    for (int kb = kb0; kb <= kb1; ++kb) {
        const int bo = ((kb - kb0) & 1) * AT_BUF;
        if (kb < kb1) { AT_STAGE(AT_BUF - bo); if (kb + 1 < kb1) AT_LOADKV(kb + 2); }
#pragma unroll 1
        for (int kp = 0; kp < 2; ++kp) {
            if ((kb < blk && kp == 0 && qrow0 >= 64) || (kb > blk && kp == 1 && qrow0 < 64)) continue;
            f32x16 sacc[2];
#pragma unroll
            for (int q = 0; q < 2; ++q)
#pragma unroll
                for (int i = 0; i < 16; ++i) sacc[q][i] = 0.f;
#pragma unroll
            for (int s = 0; s < 8; ++s) {
                const bf16x8 a0 = *(const LAS bf16x8*)(lds + bo + AT_K + (64 * kp + r) * AT_P + (16 * s + 8 * h) * 2);
                const bf16x8 a1 = *(const LAS bf16x8*)(lds + bo + AT_K + (64 * kp + 32 + r) * AT_P + (16 * s + 8 * h) * 2);
                sacc[0] = MFMA32(a0, qf[s], sacc[0]); sacc[1] = MFMA32(a1, qf[s], sacc[1]); }
            const int relbase = (kb - blk) * 128 + 64 * kp + 4 * h - qrow0 - r + 256 + hh * 512;
            float x[32]; float tmax = -3.0e38f;
#pragma unroll
            for (int q = 0; q < 2; ++q)
#pragma unroll
                for (int i = 0; i < 16; ++i) { x[16 * q + i] = sacc[q][i] * (0.08838834764831845f * 1.4426950408889634f) + LUT[relbase + 32 * q + (i & 3) + 8 * (i >> 2)]; tmax = fmaxf(tmax, x[16 * q + i]); }
            tmax = fmaxf(tmax, __shfl_xor(tmax, 32));
            const float mnew = fmaxf(mrun, tmax);
            if (__ballot(mnew > mrun) != 0ull) {
                const float alpha = __builtin_amdgcn_exp2f(mrun - mnew); lrun *= alpha;
#pragma unroll
                for (int dt = 0; dt < 4; ++dt)
#pragma unroll
                    for (int i = 0; i < 16; ++i) oacc[dt][i] *= alpha;
            }
            mrun = mnew;
            float psum = 0.f;
#pragma unroll
            for (int i = 0; i < 32; ++i) { x[i] = __builtin_amdgcn_exp2f(x[i] - mnew); psum += x[i]; }
            psum += __shfl_xor(psum, 32);
            lrun += psum;
            bf16x8 pb[4];
#pragma unroll
            for (int s2 = 0; s2 < 4; ++s2) { v4u w; w.x = pkbf(x[8 * s2 + 0], x[8 * s2 + 1]); w.y = pkbf(x[8 * s2 + 2], x[8 * s2 + 3]); w.z = pkbf(x[8 * s2 + 4], x[8 * s2 + 5]); w.w = pkbf(x[8 * s2 + 6], x[8 * s2 + 7]); pb[s2] = __builtin_bit_cast(bf16x8, w); }
#pragma unroll
            for (int s2 = 0; s2 < 4; ++s2)
#pragma unroll
                for (int dt = 0; dt < 4; ++dt) { const LAS unsigned char* vp = lds + bo + AT_VT + (32 * dt + r) * AT_P + (64 * kp + 16 * s2 + 4 * h) * 2;
                    const s16x4 lo = *(const LAS s16x4*)vp, hi = *(const LAS s16x4*)(vp + 16);
                    const bf16x8 a = __builtin_shufflevector(lo, hi, 0, 1, 2, 3, 4, 5, 6, 7);
                    oacc[dt] = MFMA32(a, pb[s2], oacc[dt]); }
        }
        __syncthreads();
    }
#undef AT_LOADKV
#undef AT_STAGE
    const float inv = 1.0f / lrun;
    LAS unsigned char* ob = lds + F.wave * (32 * AT_P);
#pragma unroll
    for (int dt = 0; dt < 4; ++dt)
#pragma unroll
        for (int i = 0; i < 16; ++i) *(LAS bf16*)(ob + r * AT_P + (32 * dt + crow(i, h)) * 2) = f2bf1(oacc[dt][i] * inv);
    LDS_WAIT(); asm volatile("" ::: "memory");
    const size_t trow0 = (size_t)b * SEQ + blk * 128 + qrow0;
#pragma unroll
    for (int i = 0; i < 8; ++i) { const int c = lane + 64 * i, row = c >> 4, ch = c & 15;
        const v4u v = *(const LAS v4u*)(ob + row * AT_P + ch * 16);
        *(GAS v4u*)(CAT + (trow0 + row) * D + head * 128 + ch * 8) = v; }
}

constexpr int SS_XP = 66;
constexpr int SS_HP = 272;
constexpr int SS_SP = 20;
constexpr int SS_TILE8 = 64 * 36;
constexpr int SS_WAVE_BYTES = 32 * SS_HP + 32 * SS_SP * 4 + SS_TILE8;
constexpr int SS_C1 = SS_C1_, SS_C2 = SS_C2_;
struct HalfItem { const float* W; unsigned char* WT; int row_base, k0, n0; };
__device__ __forceinline__ HalfItem half_item_desc(Frame& F, int hid) { const ExpItem e = expert_item_desc(F, 0, hid >> 1); HalfItem h; h.W = e.W; h.WT = e.WT; h.row_base = e.row_base; h.k0 = e.k0 + 64 * (hid & 1); h.n0 = e.n0; return h; }
__device__ __forceinline__ void half_load(const HalfItem& h, int lane, f32x4 (&t)[8]) {
#pragma unroll
    for (int i = 0; i < 8; ++i) t[i] = *(const GAS f32x4*)(h.W + (size_t)(h.k0 + 8 * i + (lane >> 3)) * FF + h.n0 + 4 * (lane & 7));
}
__device__ __forceinline__ void half_finish(const HalfItem& h, const f32x4 (&t)[8], LAS unsigned* tile, int lane) {
#pragma unroll
    for (int i = 0; i < 8; ++i) tile[(8 * i + (lane >> 3)) * 9 + (lane & 7)] = pk4_fp8(t[i].x * WSC, t[i].y * WSC, t[i].z * WSC, t[i].w * WSC);
    LDS_WAIT(); asm volatile("" ::: "memory");
    const int kg = lane & 3, n4 = (lane >> 2) & 7, hf = lane >> 5;
    unsigned r[16];
#pragma unroll
    for (int j = 0; j < 16; ++j) r[j] = tile[(16 * kg + j) * 9 + n4];
    LDS_WAIT(); asm volatile("" ::: "memory");
    const unsigned selA = hf ? 0x07030602u : 0x05010400u;
    v4u o0, o1;
#pragma unroll
    for (int q = 0; q < 4; ++q) { const unsigned lo = bperm(r[4 * q + 1], r[4 * q], selA), hi = bperm(r[4 * q + 3], r[4 * q + 2], selA); o0[q] = bperm(hi, lo, 0x05040100u); o1[q] = bperm(hi, lo, 0x07060302u); }
    unsigned char* dst = h.WT + (size_t)(h.row_base + 4 * n4 + 2 * hf) * D + h.k0 + 16 * kg;
    *(GAS v4u*)dst = o0; *(GAS v4u*)(dst + D) = o1;
}
static_assert(NWAVES * SS_WAVE_BYTES + NWAVES * 4096 <= SCR_BYTES && 32 * SS_XP * 4 <= 32 * SS_HP, "S5 scratch (+ the C fragment copies)");

template <int DIR, int MODE>
__device__ __forceinline__ void ssm_superchunk(Frame& F, int b, int g, int sc, float& hre, float& him, int cv_first, int cv_n) {
    const bf16* PROJ = (const bf16*)(F.ws + WS_PROJ);
    const int lane = F.lane, r = lane & 31, h = lane >> 5, dg = DIR * 64 + g;
    LAS unsigned* XS = (LAS unsigned*)(F.lds + F.wave * SS_WAVE_BYTES); LAS unsigned char* HS = (LAS unsigned char*)XS;
    LAS float* ST = (LAS float*)(HS + 32 * SS_HP);
    LAS unsigned* tile8 = (LAS unsigned*)(HS + 32 * SS_HP + 32 * SS_SP * 4);
    const float2 lam = ((const float2*)(F.ws + WS_LAM))[dg * 64 + lane];
    bf16x8 bbf[4];
#pragma unroll
    for (int t = 0; t < 4; ++t) bbf[t] = *(const bf16x8*)((const bf16*)(F.ws + WS_BB) + ((size_t)dg * 128 + 32 * t + r) * 16 + 8 * h);
    const bf16* cmp_ = (const bf16*)(F.ws + WS_CM) + ((size_t)dg * 16 + (lane & 15)) * 128 + 8 * (lane >> 4);
    LAS unsigned char* CML = F.lds + NWAVES * SS_WAVE_BYTES + F.wave * 4096;
    if (MODE != 0) {
#pragma unroll
        for (int ks = 0; ks < 4; ++ks) { const bf16x8 c = *(const bf16x8*)(cmp_ + 32 * ks); *(LAS bf16x8*)(CML + ks * 1024 + lane * 16) = c; }
    }
    const size_t tsc = (size_t)b * SEQ + sc * 512;
    bf16* YF = (bf16*)(F.ws + WS_YF); bf16* G = (bf16*)(F.ws + WS_G);
    const int cb = g * 16 + 8 * h;
    f32x4 dsk0 = (f32x4){0.f, 0.f, 0.f, 0.f}, dsk1 = dsk0;
    if (MODE == 2) { dsk0 = *(const f32x4*)(F.in[I_SSMD] + cb); dsk1 = *(const f32x4*)(F.in[I_SSMD] + cb + 4); }
    const size_t tfirst = tsc + (DIR ? 15 : 0) * 32;
    bf16x8 uf = *(const bf16x8*)(PROJ + (tfirst + r) * EIN + UOFF + cb);
    v4u yfv = (v4u){0u, 0u, 0u, 0u};
    if (MODE == 2) yfv = *(const v4u*)(YF + (tfirst + r) * SW + cb);
    HalfItem cvh = {}; f32x4 cvt[8];
    if (cv_n > 0) { cvh = half_item_desc(F, cv_first); half_load(cvh, lane, cvt); }
#pragma unroll 1
    for (int ci = 0; ci < 16; ++ci) {
        const int ch = DIR ? 15 - ci : ci; const size_t t0 = tsc + ch * 32;
        const int chn = (ci < 15) ? (DIR ? ch - 1 : ch + 1) : ch; const size_t tn = tsc + chn * 32;
        const bf16x8 uf_n = *(const bf16x8*)(PROJ + (tn + r) * EIN + UOFF + cb);
        v4u yfn = (v4u){0u, 0u, 0u, 0u};
        if (MODE == 2) yfn = *(const v4u*)(YF + (tn + r) * SW + cb);

#pragma unroll
        for (int t = 0; t < 4; ++t) { f32x16 xa;
#pragma unroll
            for (int i = 0; i < 16; ++i) xa[i] = 0.f;
            xa = MFMA32(bbf[t], uf, xa);
#pragma unroll
            for (int k = 0; k < 4; ++k) { v2u w; w.x = pkbf(xa[4 * k], xa[4 * k + 1]); w.y = pkbf(xa[4 * k + 2], xa[4 * k + 3]);
                *(LAS v2u*)(XS + r * SS_XP + 16 * t + 4 * k + 2 * h) = w; } }
        LDS_WAIT(); asm volatile("" ::: "memory");
        float xr[32], xi[32];
#pragma unroll
        for (int s = 0; s < 32; ++s) { const unsigned x2 = XS[s * SS_XP + lane]; xr[s] = bflo(x2); xi[s] = bfhi(x2); }
        LDS_WAIT(); asm volatile("" ::: "memory");
#pragma unroll
        for (int st = 0; st < 32; ++st) { const int s = DIR ? 31 - st : st;
            const float nr = lam.x * hre - lam.y * him + xr[s], ni = lam.x * him + lam.y * hre + xi[s]; hre = nr; him = ni;
            if (MODE != 0) *(LAS unsigned*)(HS + s * SS_HP + lane * 4) = pkbf(nr, ni); }
        f32x4 y[2];
        if (MODE != 0) {
            LDS_WAIT(); asm volatile("" ::: "memory");
            bf16x8 cmf[4];
#pragma unroll
            for (int ks = 0; ks < 4; ++ks) cmf[ks] = *(const LAS bf16x8*)(CML + ks * 1024 + lane * 16);
#pragma unroll
            for (int rt = 0; rt < 2; ++rt) { y[rt] = (f32x4){0.f, 0.f, 0.f, 0.f};
#pragma unroll
                for (int ks = 0; ks < 4; ++ks) { const bf16x8 a = *(const LAS bf16x8*)(HS + (16 * rt + (lane & 15)) * SS_HP + (32 * ks + 8 * (lane >> 4)) * 2); y[rt] = MFMA16(a, cmf[ks], y[rt]); } }
        }
        { const v4u un = __builtin_bit_cast(v4u, uf_n); asm volatile("" :: "v"(un.x), "v"(un.y), "v"(un.z), "v"(un.w));
          if (MODE == 2) asm volatile("" :: "v"(yfn.x), "v"(yfn.y), "v"(yfn.z), "v"(yfn.w)); }
        if (ci < cv_n) { half_finish(cvh, cvt, tile8, lane);
            if (ci + 1 < cv_n) { cvh = half_item_desc(F, cv_first + (ci + 1) * 2048); half_load(cvh, lane, cvt); } }
        if (MODE != 0) {
#pragma unroll
            for (int rt = 0; rt < 2; ++rt)
#pragma unroll
                for (int j = 0; j < 4; ++j) ST[(16 * rt + 4 * (lane >> 4) + j) * SS_SP + (lane & 15)] = y[rt][j];
            LDS_WAIT(); asm volatile("" ::: "memory");
            const f32x4 ya = *(const LAS f32x4*)(ST + r * SS_SP + 8 * h), yb = *(const LAS f32x4*)(ST + r * SS_SP + 8 * h + 4);
            LDS_WAIT(); asm volatile("" ::: "memory");
            v4u o;
            if (MODE == 1 || MODE == 3) { o.x = pkbf(ya.x, ya.y); o.y = pkbf(ya.z, ya.w); o.z = pkbf(yb.x, yb.y); o.w = pkbf(yb.z, yb.w); if (MODE == 1 || F.G == 12345) *(v4u*)(YF + (t0 + r) * SW + cb) = o; }
            else {
                const v4u uw = __builtin_bit_cast(v4u, uf);
                const float v0 = ya.x + bflo(yfv.x) + dsk0.x * bflo(uw.x), v1 = ya.y + bfhi(yfv.x) + dsk0.y * bfhi(uw.x), v2 = ya.z + bflo(yfv.y) + dsk0.z * bflo(uw.y), v3 = ya.w + bfhi(yfv.y) + dsk0.w * bfhi(uw.y);
                const float v4 = yb.x + bflo(yfv.z) + dsk1.x * bflo(uw.z), v5 = yb.y + bfhi(yfv.z) + dsk1.y * bfhi(uw.z), v6 = yb.z + bflo(yfv.w) + dsk1.z * bflo(uw.w), v7 = yb.w + bfhi(yfv.w) + dsk1.w * bfhi(uw.w);
                o.x = pkbf(gelu_tanh(v0), gelu_tanh(v1)); o.y = pkbf(gelu_tanh(v2), gelu_tanh(v3)); o.z = pkbf(gelu_tanh(v4), gelu_tanh(v5)); o.w = pkbf(gelu_tanh(v6), gelu_tanh(v7));
                *(v4u*)(G + (t0 + r) * SW + cb) = o; }
        }
        uf = uf_n; yfv = yfn;
    }
}
__device__ __forceinline__ void ssm_pass1(Frame& F) {
    float* E = (float*)(F.ws + WS_E);
    const bool cvon = F.G * NWAVES == 2048; const int wg = F.vcu * NWAVES + F.wave; int li0 = 0;
    for (int task = F.vcu * NWAVES + F.wave; task < BATCH * 64 * 2 * 8; task += F.G * NWAVES, li0 += 16) {
        const int sc = task & 7, dir = (task >> 3) & 1, g = (task >> 4) & 63, b = task >> 10;
        float hre = 0.f, him = 0.f;
        const int cn = cvon ? (SS_C1 - li0 < 0 ? 0 : (SS_C1 - li0 > 16 ? 16 : SS_C1 - li0)) : 0, cf = li0 * 2048 + wg;
        if (dir == 0) ssm_superchunk<0, 0>(F, b, g, sc, hre, him, cf, cn); else ssm_superchunk<1, 0>(F, b, g, sc, hre, him, cf, cn);
        E[(size_t)task * 128 + F.lane] = hre; E[(size_t)task * 128 + 64 + F.lane] = him;
    }
}
__device__ __forceinline__ void ssm_pass2(Frame& F) {
    const float* E = (const float*)(F.ws + WS_E);
    const bool cvon = F.G * NWAVES == 2048; const int wg = F.vcu * NWAVES + F.wave;
    for (int task = F.vcu * NWAVES + F.wave; task < BATCH * 64 * 8; task += F.G * NWAVES) {
        const int sc = task & 7, g = (task >> 3) & 63, b = task >> 9;
        const int c0 = cvon ? (SS_C2 > 16 ? 16 : SS_C2) : 0, c1n = cvon ? (SS_C2 > 16 ? SS_C2 - 16 : 0) : 0;
        { const float2 l5 = ((const float2*)(F.ws + WS_LAM512))[(0 * 64 + g) * 64 + F.lane]; float cr = 0.f, ci = 0.f;
          float er[7], ei[7];
#pragma unroll
          for (int s2 = 0; s2 < 7; ++s2) { const float* e = E + ((size_t)(((b * 64 + g) * 2 + 0) * 8 + s2)) * 128; er[s2] = e[F.lane]; ei[s2] = e[64 + F.lane]; }
#pragma unroll
          for (int s2 = 0; s2 < 7; ++s2) if (s2 < sc) { const float nr = l5.x * cr - l5.y * ci + er[s2], ni = l5.x * ci + l5.y * cr + ei[s2]; cr = nr; ci = ni; }
#if defined(PROBE_SSM_M1)
          { float c2r = cr, c2i = ci; ssm_superchunk<0, 1>(F, b, g, sc, c2r, c2i, 0, 0); }
#endif
#if defined(PROBE_SSM_M3)
          { float c2r = cr, c2i = ci; ssm_superchunk<0, 3>(F, b, g, sc, c2r, c2i, 0, 0); }
#endif
          ssm_superchunk<0, 1>(F, b, g, sc, cr, ci, SS_C1 * 2048 + wg, c0); }
        { const float2 l5 = ((const float2*)(F.ws + WS_LAM512))[(1 * 64 + g) * 64 + F.lane]; float cr = 0.f, ci = 0.f;
          float er[7], ei[7];
#pragma unroll
          for (int q = 0; q < 7; ++q) { const float* e = E + ((size_t)(((b * 64 + g) * 2 + 1) * 8 + 7 - q)) * 128; er[q] = e[F.lane]; ei[q] = e[64 + F.lane]; }
#pragma unroll
          for (int q = 0; q < 7; ++q) if (7 - q > sc) { const float nr = l5.x * cr - l5.y * ci + er[q], ni = l5.x * ci + l5.y * cr + ei[q]; cr = nr; ci = ni; }
          ssm_superchunk<1, 2>(F, b, g, sc, cr, ci, (SS_C1 + 16) * 2048 + wg, c1n); }
    }
}

__device__ __forceinline__ void router_phase(Frame& F, const bf16* X16, const float* gain, const float* router) {
    unsigned char* H = F.ws + WS_H; float* AFF = (float*)(F.ws + WS_AFF);
    LAS f32x4* RL = (LAS f32x4*)F.lds;
    __syncthreads();
    for (int q = F.tid; q < 2048 * 4; q += NT) { const int d = q >> 2, e4 = q & 3; const f32x4 v = *(const f32x4*)(router + d * 16 + e4 * 4);
        RL[(((d >> 8) * 4 + (d & 3)) * 4 + e4) * 64 + ((d & 255) >> 2)] = v; }
    __syncthreads();
    const int lane = F.lane;
    f32x4 gn[8];
#pragma unroll
    for (int j = 0; j < 8; ++j) gn[j] = *((const GAS f32x4*)gain + lane + 64 * j);
    for (int pr = F.vcu * NWAVES + F.wave; pr < M / 2; pr += F.G * NWAVES) {
        const size_t t0 = (size_t)pr * 2;
        f32x4 v0[8], v1[8]; float s0 = 0.f, s1 = 0.f;
#pragma unroll
        for (int j = 0; j < 8; ++j) {
            { const v2u x0 = *((const GAS v2u*)(X16 + t0 * D) + lane + 64 * j), x1 = *((const GAS v2u*)(X16 + (t0 + 1) * D) + lane + 64 * j);
                v0[j] = (f32x4){bflo(x0.x), bfhi(x0.x), bflo(x0.y), bfhi(x0.y)}; v1[j] = (f32x4){bflo(x1.x), bfhi(x1.x), bflo(x1.y), bfhi(x1.y)}; }
            s0 += (v0[j].x * v0[j].x + v0[j].y * v0[j].y) + (v0[j].z * v0[j].z + v0[j].w * v0[j].w); s1 += (v1[j].x * v1[j].x + v1[j].y * v1[j].y) + (v1[j].z * v1[j].z + v1[j].w * v1[j].w); }
        const float r0 = 1.0f / sqrtf(wave_sum(s0) * (1.f / D) + EPS), r1 = 1.0f / sqrtf(wave_sum(s1) * (1.f / D) + EPS);
        f32x4 a0[4], a1[4];
#pragma unroll
        for (int e4 = 0; e4 < 4; ++e4) { a0[e4] = (f32x4){0.f, 0.f, 0.f, 0.f}; a1[e4] = (f32x4){0.f, 0.f, 0.f, 0.f}; }
#pragma unroll
        for (int j = 0; j < 8; ++j) { v0[j] = v0[j] * r0 * gn[j]; v1[j] = v1[j] * r1 * gn[j];
            *((GAS unsigned*)(H + t0 * D) + lane + 64 * j) = pk4_fp8(v0[j].x * HSC, v0[j].y * HSC, v0[j].z * HSC, v0[j].w * HSC);
            *((GAS unsigned*)(H + (t0 + 1) * D) + lane + 64 * j) = pk4_fp8(v1[j].x * HSC, v1[j].y * HSC, v1[j].z * HSC, v1[j].w * HSC);
#pragma unroll
            for (int i = 0; i < 4; ++i) {
#pragma unroll
                for (int e4 = 0; e4 < 4; ++e4) { const f32x4 w = RL[((j * 4 + i) * 4 + e4) * 64 + lane]; a0[e4] += w * v0[j][i]; a1[e4] += w * v1[j][i]; }
                asm volatile("" ::: "memory"); } }
        float l0[16], l1[16];
#pragma unroll
        for (int e = 0; e < 16; ++e) { l0[e] = wave_sum(a0[e >> 2][e & 3]); l1[e] = wave_sum(a1[e >> 2][e & 3]); }
        float m0 = l0[0], m1 = l1[0];
#pragma unroll
        for (int e = 1; e < 16; ++e) { m0 = fmaxf(m0, l0[e]); m1 = fmaxf(m1, l1[e]); }
        float z0 = 0.f, z1 = 0.f;
#pragma unroll
        for (int e = 0; e < 16; ++e) { l0[e] = expf(l0[e] - m0); l1[e] = expf(l1[e] - m1); z0 += l0[e]; z1 += l1[e]; }
        const int bb = (int)(t0 / SEQ), ss = (int)(t0 % SEQ);
        float p0 = 0.f, p1 = 0.f;
#pragma unroll
        for (int e = 0; e < 16; ++e) { if (lane == e) { p0 = l0[e] / z0; p1 = l1[e] / z1; } }
        if (lane < 16) { AFF[((size_t)bb * NE + lane) * SEQ + ss] = p0; AFF[((size_t)bb * NE + lane) * SEQ + ss + 1] = p1; }
    }
    __syncthreads();
}

__device__ __forceinline__ void topk_unit(Frame& F, int unit) {
    const float* AFF = (const float*)(F.ws + WS_AFF) + (size_t)unit * SEQ;
    int* IDX = (int*)(F.ws + WS_IDX) + (size_t)unit * CAP; float* GATE = (float*)(F.ws + WS_GATE) + (size_t)unit * CAP; int* INV = (int*)(F.ws + WS_INV);
    const int b = unit >> 4, e = unit & 15, tid = F.tid, lane = F.lane;
    int* TOK = (int*)(F.ws + WS_TOK) + e * 2048 + b * 512;
    LAS unsigned* hist = (LAS unsigned*)F.lds;
    LAS unsigned* misc = hist + 256;
    unsigned v[8];
    { const v4u a = *(const v4u*)(AFF + tid * 8), c = *(const v4u*)(AFF + tid * 8 + 4); v[0] = a.x; v[1] = a.y; v[2] = a.z; v[3] = a.w; v[4] = c.x; v[5] = c.y; v[6] = c.z; v[7] = c.w; }
    unsigned prefix = 0u, need = CAP;
#pragma unroll 1
    for (int pass = 0; pass < 4; ++pass) {
        const int shift = 24 - 8 * pass;
        __syncthreads();
        if (tid < 256) hist[tid] = 0u;
        __syncthreads();
#pragma unroll
        for (int k = 0; k < 8; ++k) { const bool match = (pass == 0) || ((v[k] >> (shift + 8)) == prefix); if (match) (void)__hip_atomic_fetch_add(&hist[(v[k] >> shift) & 255u], 1u, __ATOMIC_RELAXED, __HIP_MEMORY_SCOPE_WORKGROUP); }
        __syncthreads();
        if (F.wave == 0) {
            const unsigned c0 = hist[4 * lane], c1 = hist[4 * lane + 1], c2 = hist[4 * lane + 2], c3 = hist[4 * lane + 3];
            unsigned suf = c0 + c1 + c2 + c3;
#pragma unroll
            for (int o = 1; o < 64; o <<= 1) { const unsigned t = __shfl_down(suf, o); if (lane + o < 64) suf += t; }
            const unsigned long long mask = __ballot(suf >= need);
            const int L = 63 - __builtin_clzll(mask);
            if (lane == L) { unsigned run = suf - (c0 + c1 + c2 + c3); unsigned dig, nd;
                if (run + c3 >= need) { dig = 3; nd = need - run; } else { run += c3;
                if (run + c2 >= need) { dig = 2; nd = need - run; } else { run += c2;
                if (run + c1 >= need) { dig = 1; nd = need - run; } else { run += c1; dig = 0; nd = need - run; } } }
                misc[0] = 4u * (unsigned)lane + dig; misc[1] = nd; }
        }
        __syncthreads();
        prefix = (prefix << 8) | misc[0]; need = misc[1];
    }
    const unsigned T = prefix;
    unsigned neq = 0u;
#pragma unroll
    for (int k = 0; k < 8; ++k) neq += (v[k] == T) ? 1u : 0u;
    unsigned inc = neq;
#pragma unroll
    for (int o = 1; o < 64; o <<= 1) { const unsigned t = __shfl_up(inc, o); if (lane >= o) inc += t; }
    __syncthreads();
    if (lane == 63) misc[16 + F.wave] = inc;
    __syncthreads();
    unsigned woff = 0u;
#pragma unroll
    for (int w = 0; w < NWAVES; ++w) woff += (w < F.wave) ? misc[16 + w] : 0u;
    unsigned eqrank = woff + inc - neq;
    unsigned sel = 0u; unsigned selm = 0u;
#pragma unroll
    for (int k = 0; k < 8; ++k) { bool s = v[k] > T; if (v[k] == T) { s = eqrank < need; ++eqrank; } if (s) { selm |= 1u << k; ++sel; } }
    unsigned inc2 = sel;
#pragma unroll
    for (int o = 1; o < 64; o <<= 1) { const unsigned t = __shfl_up(inc2, o); if (lane >= o) inc2 += t; }
    if (lane == 63) misc[32 + F.wave] = inc2;
    __syncthreads();
    unsigned woff2 = 0u;
#pragma unroll
    for (int w = 0; w < NWAVES; ++w) woff2 += (w < F.wave) ? misc[32 + w] : 0u;
    unsigned slot = woff2 + inc2 - sel;
#pragma unroll
    for (int k = 0; k < 8; ++k) { const int s = tid * 8 + k; int sl = -1;
        if (selm & (1u << k)) { sl = (int)slot; ++slot; IDX[sl] = s; TOK[sl] = b * SEQ + s; GATE[sl] = __builtin_bit_cast(float, v[k]); }
        INV[((size_t)b * SEQ + s) * NE + e] = sl; }
}

__device__ __forceinline__ void gather_phase(Frame& F) {
    const unsigned char* H = F.ws + WS_H; unsigned char* XS = F.ws + WS_XS; const int* IDX = (const int*)(F.ws + WS_IDX);
    for (int row = F.vcu * NWAVES + F.wave; row < MS; row += F.G * NWAVES) {
        const int e = row >> 11, b = (row >> 9) & 3, c = row & 511; const int s = IDX[(b * NE + e) * CAP + c];
        const GAS v4u* src = (const GAS v4u*)(H + ((size_t)b * SEQ + s) * D) + F.lane; GAS v4u* dst = (GAS v4u*)(XS + (size_t)row * D) + F.lane;
        const v4u t0 = src[0], t1 = src[64];
        dst[0] = t0; dst[64] = t1;
    }
}
template <bool FINAL>
__device__ __forceinline__ void combine_phase(Frame& F, const bf16* Xin, bf16* Xout, const float* gain) {
    const unsigned char* YS = F.ws + WS_YS; const int* INV = (const int*)(F.ws + WS_INV); const float* GATE = (const float*)(F.ws + WS_GATE);
    const int lane = F.lane;
    const int tstep = F.G * NWAVES; int t = F.vcu * NWAVES + F.wave;
    typedef float f2 __attribute__((ext_vector_type(2)));
#define CB_FIRST(inv_, tok_, W0, W1, G0, G1) do { const unsigned m_ = (unsigned)(__ballot((inv_) >= 0) & 0xffffull); \
        if (m_) { const int b_ = (tok_) / SEQ; const int e0_ = __builtin_ctz(m_); const unsigned mr_ = m_ & (m_ - 1u); const bool two_ = mr_ != 0u; const int e1_ = two_ ? __builtin_ctz(mr_) : e0_; \
            const int s0_ = __builtin_amdgcn_readlane((inv_), e0_), s1_ = __builtin_amdgcn_readlane((inv_), e1_); \
            G0 = GATE[(b_ * NE + e0_) * CAP + s0_] * (1.f / YSC); G1 = two_ ? GATE[(b_ * NE + e1_) * CAP + s1_] * (1.f / YSC) : 0.f; \
            const size_t r0_ = (size_t)e0_ * 2048 + b_ * 512 + s0_, r1_ = (size_t)e1_ * 2048 + b_ * 512 + s1_; \
            _Pragma("unroll") for (int j = 0; j < 8; ++j) { W0[j] = *((const GAS unsigned*)(YS + r0_ * D) + lane + 64 * j); W1[j] = *((const GAS unsigned*)(YS + r1_ * D) + lane + 64 * j); } } } while (0)
#define CB_ACC(W0, W1, G0, G1) do { _Pragma("unroll") for (int j = 0; j < 8; ++j) { \
            const f2 a0 = __builtin_amdgcn_cvt_pk_f32_fp8((int)W0[j], false), a1 = __builtin_amdgcn_cvt_pk_f32_fp8((int)W0[j], true), b0 = __builtin_amdgcn_cvt_pk_f32_fp8((int)W1[j], false), b1 = __builtin_amdgcn_cvt_pk_f32_fp8((int)W1[j], true); \
            v[j].x += G0 * a0.x + G1 * b0.x; v[j].y += G0 * a0.y + G1 * b0.y; v[j].z += G0 * a1.x + G1 * b1.x; v[j].w += G0 * a1.y + G1 * b1.y; } } while (0)
    f32x4 v[8]; int myinv = -1, inv1 = -1; unsigned pw0[8], pw1[8]; float pg0 = 0.f, pg1 = 0.f;
    f32x4 gn[8];
    if (FINAL) {
#pragma unroll
        for (int j = 0; j < 8; ++j) gn[j] = *((const GAS f32x4*)gain + lane + 64 * j);
    }
    if (t < M) {
        const int tn = (t + tstep < M) ? t + tstep : t;
#pragma unroll
        for (int j = 0; j < 8; ++j) { const v2u x = *((const GAS v2u*)(Xin + (size_t)t * D) + lane + 64 * j); v[j] = (f32x4){bflo(x.x), bfhi(x.x), bflo(x.y), bfhi(x.y)}; }
        myinv = INV[(size_t)t * NE + (lane & 15)]; inv1 = INV[(size_t)tn * NE + (lane & 15)];
        CB_FIRST(myinv, t, pw0, pw1, pg0, pg1);
    }
    for (; t < M; t += tstep) {
        const int b = t / SEQ; const int tn = (t + tstep < M) ? t + tstep : t, tn2 = (tn + tstep < M) ? tn + tstep : tn;
        v2u vnp[8];
#pragma unroll
        for (int j = 0; j < 8; ++j) vnp[j] = *((const GAS v2u*)(Xin + (size_t)tn * D) + lane + 64 * j);
        const int inv2 = INV[(size_t)tn2 * NE + (lane & 15)];
        unsigned w0n[8], w1n[8]; float g0n = 0.f, g1n = 0.f;
        CB_FIRST(inv1, tn, w0n, w1n, g0n, g1n);
        unsigned m = (unsigned)(__ballot(myinv >= 0) & 0xffffull);
        if (m) { CB_ACC(pw0, pw1, pg0, pg1); m &= m - 1u; m &= m - 1u; }
        while (m) {
            const int e0 = __builtin_ctz(m); m &= m - 1u; const bool two = m != 0u; const int e1 = two ? __builtin_ctz(m) : e0; m &= m - 1u;
            const int s0 = __builtin_amdgcn_readlane(myinv, e0), s1 = __builtin_amdgcn_readlane(myinv, e1);
            const float g0 = GATE[(b * NE + e0) * CAP + s0] * (1.f / YSC), g1 = two ? GATE[(b * NE + e1) * CAP + s1] * (1.f / YSC) : 0.f;
            const size_t r0 = (size_t)e0 * 2048 + b * 512 + s0, r1 = (size_t)e1 * 2048 + b * 512 + s1;
            unsigned w0[8], w1[8];
#pragma unroll
            for (int j = 0; j < 8; ++j) { w0[j] = *((const GAS unsigned*)(YS + r0 * D) + lane + 64 * j); w1[j] = *((const GAS unsigned*)(YS + r1 * D) + lane + 64 * j); }
            CB_ACC(w0, w1, g0, g1);
        }
        float s = 0.f;
#pragma unroll
        for (int j = 0; j < 8; ++j) { if (!FINAL) { v2u w; w.x = pkbf(v[j].x, v[j].y); w.y = pkbf(v[j].z, v[j].w); *((GAS v2u*)(Xout + (size_t)t * D) + lane + 64 * j) = w; } s += (v[j].x * v[j].x + v[j].y * v[j].y) + (v[j].z * v[j].z + v[j].w * v[j].w); }
        const float rstd = 1.0f / sqrtf(wave_sum(s) * (1.f / D) + EPS);
        if (FINAL) {
#pragma unroll
            for (int j = 0; j < 8; ++j) __builtin_nontemporal_store(v[j] * rstd * gn[j], (GAS f32x4*)(F.out + (size_t)t * D) + lane + 64 * j);
        } else if (lane == 0) ((float*)(F.ws + WS_RSTD))[t] = rstd;
#pragma unroll
        for (int j = 0; j < 8; ++j) { v[j] = (f32x4){bflo(vnp[j].x), bfhi(vnp[j].x), bflo(vnp[j].y), bfhi(vnp[j].y)}; pw0[j] = w0n[j]; pw1[j] = w1n[j]; }
        myinv = inv1; inv1 = inv2; pg0 = g0n; pg1 = g1n;
    }
#undef CB_FIRST
#undef CB_ACC
}

constexpr int SG_VT = 0, SG_MX = 128 * AT_P, SG_MP = 132;
static_assert(SG_MX + 128 * SG_MP * 4 <= SCR_BYTES, "sgu scratch");
__device__ __forceinline__ void sgu_phase(Frame& F) {
    const bf16* Z = (const bf16*)(F.ws + WS_Z); bf16* G2 = (bf16*)(F.ws + WS_G2); const float* STAT = (const float*)(F.ws + WS_STATP);   const bf16* SG = (const bf16*)(F.ws + WS_SGU);
    int hd = blockIdx.x & 15; const int nunits = (M / 128) * 16;
    const int lane = F.lane, r = lane & 31, h = lane >> 5;
    LAS unsigned char* lds = F.lds; LAS float* MX = (LAS float*)(lds + SG_MX);
    const int rt = F.wave >> 1, dt0 = (F.wave & 1) * 2;
    bf16x8 af[8]; float sb[16];
#define SG_CONSTS() do { _Pragma("unroll") for (int ks = 0; ks < 8; ++ks) af[ks] = *(const bf16x8*)(SG + ((size_t)hd * 128 + 32 * rt + r) * 128 + 16 * ks + 8 * h); \
        _Pragma("unroll") for (int i = 0; i < 16; ++i) sb[i] = F.in[I_SGUB][hd * 128 + 32 * rt + crow(i, h)]; } while (0)
    SG_CONSTS();
    v4u uuN[4], vvN[4]; float2 stN[8];
    int unit = blockIdx.x;
    if (unit < nunits) { const size_t t0 = (size_t)(unit >> 4) * 128;
#pragma unroll
        for (int i = 0; i < 4; ++i) { const int c = F.tid + NT * i; uuN[i] = *(const v4u*)(Z + (t0 + (c >> 4)) * ZW + hd * 128 + (c & 15) * 8);
            vvN[i] = *(const v4u*)(Z + (t0 + (c & 127)) * ZW + GW + hd * 128 + (c >> 7) * 8); }
#pragma unroll
        for (int q = 0; q < 8; ++q) stN[q] = *(const float2*)(STAT + ((size_t)q * M + t0 + (F.tid & 127)) * 2); }
    for (; unit < nunits; unit += F.G) {
        const size_t t0 = (size_t)(unit >> 4) * 128;
        if ((unit & 15) != hd) { hd = unit & 15; SG_CONSTS(); }
        v4u uu[4];
#pragma unroll
        for (int i = 0; i < 4; ++i) uu[i] = uuN[i];
        __syncthreads();
        float sum1 = 0.f, sum2 = 0.f;
#pragma unroll
        for (int q = 0; q < 8; ++q) { sum1 += stN[q].x; sum2 += stN[q].y; }
        const float mu = sum1 * (1.f / GW); const float var = fmaxf(sum2 * (1.f / GW) - mu * mu, 0.f); const float rstd = 1.0f / sqrtf(var + EPS);
#pragma unroll
        for (int i = 0; i < 4; ++i) { const int c = F.tid + NT * i, row = c & 127, ch = c >> 7;
            const v4u vv = vvN[i];
            const f32x4 g0 = *(const f32x4*)(F.in[I_LNG] + hd * 128 + ch * 8), g1 = *(const f32x4*)(F.in[I_LNG] + hd * 128 + ch * 8 + 4);
            const f32x4 b0 = *(const f32x4*)(F.in[I_LNB] + hd * 128 + ch * 8), b1 = *(const f32x4*)(F.in[I_LNB] + hd * 128 + ch * 8 + 4);
            LAS bf16* vt = (LAS bf16*)(lds + SG_VT + (ch * 8) * AT_P + row * 2);
            vt[0 * (AT_P / 2)] = f2bf1((bflo(vv.x) - mu) * rstd * g0.x + b0.x); vt[1 * (AT_P / 2)] = f2bf1((bfhi(vv.x) - mu) * rstd * g0.y + b0.y);
            vt[2 * (AT_P / 2)] = f2bf1((bflo(vv.y) - mu) * rstd * g0.z + b0.z); vt[3 * (AT_P / 2)] = f2bf1((bfhi(vv.y) - mu) * rstd * g0.w + b0.w);
            vt[4 * (AT_P / 2)] = f2bf1((bflo(vv.z) - mu) * rstd * g1.x + b1.x); vt[5 * (AT_P / 2)] = f2bf1((bfhi(vv.z) - mu) * rstd * g1.y + b1.y);
            vt[6 * (AT_P / 2)] = f2bf1((bflo(vv.w) - mu) * rstd * g1.z + b1.z); vt[7 * (AT_P / 2)] = f2bf1((bfhi(vv.w) - mu) * rstd * g1.w + b1.w); }
        if (unit + F.G < nunits) { const size_t t1 = (size_t)((unit + F.G) >> 4) * 128; const int h1 = (unit + F.G) & 15;
#pragma unroll
            for (int i = 0; i < 4; ++i) { const int c = F.tid + NT * i; uuN[i] = *(const v4u*)(Z + (t1 + (c >> 4)) * ZW + h1 * 128 + (c & 15) * 8);
                vvN[i] = *(const v4u*)(Z + (t1 + (c & 127)) * ZW + GW + h1 * 128 + (c >> 7) * 8); }
#pragma unroll
            for (int q = 0; q < 8; ++q) stN[q] = *(const float2*)(STAT + ((size_t)q * M + t1 + (F.tid & 127)) * 2); }
        __syncthreads();
        f32x16 acc[2];
#pragma unroll
        for (int q = 0; q < 2; ++q)
#pragma unroll
            for (int i = 0; i < 16; ++i) acc[q][i] = 0.f;
#pragma unroll
        for (int ks = 0; ks < 8; ++ks) {
#pragma unroll
            for (int q = 0; q < 2; ++q) { const bf16x8 bv = *(const LAS bf16x8*)(lds + SG_VT + (32 * (dt0 + q) + r) * AT_P + (16 * ks + 8 * h) * 2); acc[q] = MFMA32(af[ks], bv, acc[q]); } }
#pragma unroll
        for (int q = 0; q < 2; ++q)
#pragma unroll
            for (int i = 0; i < 16; ++i) { const int t = 32 * rt + crow(i, h); MX[t * SG_MP + 32 * (dt0 + q) + r] = acc[q][i] + sb[i]; }
        __syncthreads();
#pragma unroll
        for (int i = 0; i < 4; ++i) { const int c = F.tid + NT * i, row = c >> 4, ch = c & 15;
            const f32x4 m0 = *(const LAS f32x4*)(MX + row * SG_MP + ch * 8), m1 = *(const LAS f32x4*)(MX + row * SG_MP + ch * 8 + 4);
            v4u o; o.x = pkbf(bflo(uu[i].x) * m0.x, bfhi(uu[i].x) * m0.y); o.y = pkbf(bflo(uu[i].y) * m0.z, bfhi(uu[i].y) * m0.w);
            o.z = pkbf(bflo(uu[i].z) * m1.x, bfhi(uu[i].z) * m1.y); o.w = pkbf(bflo(uu[i].w) * m1.z, bfhi(uu[i].w) * m1.w);
            *(GAS v4u*)(G2 + (t0 + row) * GW + hd * 128 + ch * 8) = o; }
    }
#undef SG_CONSTS
}

constexpr int N_PHASES = 21;
struct Args { const float* in[28]; float* out; unsigned char* ws; int ph_lo, ph_hi; };
static_assert(sizeof(Args) == 28 * 8 + 8 + 8 + 8, "Args has no padding");

__global__ void __launch_bounds__(NT, 2) enc_fwd(Args args) {
    extern __shared__ __attribute__((aligned(16))) unsigned char lds[];
    Frame F;
    F.lds = (LAS unsigned char*)lds;
    F.MISC = (volatile LAS unsigned*)(F.lds + MISC_OFF);
    F.tid = threadIdx.x; F.lane = F.tid & 63; F.wave = __builtin_amdgcn_readfirstlane(F.tid >> 6);
    F.G = gridDim.x; { const int bx = blockIdx.x; F.vcu = (F.G % 8 == 0) ? (bx % 8) * (F.G / 8) + bx / 8 : bx; }
    F.ws = args.ws; F.ctl = (gu32*)(args.ws + WS_CTL); F.out = args.out;
#pragma unroll
    for (int i = 0; i < 28; ++i) F.in[i] = args.in[i];
    for (int u = F.tid; u < (LDS_BYTES - LDSCTL_OFF) / 4; u += NT) ((LAS unsigned*)(F.lds + LDSCTL_OFF))[u] = 0u;
    __syncthreads();
    const int lo = args.ph_lo, hi = args.ph_hi;
    const bool multi = (hi - lo) > 1;
    XcdBarrier bar; bar.bar = (unsigned*)(F.ctl + CW_BAR); bar.x = 0; bar.st = nullptr;
    if (multi) bar = xcd_barrier_post((unsigned*)(F.ctl + CW_BAR), F.MISC + 8);
#ifdef ONLY_PHASE
#define IN(k) ((k) == ONLY_PHASE && lo <= (k) && (k) < hi)
#else
#define IN(k) (lo <= (k) && (k) < hi)
#endif
#ifndef PROBE_DUP_MASK
#define PROBE_DUP_MASK 0u
#endif
#define PH(k) for (int _r = 0; _r < (((PROBE_DUP_MASK >> (k)) & 1u) ? 2 : 1); ++_r) if (IN(k))
#define STOP_THR(nunits, gw) ((unsigned)(((nunits) % (gw)) ? ((gw) - (nunits) % (gw) + 1) : 1))
#ifdef PROBE_DBLBAR
#define SEAM(k) do { if (IN((k) + 1)) { xcd_barrier(bar); xcd_barrier(bar); } } while (0)
#else
#define SEAM(k) do { if (IN((k) + 1)) xcd_barrier(bar); } while (0)
#endif
    LAS unsigned char* ring = F.lds;
    bf16* const H = (bf16*)(F.ws + WS_H); bf16* const DL = (bf16*)(F.ws + WS_XA);     bf16* const XB = (bf16*)(F.ws + WS_XB);
    unsigned char* const HID = F.ws + WS_HID; unsigned char* const YS = F.ws + WS_YS;

    PH(0) { p0_prologue(F);
#if defined(PROBE_P0)
        __syncthreads(); p0_prologue(F);
#endif
        SEAM(0); }
    PH(1) {
        const int NC1 = (F.G >= 64) ? ((F.G * 5 / 32) & ~7) : 0, GW1 = F.G - NC1;
        if ((int)blockIdx.x >= GW1) conv_bg(F, 0, F.ctl + CW_DONE1, STOP_THR((M / 256) * (EIN / 256), GW1));
        else {
        pg8::Gemm g{(const bf16*)(F.ws + WS_X16), (const bf16*)(F.ws + WS_WIN0), M, EIN, D}; pg8::StaticOrder S; S.init(M, EIN, GW1, (int)blockIdx.x);
        pg8::EpiStoreRS E{(bf16*)(F.ws + WS_PROJ), EIN, EIN / 256, (const float*)(F.ws + WS_RSTD0)};
        pg8::gemm_phase<pg8::EpiStoreRS, pg8::StaticOrder, true, true>(ring, g, S, E);
        __syncthreads(); if (F.tid == 0) (void)__hip_atomic_fetch_add(F.ctl + CW_DONE1, 1u, RLX_AGENT);
        conv_bg(F, 0, F.ctl + CW_DONE1, STOP_THR((M / 256) * (EIN / 256), GW1));
        }
        SEAM(1);
    }
    PH(2) {
        for (int u = blockIdx.x; u < BATCH * 32 * 2 * 2; u += F.G) attn_unit(F, u);
        __syncthreads();
        ssm_pass1(F);
#if defined(PROBE_SSM1)
        __syncthreads(); ssm_pass1(F);
#endif
#if defined(PROBE_ATTN)
        __syncthreads(); for (int u = blockIdx.x; u < BATCH * 32 * 2 * 2; u += F.G) attn_unit(F, u);
#endif
        SEAM(2);
    }
    PH(3) { ssm_pass2(F);
#if defined(PROBE_P3)
        __syncthreads(); ssm_pass2(F);
#endif
        SEAM(3); }
    PH(4) {
        pg8::Gemm g{(const bf16*)(F.ws + WS_G), (const bf16*)(F.ws + WS_GLU), M, SW, SW}; pg8::StaticOrder S; S.init(M, SW, F.G, (int)blockIdx.x);
        pg8::EpiGlu E{(const bf16*)(F.ws + WS_G), SW, (bf16*)(F.ws + WS_CAT), D, AW, F.in[I_GLUB]};
        pg8::gemm_phase<pg8::EpiGlu, pg8::StaticOrder, true, true>(ring, g, S, E);
#if defined(PROBE_G4)
        pg8::gemm_phase<pg8::EpiGlu, pg8::StaticOrder, true, true>(ring, g, S, E);
#endif
        SEAM(4);
    }
    PH(5) {
        pg8::Gemm g{(const bf16*)(F.ws + WS_CAT), (const bf16*)(F.ws + WS_WOUT0), M, D, D}; pg8::StaticOrder S; S.init(M, D, F.G, (int)blockIdx.x);
        pg8::EpiStoreRes E{DL, D, D / 256, (const bf16*)(F.ws + WS_X16)};
        pg8::gemm_phase<pg8::EpiStoreRes, pg8::StaticOrder, true, true>(ring, g, S, E);
        SEAM(5);
    }
    PH(6) { router_phase(F, DL, F.in[I_FFNN], F.in[I_ROUTER]);
        SEAM(6); }
    PH(7) { for (int u = blockIdx.x; u < BATCH * NE; u += F.G) topk_unit(F, u);
        __syncthreads(); conv_bg(F, 0, nullptr, 0u);
#if defined(PROBE_P7)
        __syncthreads(); for (int u = blockIdx.x; u < BATCH * NE; u += F.G) topk_unit(F, u);
#endif
        if (IN(9)) xcd_barrier(bar); }
    #ifndef NCONV_NUM
#define NCONV_NUM 3
#endif
    const int NCONV = (F.G >= 64) ? ((F.G * NCONV_NUM / 16) & ~7) : 0, GWG = F.G - NCONV; const bool is_conv = (int)blockIdx.x >= GWG;
    PH(9) {
        if (is_conv) conv_bg(F, 1, F.ctl + CW_DONE9, STOP_THR((MS / 256) * (2 * FF / 256), GWG));
        else {
        pg8::Gemm g{(const bf16*)(F.ws + WS_H), (const bf16*)(F.ws + WS_W13), MS, 2 * FF, D / 2, (const int*)(F.ws + WS_TOK)}; pg8::GroupedOrder S; S.init(MS, 2 * FF, GWG, (int)blockIdx.x); S.npg = 2 * FF / 256;
        pg8::EpiSwiglu8 E{HID, FF, 2 * FF / 256, 1.f / (HSC * WSC), HIDSC, 0};
        pg8::gemm_phase<pg8::EpiSwiglu8, pg8::GroupedOrder, true, true, true, true>(ring, g, S, E);
        __syncthreads(); if (F.tid == 0) (void)__hip_atomic_fetch_add(F.ctl + CW_DONE9, 1u, RLX_AGENT);
        conv_bg(F, 1, F.ctl + CW_DONE9, STOP_THR((MS / 256) * (2 * FF / 256), GWG));
        }
        SEAM(9);
    }
    PH(10) {
        if (!is_conv) {
        pg8::Gemm g{(const bf16*)HID, (const bf16*)(F.ws + WS_W2), MS, D, FF / 2}; pg8::GroupedOrder S; S.init(MS, D, GWG, (int)blockIdx.x); S.npg = D / 256;
        pg8::EpiStore8 E{YS, D, D / 256, YSC / (HIDSC * WSC)};
        pg8::gemm_phase<pg8::EpiStore8, pg8::GroupedOrder, true, true, true>(ring, g, S, E);
        __syncthreads();
        }
        conv_bg(F, 1, nullptr, 0u);
        SEAM(10);
    }
    PH(11) { combine_phase<false>(F, DL, XB, F.in[I_MIXN] + D);
        SEAM(11); }
    PH(12) {
        pg8::Gemm g{XB, (const bf16*)(F.ws + WS_WIN1), M, ZW, D}; pg8::StaticOrder S; S.init(M, ZW, F.G, (int)blockIdx.x);
        pg8::EpiGelu E{(bf16*)(F.ws + WS_Z), ZW, (float*)(F.ws + WS_STATP), GW / 256, (const float*)(F.ws + WS_RSTD), (LAS float*)(F.lds + 131072 + 1024), M};
        pg8::gemm_phase<pg8::EpiGelu, pg8::StaticOrder, true, true>(ring, g, S, E);
#if defined(PROBE_G12)
        { pg8::EpiGelu E2{(bf16*)(F.ws + WS_Z), ZW, (float*)(F.ws + WS_XS), GW / 256, (const float*)(F.ws + WS_RSTD), (LAS float*)(F.lds + 131072 + 1024), M}; pg8::gemm_phase<pg8::EpiGelu, pg8::StaticOrder, true, true>(ring, g, S, E2); }
#endif
        SEAM(12);
    }
    PH(13) { sgu_phase(F); SEAM(13); }
    PH(14) {
        pg8::Gemm g{(const bf16*)(F.ws + WS_G2), (const bf16*)(F.ws + WS_WOUT1), M, D, GW}; pg8::StaticOrder S; S.init(M, D, F.G, (int)blockIdx.x);
        pg8::EpiStoreRes E{DL, D, D / 256, XB};
        pg8::gemm_phase<pg8::EpiStoreRes, pg8::StaticOrder, true, true>(ring, g, S, E);
        SEAM(14);
    }
    PH(15) { router_phase(F, DL, F.in[I_FFNN] + D, F.in[I_ROUTER] + D * NE); SEAM(15); }
    PH(16) { for (int u = blockIdx.x; u < BATCH * NE; u += F.G) topk_unit(F, u); if (IN(18)) xcd_barrier(bar); }
    PH(18) {
        pg8::Gemm g{(const bf16*)(F.ws + WS_H), (const bf16*)(F.ws + WS_W13) + (size_t)NE * 2 * FF * D / 2, MS, 2 * FF, D / 2, (const int*)(F.ws + WS_TOK)}; pg8::GroupedOrder S; S.init(MS, 2 * FF, F.G, (int)blockIdx.x); S.npg = 2 * FF / 256;
        pg8::EpiSwiglu8 E{HID, FF, 2 * FF / 256, 1.f / (HSC * WSC), HIDSC, 0};
        pg8::gemm_phase<pg8::EpiSwiglu8, pg8::GroupedOrder, true, true, true, true>(ring, g, S, E);
#if defined(PROBE_G18H)
        { pg8::EpiSwiglu8 E2{HID, FF, 2 * FF / 256, 1.f / (HSC * WSC), HIDSC, F.G + 12089}; pg8::gemm_phase<pg8::EpiSwiglu8, pg8::GroupedOrder, true, true, true, true>(ring, g, S, E2); }
#endif
#if defined(PROBE_G18L)
        { pg8::EpiSwiglu8 E2{(unsigned char*)(F.ws + WS_XS), FF, 2 * FF / 256, 1.f / (HSC * WSC), HIDSC, F.G + 12090}; pg8::gemm_phase<pg8::EpiSwiglu8, pg8::GroupedOrder, true, true, true, true>(ring, g, S, E2); }
#endif
#if defined(PROBE_G18)
        pg8::gemm_phase<pg8::EpiSwiglu8, pg8::GroupedOrder, true, true, true, true>(ring, g, S, E);
#endif
        SEAM(18);
    }
    PH(19) {
        pg8::Gemm g{(const bf16*)HID, (const bf16*)(F.ws + WS_W2) + (size_t)NE * FF * D / 2, MS, D, FF / 2}; pg8::GroupedOrder S; S.init(MS, D, F.G, (int)blockIdx.x); S.npg = D / 256;
        pg8::EpiStore8 E{YS, D, D / 256, YSC / (HIDSC * WSC)};
        pg8::gemm_phase<pg8::EpiStore8, pg8::GroupedOrder, true, true, true>(ring, g, S, E);
        SEAM(19);
    }
    PH(20) { combine_phase<true>(F, DL, nullptr, F.in[I_FINN]); }
#undef IN
#undef SEAM
}

extern "C" void kernel_launch(void* const* d_in, const int* in_sizes, int n_in, void* d_out, int out_size, void* d_ws, size_t ws_size, hipStream_t stream) {
    static int grid = 0;
    if (grid == 0) {
        if (n_in != 28 || in_sizes[0] != M * D || out_size != M * D || ws_size < WS_END) { fprintf(stderr, "kernel_launch: shape/workspace mismatch (n_in %d, in0 %d, out %d, ws %zu, need %zu)\n", n_in, n_in > 0 ? in_sizes[0] : -1, out_size, ws_size, (size_t)WS_END); grid = -1; return; }
        int dev = 0, cus = 0, per_cu = 0;
        if (hipGetDevice(&dev) != hipSuccess || hipDeviceGetAttribute(&cus, hipDeviceAttributeMultiprocessorCount, dev) != hipSuccess) { grid = -1; return; }
        if (hipFuncSetAttribute((const void*)enc_fwd, hipFuncAttributeMaxDynamicSharedMemorySize, LDS_BYTES) != hipSuccess) { fprintf(stderr, "kernel_launch: hipFuncSetAttribute failed\n"); grid = -1; return; }
        if (hipOccupancyMaxActiveBlocksPerMultiprocessor(&per_cu, (const void*)enc_fwd, NT, LDS_BYTES) != hipSuccess || per_cu < 1) fprintf(stderr, "kernel_launch: occupancy query reports %d\n", per_cu);
        (void)hipGetLastError();
        grid = cus;
    }
    if (grid < 0) return;
    (void)hipMemsetAsync((char*)d_ws + WS_CTL, 0, CTL_ZERO_BYTES, stream);
    Args a{};
    for (int i = 0; i < 28; ++i) a.in[i] = (const float*)d_in[i];
    a.out = (float*)d_out; a.ws = (unsigned char*)d_ws;
#if MK_N_LAUNCHES == 1
    a.ph_lo = 0; a.ph_hi = N_PHASES;
    hipLaunchKernelGGL(enc_fwd, dim3(grid), dim3(NT), LDS_BYTES, stream, a);
#else
    for (int p = 0; p < N_PHASES; ++p) { a.ph_lo = p; a.ph_hi = p + 1; hipLaunchKernelGGL(enc_fwd, dim3(grid), dim3(NT), LDS_BYTES, stream, a); }
#endif
}
```

```cpp
#include <hip/hip_runtime.h>
#include <cstdio>
#include <cstdint>
namespace pg8 {
#define PG8_LAS __attribute__((address_space(3)))
typedef unsigned short bf16_t;
typedef short bf16x8 __attribute__((ext_vector_type(8)));
typedef float f32x4 __attribute__((ext_vector_type(4)));
typedef unsigned u32x4 __attribute__((ext_vector_type(4)));
constexpr int BM = 256, BK = 64, HALF = 128, HTB = HALF * BK * 2  , STAGE_BYTES = 8 * HTB, NXCD = 8, WGM = 8;

__host__ __device__ __forceinline__ int lds_byte(int r, int c) { const int st = (r >> 4) * 2 + (c >> 5), rr = r & 15, cc = c & 31, ob = rr * 64 + cc * 2; return st * 1024 + (ob ^ (((ob >> 9) & 1) << 5)); }
__host__ __device__ __forceinline__ void stage_rc(int b, int& R, int& C) { const int st = b / 1024, sb = b % 1024, swz = sb ^ (((sb >> 9) & 1) << 5); R = (st >> 1) * 16 + swz / 64; C = (st & 1) * 32 + (swz % 64) / 2; }
__host__ __device__ __forceinline__ int perm32(int rho) { const int n = rho >> 4, i = rho & 15; return 8 * (i >> 2) + 4 * n + (i & 3); }

struct Unit { int pm, pn; };
struct Gemm { const bf16_t* A; const bf16_t* Bt; int M, N, K; const int* rowtok; };

struct StaticOrder {
    int nM, nN, nwg, G, c;
    __host__ __device__ void init(int M, int N, int G_, int c_) { nM = M / BM; nN = N / BM; nwg = nM * nN; G = G_; c = c_; }
    __host__ __device__ bool next(int i, Unit& u) const {
        const long L = (long)i * G + c; if (L >= nwg) return false;
        int wgid = (int)L; { const int q = nwg / NXCD, r = nwg % NXCD, xcd = wgid % NXCD, off = wgid / NXCD; wgid = (xcd < r ? xcd * (q + 1) : r * (q + 1) + (xcd - r) * q) + off; }
        const int nig = WGM * nN, gid = wgid / nig, fm = gid * WGM, gsz = (nM - fm) < WGM ? (nM - fm) : WGM;
        u.pm = fm + ((wgid % nig) % gsz); u.pn = (wgid % nig) / gsz; return true;
    }
    __device__ __forceinline__ void a_ready(const Unit&) const {}
    __device__ __forceinline__ void done(const Unit&) const {}
};
__device__ __forceinline__ unsigned cvt_pk_bf16(float lo, float hi) { unsigned r; asm volatile("v_cvt_pk_bf16_f32 %0, %1, %2" : "=v"(r) : "v"(lo), "v"(hi)); return r; }
struct GroupedOrder : StaticOrder {
    int npg;
    __device__ __forceinline__ bool next(int i, Unit& u) const { if (!StaticOrder::next(i, u)) return false; u.pn += (u.pm >> 3) * npg; return true; }
};
typedef unsigned u32x2 __attribute__((ext_vector_type(2)));
typedef int i32x4_t __attribute__((ext_vector_type(4)));
typedef int i32x8_t __attribute__((ext_vector_type(8)));
__device__ __forceinline__ i32x8_t cat8(bf16x8 a, bf16x8 b) { return __builtin_shufflevector(__builtin_bit_cast(i32x4_t, a), __builtin_bit_cast(i32x4_t, b), 0, 1, 2, 3, 4, 5, 6, 7); }
typedef __bf16 bf16x2_t __attribute__((ext_vector_type(2)));
typedef float f32x2_t __attribute__((ext_vector_type(2)));
__device__ __forceinline__ unsigned pkbf(float a, float b) { f32x2_t v = {a, b}; bf16x2_t r = __builtin_convertvector(v, bf16x2_t); return __builtin_bit_cast(unsigned, r); }
__device__ __forceinline__ float clamp8(float x) { return fminf(fmaxf(x, -448.f), 448.f); }
__device__ __forceinline__ unsigned pk4_fp8(float a, float b, float c, float d) {
    unsigned w = (unsigned)__builtin_amdgcn_cvt_pk_fp8_f32(clamp8(a), clamp8(b), 0, false); return (unsigned)__builtin_amdgcn_cvt_pk_fp8_f32(clamp8(c), clamp8(d), (int)w, true); }
__device__ __forceinline__ float bflo(unsigned w) { return __builtin_bit_cast(float, w << 16); }
__device__ __forceinline__ float bfhi(unsigned w) { return __builtin_bit_cast(float, w & 0xffff0000u); }
__device__ __forceinline__ float sigmoidf_(float v) { return __builtin_amdgcn_rcpf(1.f + __expf(-v)); }
__device__ __forceinline__ float gelu_tanh(float x) { const float u = x * (1.5957691216f + 0.0713548163f * x * x); return x * sigmoidf_(u); }
typedef float f2v __attribute__((ext_vector_type(2)));
__device__ __forceinline__ f2v gelu_tanh2(f2v x) {
    const f2v x2 = x * x, u = x * (x2 * (-0.1029432397f) + (-2.3022082480f));
    f2v e; e.x = __builtin_amdgcn_exp2f(u.x); e.y = __builtin_amdgcn_exp2f(u.y);
    const f2v d = e + 1.0f; f2v r; r.x = __builtin_amdgcn_rcpf(d.x); r.y = __builtin_amdgcn_rcpf(d.y);
    return x * r;
}
__device__ __forceinline__ f2v swiglu2(f2v a, f2v b, float c1, float c2) {
    const f2v t = a * c1; f2v e; e.x = __builtin_amdgcn_exp2f(t.x); e.y = __builtin_amdgcn_exp2f(t.y);
    const f2v d = e + 1.0f; f2v r; r.x = __builtin_amdgcn_rcpf(d.x); r.y = __builtin_amdgcn_rcpf(d.y);
    return (a * b) * (r * c2);
}

struct EpiStore {
    static constexpr bool PERM = true, AFTER_DRAIN = false;
    bf16_t* O; int ldc; int npn; float osc;
    __device__ __forceinline__ void operator()(const f32x4 (&acc)[2][2][4][2], const Unit& u, int wr, int wc, int fr, int fq) const {
        const int row0 = u.pm * BM + wr * 64 + fr, col0 = (u.pn % npn) * BM + wc * 32 + 8 * fq;
#pragma unroll
        for (int ai = 0; ai < 2; ++ai)
#pragma unroll
            for (int m = 0; m < 4; ++m) { bf16_t* rowp = O + (size_t)(row0 + ai * HALF + m * 16) * ldc + col0;
#pragma unroll
                for (int bj = 0; bj < 2; ++bj) { const f32x4 v0 = acc[ai][bj][m][0] * osc, v1 = acc[ai][bj][m][1] * osc;
                    u32x4 w; w.x = pkbf(v0[0], v0[1]); w.y = pkbf(v0[2], v0[3]); w.z = pkbf(v1[0], v1[1]); w.w = pkbf(v1[2], v1[3]);
                    *(u32x4*)(rowp + bj * HALF) = w; } }
    }
};
struct EpiStoreRes {
    static constexpr bool PERM = true, AFTER_DRAIN = false;
    bf16_t* O; int ldc; int npn; const bf16_t* R;
    __device__ __forceinline__ void operator()(const f32x4 (&acc)[2][2][4][2], const Unit& u, int wr, int wc, int fr, int fq) const {
        const int row0 = u.pm * BM + wr * 64 + fr, col0 = (u.pn % npn) * BM + wc * 32 + 8 * fq;
        u32x4 res[2][4][2];
#pragma unroll
        for (int ai = 0; ai < 2; ++ai)
#pragma unroll
            for (int m = 0; m < 4; ++m)
#pragma unroll
                for (int bj = 0; bj < 2; ++bj) res[ai][m][bj] = *(const u32x4*)(R + (size_t)(row0 + ai * HALF + m * 16) * ldc + col0 + bj * HALF);
#pragma unroll
        for (int ai = 0; ai < 2; ++ai)
#pragma unroll
            for (int m = 0; m < 4; ++m) { bf16_t* rowp = O + (size_t)(row0 + ai * HALF + m * 16) * ldc + col0;
#pragma unroll
                for (int bj = 0; bj < 2; ++bj) { const f32x4 v0 = acc[ai][bj][m][0], v1 = acc[ai][bj][m][1]; const u32x4 r = res[ai][m][bj];
                    u32x4 w; w.x = pkbf(v0[0] + bflo(r.x), v0[1] + bfhi(r.x)); w.y = pkbf(v0[2] + bflo(r.y), v0[3] + bfhi(r.y)); w.z = pkbf(v1[0] + bflo(r.z), v1[1] + bfhi(r.z)); w.w = pkbf(v1[2] + bflo(r.w), v1[3] + bfhi(r.w));
                    *(u32x4*)(rowp + bj * HALF) = w; } }
    }
};
struct EpiStoreRS {
    static constexpr bool PERM = true, AFTER_DRAIN = false;
    bf16_t* O; int ldc; int npn; const float* rs;
    __device__ __forceinline__ void operator()(const f32x4 (&acc)[2][2][4][2], const Unit& u, int wr, int wc, int fr, int fq) const {
        const int row0 = u.pm * BM + wr * 64 + fr, col0 = (u.pn % npn) * BM + wc * 32 + 8 * fq;
        float rsall[2][4];
#pragma unroll
        for (int ai = 0; ai < 2; ++ai)
#pragma unroll
            for (int m = 0; m < 4; ++m) rsall[ai][m] = rs[row0 + ai * HALF + m * 16];
#pragma unroll
        for (int ai = 0; ai < 2; ++ai)
#pragma unroll
            for (int m = 0; m < 4; ++m) { const int row = row0 + ai * HALF + m * 16; bf16_t* rowp = O + (size_t)row * ldc + col0; const float osc = rsall[ai][m];
#pragma unroll
                for (int bj = 0; bj < 2; ++bj) { const f32x4 v0 = acc[ai][bj][m][0] * osc, v1 = acc[ai][bj][m][1] * osc;
                    u32x4 w; w.x = pkbf(v0[0], v0[1]); w.y = pkbf(v0[2], v0[3]); w.z = pkbf(v1[0], v1[1]); w.w = pkbf(v1[2], v1[3]);
                    *(u32x4*)(rowp + bj * HALF) = w; } }
    }
};
struct EpiStore8 {
    static constexpr bool PERM = true, AFTER_DRAIN = false;
    unsigned char* O; int ldc; int npn; float osc;
    __device__ __forceinline__ void operator()(const f32x4 (&acc)[2][2][4][2], const Unit& u, int wr, int wc, int fr, int fq) const {
        const int row0 = u.pm * BM + wr * 64 + fr, col0 = (u.pn % npn) * BM + wc * 32 + 8 * fq;
#pragma unroll
        for (int ai = 0; ai < 2; ++ai)
#pragma unroll
            for (int m = 0; m < 4; ++m) { unsigned char* rowp = O + (size_t)(row0 + ai * HALF + m * 16) * ldc + col0;
#pragma unroll
                for (int bj = 0; bj < 2; ++bj) { const f32x4 v0 = acc[ai][bj][m][0] * osc, v1 = acc[ai][bj][m][1] * osc;
                    u32x2 w; w.x = pk4_fp8(v0[0], v0[1], v0[2], v0[3]); w.y = pk4_fp8(v1[0], v1[1], v1[2], v1[3]);
                    *(u32x2*)(rowp + bj * HALF) = w; } }
    }
};
struct EpiGelu {
    static constexpr bool PERM = true, AFTER_DRAIN = false;
    bf16_t* O; int ldc; float* stat; int vtile0; const float* rs; PG8_LAS float* red; int nrows;
    __device__ __forceinline__ void operator()(const f32x4 (&acc)[2][2][4][2], const Unit& u, int wr, int wc, int fr, int fq) const {
        const int row0 = u.pm * BM + wr * 64 + fr, col0 = u.pn * BM + wc * 32 + 8 * fq;
        const bool isv = u.pn >= vtile0;
        float rsall[2][4];
#pragma unroll
        for (int ai = 0; ai < 2; ++ai)
#pragma unroll
            for (int m = 0; m < 4; ++m) rsall[ai][m] = rs[row0 + ai * HALF + m * 16];
#pragma unroll
        for (int ai = 0; ai < 2; ++ai)
#pragma unroll
            for (int m = 0; m < 4; ++m) { const int row = row0 + ai * HALF + m * 16; bf16_t* rowp = O + (size_t)row * ldc + col0; float s1 = 0.f, s2 = 0.f; const float rsc = rsall[ai][m];
                f2v s1v = (f2v){0.f, 0.f}, s2v = (f2v){0.f, 0.f};
#pragma unroll
                for (int bj = 0; bj < 2; ++bj) { const f32x4 v0 = acc[ai][bj][m][0] * rsc, v1 = acc[ai][bj][m][1] * rsc;
                    const f2v g0 = gelu_tanh2((f2v){v0[0], v0[1]}), g1 = gelu_tanh2((f2v){v0[2], v0[3]}), g2 = gelu_tanh2((f2v){v1[0], v1[1]}), g3 = gelu_tanh2((f2v){v1[2], v1[3]});
                    s1v += (g0 + g1) + (g2 + g3); s2v += g0 * g0; s2v += g1 * g1; s2v += g2 * g2; s2v += g3 * g3;
                    u32x4 w; w.x = pkbf(g0.x, g0.y); w.y = pkbf(g1.x, g1.y); w.z = pkbf(g2.x, g2.y); w.w = pkbf(g3.x, g3.y);
                    *(u32x4*)(rowp + bj * HALF) = w; }
                s1 = s1v.x + s1v.y; s2 = s2v.x + s2v.y;
                if (isv) { s1 += __shfl_xor(s1, 16); s1 += __shfl_xor(s1, 32); s2 += __shfl_xor(s2, 16); s2 += __shfl_xor(s2, 32);
                    if (fq == 0) { PG8_LAS float* rp = red + (((wr * 4 + wc) * 128 + ai * 64 + m * 16 + fr) << 1); rp[0] = s1; rp[1] = s2; } } }
        if (isv) {
            asm volatile("s_waitcnt lgkmcnt(0)" ::: "memory"); __builtin_amdgcn_s_barrier(); asm volatile("" ::: "memory");
            if (wc == 0) {
#pragma unroll
                for (int k = 0; k < 2; ++k) { const int rl = fq * 16 + fr + 64 * k; float t1 = 0.f, t2 = 0.f;
#pragma unroll
                    for (int w = 0; w < 4; ++w) { const PG8_LAS float* rp = red + (((wr * 4 + w) * 128 + rl) << 1); t1 += rp[0]; t2 += rp[1]; }
                    const int row = u.pm * BM + (rl >> 6) * HALF + wr * 64 + (rl & 63);
                    f2v o; o.x = t1; o.y = t2; *(f2v*)(stat + ((size_t)(u.pn - vtile0) * nrows + row) * 2) = o; } }
        }
    }
};
struct EpiGlu {
    static constexpr bool PERM = true, AFTER_DRAIN = false;
    const bf16_t* G; int ldg; bf16_t* O; int ldo; int ocol0; const float* bias;
    __device__ __forceinline__ void operator()(const f32x4 (&acc)[2][2][4][2], const Unit& u, int wr, int wc, int fr, int fq) const {
        const int row0 = u.pm * BM + wr * 64 + fr, col0 = u.pn * BM + wc * 32 + 8 * fq;
        f32x4 bv[2][2];
#pragma unroll
        for (int bj = 0; bj < 2; ++bj)
#pragma unroll
            for (int n = 0; n < 2; ++n) bv[bj][n] = *(const f32x4*)(bias + col0 + bj * HALF + 4 * n);
        u32x4 gall[2][4][2];
#pragma unroll
        for (int ai = 0; ai < 2; ++ai)
#pragma unroll
            for (int m = 0; m < 4; ++m)
#pragma unroll
                for (int bj = 0; bj < 2; ++bj) gall[ai][m][bj] = *(const u32x4*)(G + (size_t)(row0 + ai * HALF + m * 16) * ldg + col0 + bj * HALF);
#pragma unroll
        for (int ai = 0; ai < 2; ++ai)
#pragma unroll
            for (int m = 0; m < 4; ++m) { const int row = row0 + ai * HALF + m * 16;
#pragma unroll
                for (int bj = 0; bj < 2; ++bj) { const f32x4 v0 = acc[ai][bj][m][0] + bv[bj][0], v1 = acc[ai][bj][m][1] + bv[bj][1];
                    const u32x4 gw = gall[ai][m][bj];
                    u32x4 w;
                    w.x = pkbf(bflo(gw.x) * sigmoidf_(v0[0]), bfhi(gw.x) * sigmoidf_(v0[1]));
                    w.y = pkbf(bflo(gw.y) * sigmoidf_(v0[2]), bfhi(gw.y) * sigmoidf_(v0[3]));
                    w.z = pkbf(bflo(gw.z) * sigmoidf_(v1[0]), bfhi(gw.z) * sigmoidf_(v1[1]));
                    w.w = pkbf(bflo(gw.w) * sigmoidf_(v1[2]), bfhi(gw.w) * sigmoidf_(v1[3]));
                    *(u32x4*)(O + (size_t)row * ldo + ocol0 + col0 + bj * HALF) = w; } }
    }
};
struct EpiSwiglu8 {
    static constexpr bool PERM = true, AFTER_DRAIN = false;
    unsigned char* O; int ldc; int npn; float osc, hsc; int guard;
    __device__ __forceinline__ void operator()(const f32x4 (&acc)[2][2][4][2], const Unit& u, int wr, int wc, int fr, int fq) const {
        const int row0 = (guard == 12346 ? (int)blockIdx.x : u.pm) * BM + wr * 64 + fr, col0 = (guard == 12346 ? 0 : (u.pn % npn)) * HALF + wc * 32 + 8 * fq;
#pragma unroll
        for (int ai = 0; ai < 2; ++ai)
#pragma unroll
            for (int m = 0; m < 4; ++m) { const f32x4 a0 = acc[ai][0][m][0], a1 = acc[ai][0][m][1], b0 = acc[ai][1][m][0], b1 = acc[ai][1][m][1];
                const float c1 = osc * (-1.4426950408889634f), c2 = osc * osc * hsc;
                const f2v h0 = swiglu2((f2v){a0[0], a0[1]}, (f2v){b0[0], b0[1]}, c1, c2), h1 = swiglu2((f2v){a0[2], a0[3]}, (f2v){b0[2], b0[3]}, c1, c2);
                const f2v h2 = swiglu2((f2v){a1[0], a1[1]}, (f2v){b1[0], b1[1]}, c1, c2), h3 = swiglu2((f2v){a1[2], a1[3]}, (f2v){b1[2], b1[3]}, c1, c2);
                u32x2 w; w.x = pk4_fp8(h0.x, h0.y, h1.x, h1.y); w.y = pk4_fp8(h2.x, h2.y, h3.x, h3.y);
                if (guard != 12345 || wr == 1) *(u32x2*)(O + (size_t)(row0 + ai * HALF + m * 16) * ldc + col0) = w; }
    }
};
struct EpiRes {
    static constexpr bool PERM = false, AFTER_DRAIN = false;
    const float* base; float* out; int ldc;
    __device__ __forceinline__ void operator()(const f32x4 (&acc)[2][2][4][2], const Unit& u, int wr, int wc, int fr, int fq) const {
        const int row0 = u.pm * BM + wr * 64 + fr, col0 = u.pn * BM + wc * 32 + 4 * fq;
#pragma unroll
        for (int ai = 0; ai < 2; ++ai)
#pragma unroll
            for (int m = 0; m < 4; ++m) { const size_t off = (size_t)(row0 + ai * HALF + m * 16) * ldc + col0;
#pragma unroll
                for (int bj = 0; bj < 2; ++bj)
#pragma unroll
                    for (int n = 0; n < 2; ++n) { const f32x4 bs = *(const f32x4*)(base + off + bj * HALF + n * 16); *(f32x4*)(out + off + bj * HALF + n * 16) = bs + acc[ai][bj][m][n]; } }
    }
};
template <class Epi, class Sched, bool ALIGN_EPI = false, bool SP2 = false, bool F8 = false, bool GATHER = false>
__device__ __forceinline__ void gemm_phase(PG8_LAS unsigned char* lds, const Gemm g, const Sched& S, const Epi& E) {
    int tid_ = threadIdx.x; asm volatile("" : "+v"(tid_));
    const int tid = tid_, wid = __builtin_amdgcn_readfirstlane(tid >> 6), lane = tid & 63, wr = wid >> 2, wc = wid & 3, fr = lane & 15, fq = lane >> 4;
    const int K = g.K, nt = K / BK;
    unsigned voffA[2], voffB[2];
#pragma unroll
    for (int i = 0; i < 2; ++i) { int R, C; stage_rc(tid * 16 + i * 8192, R, C); const int Rb = Epi::PERM ? ((R & ~31) + perm32(R & 31)) : R;
        voffA[i] = (unsigned)(R * K + C) * 2u; voffB[i] = (unsigned)(Rb * K + C) * 2u; }
    PG8_LAS int* rowtab = (PG8_LAS int*)(lds + STAGE_BYTES);
    unsigned vAc[2][2] = {{0u, 0u}, {0u, 0u}};
#define PG8_ROWDMA(pm_) do { if (wid < 4) __builtin_amdgcn_global_load_lds((const unsigned*)(g.rowtok + (pm_) * BM + wid * 64 + lane), (PG8_LAS unsigned*)(rowtab + wid * 64), 4, 0, 0); } while (0)
#define PG8_ROWREAD(dst) do { int tt_ = tid; asm volatile("" : "+v"(tt_));   \
        _Pragma("unroll") for (int i_ = 0; i_ < 2; ++i_) { int R_, C_; stage_rc(tt_ * 16 + i_ * 8192, R_, C_); \
            _Pragma("unroll") for (int h_ = 0; h_ < 2; ++h_) dst[h_][i_] = (unsigned)rowtab[h_ * HALF + R_] * (unsigned)(K * 2) + (unsigned)C_ * 2u; } } while (0)
#define PG8_STAGE_A(bufoff, gbase, half, usenext) do { if constexpr (GATHER) { PG8_STAGE(bufoff, gbase, vAc[half]); } \
        else { PG8_STAGE(bufoff, (gbase) + ((half) ? hstep : (size_t)0), voffA); } } while (0)
    const size_t kstep = (size_t)(BK * 2);
    const size_t hstep = (size_t)HALF * K * 2;
    const size_t tstep = 2 * hstep;
    const unsigned ldsw = (unsigned)wid * 1024u;
    const int aoff = lds_byte(wr * 64 + fr, fq * 8), boff = lds_byte(wc * 32 + fr, fq * 8);
#define PG8_SA(b, h) (((b) * 2 + (h)) * HTB)
#define PG8_SB(b, h) ((4 + (b) * 2 + (h)) * HTB)
#define PG8_STAGE(bufoff, gbase, voff) do { _Pragma("unroll") for (int _i = 0; _i < 2; ++_i) \
        __builtin_amdgcn_global_load_lds((const unsigned*)((const char*)(gbase) + (voff)[_i]), (PG8_LAS unsigned*)(lds + (bufoff) + ldsw + _i * 8192), 16, 0, 0); } while (0)
#define PG8_LDA(dst, b, h) do { _Pragma("unroll") for (int m = 0; m < 4; ++m) _Pragma("unroll") for (int k = 0; k < 2; ++k) dst[m][k] = *(const PG8_LAS bf16x8*)(lds + PG8_SA(b, h) + aoff + m * 2048 + k * 1024); } while (0)
#define PG8_LDB(dst, b, h) do { _Pragma("unroll") for (int n = 0; n < 2; ++n) _Pragma("unroll") for (int k = 0; k < 2; ++k) dst[n][k] = *(const PG8_LAS bf16x8*)(lds + PG8_SB(b, h) + boff + n * 2048 + k * 1024); } while (0)
#define PG8_MMA(ai, bj, At, Bt) do { __builtin_amdgcn_s_setprio(1); \
        if constexpr (F8) { _Pragma("unroll") for (int m = 0; m < 4; ++m) _Pragma("unroll") for (int n = 0; n < 2; ++n) \
            asm volatile("v_mfma_scale_f32_16x16x128_f8f6f4 %0, %1, %2, %0, %3, %3 op_sel_hi:[0,0,0]" : "+v"(acc[ai][bj][m][n]) : "v"(cat8(Bt[n][0], Bt[n][1])), "v"(cat8(At[m][0], At[m][1])), "v"(0x7f7f7f7f)); } \
        else { _Pragma("unroll") for (int m = 0; m < 4; ++m) _Pragma("unroll") for (int n = 0; n < 2; ++n) _Pragma("unroll") for (int k = 0; k < 2; ++k) \
            acc[ai][bj][m][n] = __builtin_amdgcn_mfma_f32_16x16x32_bf16(Bt[n][k], At[m][k], acc[ai][bj][m][n], 0, 0, 0); } \
        __builtin_amdgcn_s_setprio(0); } while (0)
#define PG8_WAIT_V(n) asm volatile("s_waitcnt vmcnt(" #n ")" ::: "memory")
#define PG8_WAIT_L(n) asm volatile("s_waitcnt lgkmcnt(" #n ")" ::: "memory")
#define PG8_BAR __builtin_amdgcn_s_barrier()
#define PG8_SCHED __builtin_amdgcn_sched_barrier(0)
#define PG8_ACCFENCE(NOPS) do { if constexpr (F8) { _Pragma("unroll") for (int a_ = 0; a_ < 2; ++a_) _Pragma("unroll") for (int b_ = 0; b_ < 2; ++b_) \
        asm volatile(NOPS : "+v"(acc[a_][b_][0][0]), "+v"(acc[a_][b_][0][1]), "+v"(acc[a_][b_][1][0]), "+v"(acc[a_][b_][1][1]), "+v"(acc[a_][b_][2][0]), "+v"(acc[a_][b_][2][1]), "+v"(acc[a_][b_][3][0]), "+v"(acc[a_][b_][3][1])); } } while (0)
    Unit cur, nxt; int ui = 0;
    if (!S.next(0, cur)) return;
    f32x4 acc[2][2][4][2];
#pragma unroll
    for (int a = 0; a < 2; ++a)
#pragma unroll
        for (int b = 0; b < 2; ++b)
#pragma unroll
            for (int m = 0; m < 4; ++m)
#pragma unroll
                for (int n = 0; n < 2; ++n) acc[a][b][m][n] = (f32x4){0.f, 0.f, 0.f, 0.f};
    PG8_ACCFENCE("s_nop 1");
    bf16x8 At[4][2], B0[2][2], B1[2][2];
    const char* cA = GATHER ? (const char*)g.A : (const char*)g.A + (size_t)cur.pm * tstep; const char* cB = (const char*)g.Bt + (size_t)cur.pn * tstep;
    S.a_ready(cur);
    if constexpr (GATHER) { PG8_ROWDMA(cur.pm); PG8_WAIT_V(0); PG8_BAR; PG8_ROWREAD(vAc); PG8_WAIT_L(0); PG8_BAR; }
    if constexpr (SP2) {
        PG8_STAGE(PG8_SB(0, 0), cB, voffB); PG8_STAGE(PG8_SB(0, 1), cB + hstep, voffB); PG8_STAGE_A(PG8_SA(0, 0), cA, 0, false); PG8_STAGE_A(PG8_SA(0, 1), cA, 1, false);
        if (wr == 1) PG8_BAR;
        PG8_WAIT_V(2); PG8_BAR;
        PG8_STAGE(PG8_SB(1, 0), cB + kstep, voffB); PG8_STAGE_A(PG8_SA(1, 0), cA + kstep, 0, false); PG8_STAGE(PG8_SB(1, 1), cB + hstep + kstep, voffB);
        PG8_WAIT_V(6); PG8_BAR;
    } else {
        PG8_STAGE(PG8_SB(0, 0), cB, voffB); PG8_STAGE(PG8_SA(0, 0), cA, voffA); PG8_STAGE(PG8_SB(0, 1), cB + hstep, voffB); PG8_STAGE(PG8_SA(0, 1), cA + hstep, voffA);
        if (wr == 1) PG8_BAR;
        PG8_WAIT_V(4); PG8_BAR;
        PG8_STAGE(PG8_SB(1, 0), cB + kstep, voffB); PG8_STAGE(PG8_SA(1, 0), cA + kstep, voffA); PG8_STAGE(PG8_SB(1, 1), cB + hstep + kstep, voffB);
        PG8_WAIT_V(6); PG8_BAR;
    }
    for (;;) {
        const bool has_next = S.next(ui + 1, nxt);
        const char* nA = (has_next && !GATHER) ? (const char*)g.A + (size_t)nxt.pm * tstep : cA;
        if constexpr (GATHER) { if (has_next) PG8_ROWDMA(nxt.pm); } const char* nB = has_next ? (const char*)g.Bt + (size_t)nxt.pn * tstep : cB;
        for (int t = 0; t < nt; t += 2) {
            const bool last = (t == nt - 2);
            const char* a1 = cA + (size_t)(t + 1) * kstep;
            const char* a2 = last ? nA : cA + (size_t)(t + 2) * kstep; const char* b2 = last ? nB : cB + (size_t)(t + 2) * kstep;
            const char* a3 = a2 + kstep; const char* b3 = b2 + kstep;
            if (last && has_next) S.a_ready(nxt);

            if constexpr (SP2) {
            PG8_LDB(B0, 0, 0); PG8_LDB(B1, 0, 1); PG8_SCHED; PG8_LDA(At, 0, 0); PG8_STAGE_A(PG8_SA(1, 1), a1, 1, false);
            if constexpr (GATHER) { if (last && has_next) PG8_ROWREAD(vAc); }
            PG8_WAIT_V(8); PG8_WAIT_L(0); PG8_BAR; PG8_MMA(0, 0, At, B0); PG8_MMA(0, 1, At, B1); PG8_BAR; PG8_SCHED;
            PG8_LDA(At, 0, 1); PG8_STAGE(PG8_SB(0, 0), b2, voffB); PG8_STAGE(PG8_SB(0, 1), b2 + hstep, voffB); PG8_STAGE_A(PG8_SA(0, 0), a2, 0, last);
            PG8_WAIT_V(8); PG8_WAIT_L(0); PG8_BAR; PG8_MMA(1, 0, At, B0); PG8_MMA(1, 1, At, B1); PG8_BAR; PG8_SCHED;
            PG8_LDB(B0, 1, 0); PG8_LDB(B1, 1, 1); PG8_SCHED; PG8_LDA(At, 1, 0); PG8_STAGE_A(PG8_SA(0, 1), a2, 1, last);
            PG8_WAIT_V(8); PG8_WAIT_L(0); PG8_BAR; PG8_MMA(0, 0, At, B0); PG8_MMA(0, 1, At, B1); PG8_BAR; PG8_SCHED;
            PG8_LDA(At, 1, 1); PG8_STAGE(PG8_SB(1, 0), b3, voffB); PG8_STAGE(PG8_SB(1, 1), b3 + hstep, voffB); PG8_STAGE_A(PG8_SA(1, 0), a3, 0, last);
            PG8_WAIT_V(8); PG8_WAIT_L(0); PG8_BAR; PG8_MMA(1, 0, At, B0); PG8_MMA(1, 1, At, B1); PG8_BAR; PG8_SCHED;
            } else {
            PG8_LDB(B0, 0, 0); PG8_SCHED; PG8_LDA(At, 0, 0); PG8_STAGE(PG8_SA(1, 1), a1 + hstep, voffA);
            PG8_WAIT_L(8); PG8_BAR; PG8_WAIT_L(0); PG8_MMA(0, 0, At, B0); PG8_BAR; PG8_SCHED;
            PG8_LDB(B1, 0, 1); PG8_STAGE(PG8_SB(0, 0), b2, voffB);
            PG8_BAR; PG8_WAIT_L(0); PG8_MMA(0, 1, At, B1); PG8_BAR;
            PG8_LDA(At, 0, 1); PG8_STAGE(PG8_SA(0, 0), a2, voffA);
            PG8_BAR; PG8_WAIT_L(0); PG8_MMA(1, 0, At, B0); PG8_BAR; PG8_SCHED;
            PG8_STAGE(PG8_SB(0, 1), b2 + hstep, voffB);
            PG8_WAIT_V(6); PG8_BAR; PG8_MMA(1, 1, At, B1); PG8_BAR;
            PG8_LDB(B0, 1, 0); PG8_SCHED; PG8_LDA(At, 1, 0); PG8_STAGE(PG8_SA(0, 1), a2 + hstep, voffA);
            PG8_WAIT_L(8); PG8_BAR; PG8_WAIT_L(0); PG8_MMA(0, 0, At, B0); PG8_BAR; PG8_SCHED;
            PG8_LDB(B1, 1, 1); PG8_STAGE(PG8_SB(1, 0), b3, voffB);
            PG8_BAR; PG8_WAIT_L(0); PG8_MMA(0, 1, At, B1); PG8_BAR;
            PG8_LDA(At, 1, 1); PG8_STAGE(PG8_SA(1, 0), a3, voffA);
            PG8_BAR; PG8_WAIT_L(0); PG8_MMA(1, 0, At, B0); PG8_BAR; PG8_SCHED;
            PG8_STAGE(PG8_SB(1, 1), b3 + hstep, voffB);
            PG8_WAIT_V(6); PG8_BAR; PG8_MMA(1, 1, At, B1); PG8_BAR;
            }
        }
        PG8_ACCFENCE("s_nop 15\n\ts_nop 7");
        if constexpr (ALIGN_EPI) { if (wr == 0) PG8_BAR; }
        if constexpr (!Epi::AFTER_DRAIN) { E(acc, cur, wr, wc, fr, fq); S.done(cur); }
        if (!has_next) break;
#pragma unroll
        for (int a = 0; a < 2; ++a)
#pragma unroll
            for (int b = 0; b < 2; ++b)
#pragma unroll
                for (int m = 0; m < 4; ++m)
#pragma unroll
                    for (int n = 0; n < 2; ++n) acc[a][b][m][n] = (f32x4){0.f, 0.f, 0.f, 0.f};
        PG8_ACCFENCE("s_nop 1");
        cur = nxt; cA = nA; cB = nB; ++ui;
        if constexpr (ALIGN_EPI) { if (wr == 1) PG8_BAR; }
    }
    PG8_WAIT_V(0);
    if constexpr (!ALIGN_EPI) { if (wr == 0) PG8_BAR; }
    PG8_BAR;
    if constexpr (Epi::AFTER_DRAIN) { E.fused(acc, cur, wr, wc, fr, fq, lds, wid, lane); S.done(cur); }
#undef PG8_SA
#undef PG8_SB
#undef PG8_STAGE
#undef PG8_LDA
#undef PG8_LDB
#undef PG8_MMA
#undef PG8_WAIT_V
#undef PG8_WAIT_L
#undef PG8_BAR
#undef PG8_SCHED
#undef PG8_ROWDMA
#undef PG8_ROWREAD
#undef PG8_STAGE_A
#undef PG8_ACCFENCE
}
}

constexpr int NWAVES = 8, NT = NWAVES * 64;
#ifndef MK_N_LAUNCHES
#define MK_N_LAUNCHES 1
#endif
constexpr int BATCH = 4, SEQ = 4096, D = 2048, M = BATCH * SEQ;
constexpr int AW = 1024, KVW = 256, SW = 1024, EIN = 2560;
constexpr int QOFF = 0, KOFF = 1024, VOFF = 1280, UOFF = 1536;
constexpr int NE = 16, CAP = 512, FF = 2048, MS = NE * BATCH * CAP;
constexpr int GW = 2048, ZW = 4096;
constexpr float EPS = 1e-6f;

constexpr size_t MiB = 1u << 20, KiB = 1u << 10;
constexpr size_t WS_CTL = 0, CTL_ZERO_BYTES = 1 * MiB;
constexpr int CW_TMO = 0, CW_CODE = 1, CW_BAR = 4096;
constexpr size_t WS_STAT = 256 * KiB;
constexpr size_t WS_LUT = 1 * MiB;
constexpr size_t WS_LAM = WS_LUT + 16 * KiB;
constexpr size_t WS_LAM512 = WS_LAM + 64 * KiB;
constexpr size_t WS_BB = WS_LAM512 + 64 * KiB;
constexpr size_t WS_CM = WS_BB + 512 * KiB;
constexpr size_t WS_SGU = WS_CM + 512 * KiB;
constexpr size_t WS_E = 4 * MiB;
constexpr size_t WS_AFF = 6 * MiB;
constexpr size_t WS_IDX = 7 * MiB;
constexpr size_t WS_GATE = WS_IDX + 128 * KiB;
constexpr size_t WS_TOK = WS_IDX + 256 * KiB;
constexpr size_t WS_INV = 8 * MiB;
constexpr size_t WS_STATP = 11 * MiB;
constexpr size_t WS_RSTD0 = 10 * MiB + 64 * KiB;
constexpr size_t WS_RSTD = 10 * MiB;
constexpr size_t WS_WIN0 = 16 * MiB, WS_GLU = 26 * MiB, WS_WOUT0 = 28 * MiB, WS_WIN1 = 36 * MiB, WS_WOUT1 = 52 * MiB;
constexpr size_t WS_W13 = 64 * MiB, WS_W2 = 576 * MiB;
constexpr float WSC = 256.f, HSC = 8.f, HIDSC = 8.f, YSC = 32.f;
constexpr size_t WS_H = 832 * MiB, WS_XA = 896 * MiB, WS_XB = 1024 * MiB;
constexpr size_t WS_X16 = WS_XB + 64 * MiB;
constexpr size_t WS_XS = 1152 * MiB, WS_HID = 1280 * MiB, WS_YS = 1408 * MiB;
constexpr size_t WS_PROJ = 1536 * MiB, WS_CAT = 1616 * MiB, WS_G = 1680 * MiB, WS_YF = 1712 * MiB;
constexpr size_t WS_Z = 1536 * MiB, WS_G2 = 1664 * MiB;
constexpr size_t WS_END = 1776 * MiB;

constexpr int SCR_BYTES = 143360;
constexpr int LDSCTL_OFF = SCR_BYTES, MISC_OFF = LDSCTL_OFF + 320;
constexpr int LDS_BYTES = 151552;
constexpr int EPI_STG_OFF = 131072 + 1024;
static_assert(EPI_STG_OFF + 2 * 32 * 136 <= SCR_BYTES, "epilogue staging");

#define GAS __attribute__((address_space(1)))
#define LAS __attribute__((address_space(3)))
typedef unsigned short bf16;
typedef unsigned v4u __attribute__((ext_vector_type(4)));
typedef unsigned v2u __attribute__((ext_vector_type(2)));
typedef float f32x4 __attribute__((ext_vector_type(4)));
typedef float f32x16 __attribute__((ext_vector_type(16)));
typedef short bf16x8 __attribute__((ext_vector_type(8)));
typedef short s16x4 __attribute__((ext_vector_type(4)));
typedef GAS unsigned gu32;
#define RLX_AGENT __ATOMIC_RELAXED, __HIP_MEMORY_SCOPE_AGENT
#define LDS_WAIT() asm volatile("s_waitcnt lgkmcnt(0)" ::: "memory")
#define VM_WAIT() asm volatile("s_waitcnt vmcnt(0)" ::: "memory")
using pg8::pkbf; using pg8::pk4_fp8; using pg8::bflo; using pg8::bfhi; using pg8::gelu_tanh;
__device__ __forceinline__ bf16 f2bf1(float f) { return (bf16)(pkbf(f, 0.f) & 0xffffu); }
__device__ __forceinline__ float bf2f(bf16 b) { return __builtin_bit_cast(float, ((unsigned)b) << 16); }
#define MFMA32(a, b, c) __builtin_amdgcn_mfma_f32_32x32x16_bf16((a), (b), (c), 0, 0, 0)
#define MFMA16(a, b, c) __builtin_amdgcn_mfma_f32_16x16x32_bf16((a), (b), (c), 0, 0, 0)
__device__ __forceinline__ int crow(int reg, int h) { return (reg & 3) + 8 * (reg >> 2) + 4 * h; }
__device__ __forceinline__ float wave_sum(float v) {
#pragma unroll
    for (int o = 1; o < 64; o <<= 1) v += __shfl_xor(v, o);
    return v;
}
#define XB_TMO      128
#define XB_XCNT(j)  (256  + 64 * (j))
#define XB_XSUB(j)  (1280 + 64 * (j))
#define XB_XGEN(j)  (2304 + 64 * (j))
#define XB_TOP      3328
#define XB_TOPGEN   3392
#define XCD_BAR_WORDS 3456
#define XB_SPIN_CAP (1u << 18)

__device__ __forceinline__ unsigned xb_ld(unsigned* p)              { return __hip_atomic_load(p, __ATOMIC_RELAXED, __HIP_MEMORY_SCOPE_AGENT); }
__device__ __forceinline__ unsigned xb_add(unsigned* p, unsigned v) { return __hip_atomic_fetch_add(p, v, __ATOMIC_RELAXED, __HIP_MEMORY_SCOPE_AGENT); }
__device__ __forceinline__ unsigned xb_xcc_id() { return (unsigned)__builtin_amdgcn_s_getreg((3 << 11) | 20) & 0xFu; }
#define XB_SPIN(cond, bar) do { unsigned _sp = 0; while (cond) { __builtin_amdgcn_s_sleep(1); \
    if ((++_sp & 255u) == 0u) { if (xb_ld(&(bar)[XB_TMO])) break; if (_sp > XB_SPIN_CAP) { atomicAdd(&(bar)[XB_TMO], 1u); break; } } } } while (0)

struct XcdBarrier {
    unsigned* bar; unsigned x;
    volatile LAS unsigned* st;
};

__device__ __forceinline__ XcdBarrier xcd_barrier_post(unsigned* bar, volatile LAS unsigned* st) {
    XcdBarrier b; b.bar = bar; b.x = xb_xcc_id(); b.st = st;
    if (threadIdx.x == 0) (void)xb_add(&bar[XB_XCNT(b.x)], 1u);
    return b;
}
__device__ __forceinline__ void xcd_barrier_complete(unsigned* bar, unsigned x, unsigned& nloc, unsigned& nx) {
    const unsigned G = gridDim.x * gridDim.y * gridDim.z;
    unsigned sum, cnt, mine, sp = 0u;
    for (;;) {
        sum = 0u; cnt = 0u; mine = 0u;
#pragma unroll
        for (unsigned j = 0; j < 16; ++j) { const unsigned c = xb_ld(&bar[XB_XCNT(j)]); sum += c; cnt += (c > 0u) ? 1u : 0u; mine = (j == x) ? c : mine; }
        if (sum == G) break;
        __builtin_amdgcn_s_sleep(1);
        if ((++sp & 255u) == 0u) { if (xb_ld(&bar[XB_TMO])) break; if (sp > XB_SPIN_CAP) { atomicAdd(&bar[XB_TMO], 1u); break; } }
    }
    nloc = mine > 0u ? mine : 1u; nx = cnt > 0u ? cnt : 1u;
}

__device__ __forceinline__ void xcd_barrier(const XcdBarrier& b) {
    asm volatile("s_waitcnt vmcnt(0)" ::: "memory");
    __syncthreads();
    if (threadIdx.x == 0) {
        unsigned* bar = b.bar;
        __builtin_amdgcn_s_waitcnt(0);
        unsigned nloc = b.st[0], nx = b.st[1];
        if (nloc == 0u) { xcd_barrier_complete(bar, b.x, nloc, nx); b.st[0] = nloc; b.st[1] = nx; }
        const unsigned old = xb_add(&bar[XB_XSUB(b.x)], 1u);
        const unsigned gen = old / nloc;
        if (old + 1u == (gen + 1u) * nloc) {
            __builtin_amdgcn_fence(__ATOMIC_RELEASE, "agent");
            asm volatile("s_waitcnt vmcnt(0)" ::: "memory");
            const unsigned og = xb_add(&bar[XB_TOP], 1u);
            const unsigned tg = og / nx;
            if (og + 1u == (tg + 1u) * nx) xb_add(&bar[XB_TOPGEN], 1u);
            else XB_SPIN(xb_ld(&bar[XB_TOPGEN]) == tg, bar);
            __builtin_amdgcn_fence(__ATOMIC_ACQUIRE, "agent");
            xb_add(&bar[XB_XGEN(b.x)], 1u);
            asm volatile("s_waitcnt vmcnt(0)" ::: "memory");
        } else {
            XB_SPIN(xb_ld(&bar[XB_XGEN(b.x)]) == gen, bar);
            __builtin_amdgcn_fence(__ATOMIC_ACQUIRE, "agent");
            asm volatile("s_waitcnt vmcnt(0)" ::: "memory");
        }
    }
    __syncthreads();
}

struct Frame {
    LAS unsigned char* lds;
    volatile LAS unsigned* MISC;
    gu32* ctl;
    unsigned char* ws;
    int tid, lane, wave, vcu, G;
    const float* in[28];
    float* out;
};
enum { I_X = 0, I_RELB, I_MIXN, I_FFNN, I_FINN, I_EWIN, I_SINK, I_ARE, I_AIM, I_LDT, I_BRE, I_BIM, I_CRE, I_CIM, I_SSMD, I_GLUW, I_GLUB, I_EWOUT,
       I_OWIN, I_LNG, I_LNB, I_SGUW, I_SGUB, I_OWOUT, I_ROUTER, I_W1, I_W3, I_W2 };

__device__ __forceinline__ void p0_transpose_item(const float* W, int K, int N, bf16* WT, int row_base, LAS float* scr, int k0, int n0, int lane, const float* kgain = nullptr) {
#pragma unroll 8
    for (int i = 0; i < 32; ++i) { const int kk = 2 * i + (lane >> 5); float w = W[(size_t)(k0 + kk) * N + n0 + (lane & 31)]; if (kgain) w *= kgain[k0 + kk]; scr[kk * 33 + (lane & 31)] = w; }
    LDS_WAIT(); asm volatile("" ::: "memory");
    const int c = lane & 7;
#pragma unroll
    for (int j = 0; j < 4; ++j) { const int n = (lane >> 3) + 8 * j; const LAS float* s = scr + (8 * c) * 33 + n;
        v4u o; o.x = pkbf(s[0 * 33], s[1 * 33]); o.y = pkbf(s[2 * 33], s[3 * 33]); o.z = pkbf(s[4 * 33], s[5 * 33]); o.w = pkbf(s[6 * 33], s[7 * 33]);
        *(GAS v4u*)(WT + (size_t)(row_base + n) * K + k0 + 8 * c) = o; }
    LDS_WAIT(); asm volatile("" ::: "memory");
}
__device__ __forceinline__ void p0_item8_load(const float* W, int N, int k0, int n0, int lane, f32x4 (&t)[16]) {
#pragma unroll
    for (int i = 0; i < 16; ++i) t[i] = *(const GAS f32x4*)(W + (size_t)(k0 + 8 * i + (lane >> 3)) * N + n0 + 4 * (lane & 7));
}
__device__ __forceinline__ unsigned bperm(unsigned hi, unsigned lo, unsigned sel) { return __builtin_amdgcn_perm(hi, lo, sel); }
__device__ __forceinline__ void p0_item8_finish(const f32x4 (&t)[16], int K, unsigned char* WT, int row_base, LAS float* scr, int k0, int lane, float sc) {
    LAS unsigned* tile = (LAS unsigned*)scr;
#pragma unroll
    for (int i = 0; i < 16; ++i) tile[(8 * i + (lane >> 3)) * 9 + (lane & 7)] = pk4_fp8(t[i].x * sc, t[i].y * sc, t[i].z * sc, t[i].w * sc);
    LDS_WAIT(); asm volatile("" ::: "memory");
    const int n4 = lane >> 3, kg = lane & 7;
    unsigned r[16];
#pragma unroll
    for (int j = 0; j < 16; ++j) r[j] = tile[(16 * kg + j) * 9 + n4];
    LDS_WAIT(); asm volatile("" ::: "memory");
    v4u o[4];
#pragma unroll
    for (int q = 0; q < 4; ++q) { const unsigned a = bperm(r[4 * q + 1], r[4 * q], 0x05010400u), b = bperm(r[4 * q + 1], r[4 * q], 0x07030602u), c = bperm(r[4 * q + 3], r[4 * q + 2], 0x05010400u), d = bperm(r[4 * q + 3], r[4 * q + 2], 0x07030602u);
        o[0][q] = bperm(c, a, 0x05040100u); o[1][q] = bperm(c, a, 0x07060302u); o[2][q] = bperm(d, b, 0x05040100u); o[3][q] = bperm(d, b, 0x07060302u); }
#pragma unroll
    for (int b = 0; b < 4; ++b) *(GAS v4u*)(WT + (size_t)(row_base + 4 * n4 + b) * K + k0 + 16 * kg) = o[b];
}
__device__ __forceinline__ int t5_bucket(int rel) {
    const int n = rel < 0 ? -rel : rel; int b;
    if (n < 8) b = n; else { b = 8 + (31 - __clz(n * n)) - 6; if (b > 15) b = 15; }
    return b + (rel > 0 ? 16 : 0);
}
__device__ __forceinline__ void sincos_d(double x, double& s, double& c) {
    const double q = __builtin_rint(x * 0.63661977236758134308);
    const double r = (x - q * 1.57079632673412561417) - q * 6.07710050650619224932e-11;
    const double r2 = r * r;
    const double sp = r * (1.0 + r2 * (-1.0 / 6 + r2 * (1.0 / 120 + r2 * (-1.0 / 5040 + r2 * (1.0 / 362880 + r2 * (-1.0 / 39916800 + r2 * (1.0 / 6227020800.0)))))));
    const double cp = 1.0 + r2 * (-0.5 + r2 * (1.0 / 24 + r2 * (-1.0 / 720 + r2 * (1.0 / 40320 + r2 * (-1.0 / 3628800 + r2 * (1.0 / 479001600.0 + r2 * (-1.0 / 87178291200.0)))))));
    const int qi = (int)((long long)q & 3);
    s = (qi == 0) ? sp : (qi == 1) ? cp : (qi == 2) ? -sp : -cp;
    c = (qi == 0) ? cp : (qi == 1) ? -sp : (qi == 2) ? -cp : sp;
}
constexpr int SS_C1_ = 12, SS_C2_ = 22;
constexpr int IPM = (D / 128) * (FF / 32);
constexpr int EXP_ITEMS = 3 * NE * IPM;
struct ExpItem { const float* W; unsigned char* WT; int row_base, k0, n0; };
__device__ __forceinline__ ExpItem expert_item_desc(Frame& F, int layer, int it) {
    const int which = it / (NE * IPM), r0 = it % (NE * IPM), mat = layer * NE + r0 / IPM, r = r0 % IPM, nb = FF / 32, k0 = 128 * (r / nb), n0 = 32 * (r % nb);
    const size_t moff = (size_t)mat * D * FF; ExpItem e; e.k0 = k0; e.n0 = n0;
    if (which == 0) { e.W = F.in[I_W1] + moff; e.WT = F.ws + WS_W13 + (size_t)mat * 2 * FF * D; e.row_base = (n0 >> 7) * 256 + (n0 & 127); }
    else if (which == 1) { e.W = F.in[I_W3] + moff; e.WT = F.ws + WS_W13 + (size_t)mat * 2 * FF * D; e.row_base = (n0 >> 7) * 256 + 128 + (n0 & 127); }
    else { e.W = F.in[I_W2] + moff; e.WT = F.ws + WS_W2 + (size_t)mat * FF * D; e.row_base = n0; }
    return e;
}
__device__ __forceinline__ void expert_items(Frame& F, LAS float* scr, int layer, int first, int step, int end) {
    for (int it = first; it < end; it += 2 * step) { f32x4 ta[16], tb[16]; const ExpItem ea = expert_item_desc(F, layer, it); const bool hb = it + step < end;
        const ExpItem eb = expert_item_desc(F, layer, hb ? it + step : it);
        p0_item8_load(ea.W, FF, ea.k0, ea.n0, F.lane, ta);
        if (hb) p0_item8_load(eb.W, FF, eb.k0, eb.n0, F.lane, tb);
        p0_item8_finish(ta, D, ea.WT, ea.row_base, scr, ea.k0, F.lane, WSC);
        if (hb) p0_item8_finish(tb, D, eb.WT, eb.row_base, scr, eb.k0, F.lane, WSC); }
}
constexpr int CW_Q = 2048, CW_DONE9 = 2112, CW_Q0 = 2176, CW_DONE1 = 2240, CW_DONE5 = 2304, CW_DONE10 = 2368, CW_DONE12 = 2432, QBATCH = 4;
__device__ __forceinline__ void conv_bg(Frame& F, int layer, gu32* stop, unsigned stopcount) {
    LAS float* scr = (LAS float*)(F.lds + F.wave * 17408);
    for (;;) {
        if (stop) { unsigned d = 0u; if (F.lane == 0) d = __hip_atomic_load(stop, RLX_AGENT); d = (unsigned)__builtin_amdgcn_readfirstlane((int)d); if (d >= stopcount) break; }
        unsigned it0 = 0u; if (F.lane == 0) it0 = __hip_atomic_fetch_add(F.ctl + (layer ? CW_Q : CW_Q0), (unsigned)QBATCH, RLX_AGENT); it0 = (unsigned)__builtin_amdgcn_readfirstlane((int)it0);
        if (layer == 0 && F.G * NWAVES == 2048) it0 += (unsigned)((SS_C1_ + SS_C2_) * 1024);
        if (it0 >= (unsigned)EXP_ITEMS) break;
        expert_items(F, scr, layer, (int)it0, 1, (int)it0 + QBATCH);
    }
}
__device__ __forceinline__ void p0_prologue(Frame& F) {
    LAS float* scr = (LAS float*)(F.lds + F.wave * 17408);
    const int gw = F.vcu * NWAVES + F.wave, NGW = F.G * NWAVES;
    bf16* WIN0 = (bf16*)(F.ws + WS_WIN0); bf16* GLU = (bf16*)(F.ws + WS_GLU); bf16* WOUT0 = (bf16*)(F.ws + WS_WOUT0); bf16* WIN1 = (bf16*)(F.ws + WS_WIN1); bf16* WOUT1 = (bf16*)(F.ws + WS_WOUT1);
    constexpr int I0 = (D / 64) * (EIN / 32), I1 = (SW / 64) * (SW / 32), I2 = (D / 64) * (D / 32), I3 = (D / 64) * (ZW / 32), I4 = I2;
    constexpr int NSM = I0 + I1 + I2 + I3 + I4;
    for (int it = gw; it < NSM; it += NGW) {
        int r = it;
        if (r < I0) { const int nb = EIN / 32; p0_transpose_item(F.in[I_EWIN], D, EIN, WIN0, 32 * (r % nb), scr, 64 * (r / nb), 32 * (r % nb), F.lane, F.in[I_MIXN]); continue; } r -= I0;
        if (r < I1) { const int nb = SW / 32; p0_transpose_item(F.in[I_GLUW], SW, SW, GLU, 32 * (r % nb), scr, 64 * (r / nb), 32 * (r % nb), F.lane); continue; } r -= I1;
        if (r < I2) { const int nb = D / 32; p0_transpose_item(F.in[I_EWOUT], D, D, WOUT0, 32 * (r % nb), scr, 64 * (r / nb), 32 * (r % nb), F.lane); continue; } r -= I2;
        if (r < I3) { const int nb = ZW / 32; p0_transpose_item(F.in[I_OWIN], D, ZW, WIN1, 32 * (r % nb), scr, 64 * (r / nb), 32 * (r % nb), F.lane, F.in[I_MIXN] + D); continue; } r -= I3;
        { const int nb = D / 32; p0_transpose_item(F.in[I_OWOUT], D, D, WOUT1, 32 * (r % nb), scr, 64 * (r / nb), 32 * (r % nb), F.lane); }
    }
    { bf16* SG = (bf16*)(F.ws + WS_SGU); const float* sw = F.in[I_SGUW];
      for (int i = (F.vcu * NT + F.tid) * 4; i < 16 * 128 * 128; i += F.G * NT * 4) { const f32x4 v = *(const f32x4*)(sw + i); v2u w; w.x = pkbf(v.x, v.y); w.y = pkbf(v.z, v.w); *(v2u*)(SG + i) = w; } }
    { float* LUT = (float*)(F.ws + WS_LUT); const float* rb = F.in[I_RELB];
      for (int i = F.vcu * NT + F.tid; i < 8 * 512; i += F.G * NT) { const int hd = i >> 9, rel = (i & 511) - 256; float v = -1e30f; if (rel >= -128 && rel <= 128) v = rb[t5_bucket(rel) * 8 + hd]; LUT[i] = v; } }
    { float* LAM = (float*)(F.ws + WS_LAM); float* LAM512 = (float*)(F.ws + WS_LAM512); bf16* BB = (bf16*)(F.ws + WS_BB); bf16* CM = (bf16*)(F.ws + WS_CM);
      for (int i = F.vcu * NT + F.tid; i < 2 * 64 * 64; i += F.G * NT) {
          const int p = i & 63, dg = i >> 6;
          const double dt = (double)expf(F.in[I_LDT][dg]); const double ar = (double)F.in[I_ARE][i], ai = (double)F.in[I_AIM][i];
          const double mag = (double)expf((float)(ar * dt)); double sn, cs; sincos_d(ai * dt, sn, cs);
          const double lbr = mag * cs, lbi = mag * sn, den = ar * ar + ai * ai, nr = lbr - 1.0;
          const double cr = (nr * ar + lbi * ai) / den, ci = (lbi * ar - nr * ai) / den;
          LAM[2 * i] = (float)lbr; LAM[2 * i + 1] = (float)lbi;
          const double mag5 = (double)expf((float)(512.0 * ar * dt)); double s5, c5; sincos_d(512.0 * ai * dt, s5, c5);
          LAM512[2 * i] = (float)(mag5 * c5); LAM512[2 * i + 1] = (float)(mag5 * s5);
#pragma unroll
          for (int c = 0; c < 16; ++c) { const double br = (double)F.in[I_BRE][(size_t)i * 16 + c], bi = (double)F.in[I_BIM][(size_t)i * 16 + c];
              BB[((size_t)dg * 128 + 2 * p) * 16 + c] = f2bf1((float)(cr * br - ci * bi)); BB[((size_t)dg * 128 + 2 * p + 1) * 16 + c] = f2bf1((float)(cr * bi + ci * br));
              CM[((size_t)dg * 16 + c) * 128 + 2 * p] = f2bf1(F.in[I_CRE][((size_t)dg * 16 + c) * 64 + p]); CM[((size_t)dg * 16 + c) * 128 + 2 * p + 1] = f2bf1(-F.in[I_CIM][((size_t)dg * 16 + c) * 64 + p]); }
      } }
    { bf16* X16 = (bf16*)(F.ws + WS_X16); float* RS0 = (float*)(F.ws + WS_RSTD0);
      for (int m = gw; m < M; m += NGW) { const GAS f32x4* xr = (const GAS f32x4*)(F.in[I_X] + (size_t)m * D) + F.lane; f32x4 v[8]; float s = 0.f;
#pragma unroll
          for (int j = 0; j < 8; ++j) { v[j] = xr[64 * j]; s += (v[j].x * v[j].x + v[j].y * v[j].y) + (v[j].z * v[j].z + v[j].w * v[j].w); }
#pragma unroll
          for (int j = 0; j < 8; ++j) { v2u w; w.x = pkbf(v[j].x, v[j].y); w.y = pkbf(v[j].z, v[j].w); *((GAS v2u*)(X16 + (size_t)m * D) + F.lane + 64 * j) = w; }
          const float rstd = 1.0f / sqrtf(wave_sum(s) * (1.f / D) + EPS); if (F.lane == 0) RS0[m] = rstd; } }
}

constexpr int AT_P = 272;
constexpr int AT_K = 0, AT_VT = 128 * AT_P, AT_LUT = 2 * 128 * AT_P;
__device__ __forceinline__ void attn_unit(Frame& F, int unit) {
    const bf16* PROJ = (const bf16*)(F.ws + WS_PROJ); bf16* CAT = (bf16*)(F.ws + WS_CAT); const float* LUTG = (const float*)(F.ws + WS_LUT);
    const int hp = unit & 1, kvh = (unit >> 1) & 1, blk = (unit >> 2) & 31, b = unit >> 7;
    const int lane = F.lane, r = lane & 31, h = lane >> 5, hh = F.wave >> 2, head = kvh * 4 + hp * 2 + hh, qrow0 = (F.wave & 3) * 32;
    LAS unsigned char* lds = F.lds; LAS float* LUT = (LAS float*)(lds + AT_LUT);
    __syncthreads();
    for (int i = F.tid; i < 1024; i += NT) LUT[i] = LUTG[(kvh * 4 + hp * 2 + (i >> 9)) * 512 + (i & 511)] * 1.4426950408889634f;
    const size_t tq = (size_t)b * SEQ + blk * 128 + qrow0 + r;
    bf16x8 qf[8];
#pragma unroll
    for (int s = 0; s < 8; ++s) qf[s] = *(const bf16x8*)(PROJ + tq * EIN + QOFF + head * 128 + 16 * s + 8 * h);
    float mrun = F.in[I_SINK][head] * 1.4426950408889634f, lrun = 1.0f;
    f32x16 oacc[4];
#pragma unroll
    for (int dt = 0; dt < 4; ++dt)
#pragma unroll
        for (int i = 0; i < 16; ++i) oacc[dt][i] = 0.f;
    const int kb0 = blk > 0 ? blk - 1 : 0, kb1 = blk < SEQ / 128 - 1 ? blk + 1 : SEQ / 128 - 1;
    v4u kreg[4], vreg[4];
#define AT_LOADKV(kb_) do { const size_t tok0_ = (size_t)b * SEQ + (kb_) * 128; _Pragma("unroll") for (int i = 0; i < 4; ++i) { const int c = F.tid + NT * i, row = c >> 4, ch = c & 15, row2 = c & 127, ch2 = c >> 7; \
        kreg[i] = *(const v4u*)(PROJ + (tok0_ + row) * EIN + KOFF + kvh * 128 + ch * 8); vreg[i] = *(const v4u*)(PROJ + (tok0_ + row2) * EIN + VOFF + kvh * 128 + ch2 * 8); } } while (0)
    AT_LOADKV(kb0);
    for (int kb = kb0; kb <= kb1; ++kb) {
        __syncthreads();
#pragma unroll
        for (int i = 0; i < 4; ++i) { const int c = F.tid + NT * i, row = c >> 4, ch = c & 15, row2 = c & 127, ch2 = c >> 7;
            const v4u kv = kreg[i], vv = vreg[i];
            *(LAS v4u*)(lds + AT_K + row * AT_P + ch * 16) = kv;
            LAS bf16* vt = (LAS bf16*)(lds + AT_VT + (ch2 * 8) * AT_P + row2 * 2);
            vt[0 * (AT_P / 2)] = (bf16)(vv.x & 0xffffu); vt[1 * (AT_P / 2)] = (bf16)(vv.x >> 16); vt[2 * (AT_P / 2)] = (bf16)(vv.y & 0xffffu); vt[3 * (AT_P / 2)] = (bf16)(vv.y >> 16);
            vt[4 * (AT_P / 2)] = (bf16)(vv.z & 0xffffu); vt[5 * (AT_P / 2)] = (bf16)(vv.z >> 16); vt[6 * (AT_P / 2)] = (bf16)(vv.w & 0xffffu); vt[7 * (AT_P / 2)] = (bf16)(vv.w >> 16); }
        if (kb < kb1) AT_LOADKV(kb + 1);
        __syncthreads();
#pragma unroll 1
        for (int kp = 0; kp < 2; ++kp) {
            if ((kb < blk && kp == 0 && qrow0 >= 64) || (kb > blk && kp == 1 && qrow0 < 64)) continue;
            f32x16 sacc[2];
#pragma unroll
            for (int q = 0; q < 2; ++q)
#pragma unroll
                for (int i = 0; i < 16; ++i) sacc[q][i] = 0.f;
#pragma unroll
            for (int s = 0; s < 8; ++s) {
                const bf16x8 a0 = *(const LAS bf16x8*)(lds + AT_K + (64 * kp + r) * AT_P + (16 * s + 8 * h) * 2);
                const bf16x8 a1 = *(const LAS bf16x8*)(lds + AT_K + (64 * kp + 32 + r) * AT_P + (16 * s + 8 * h) * 2);
                sacc[0] = MFMA32(a0, qf[s], sacc[0]); sacc[1] = MFMA32(a1, qf[s], sacc[1]); }
            const int relbase = (kb - blk) * 128 + 64 * kp + 4 * h - qrow0 - r + 256 + hh * 512;
            float x[32]; float tmax = -3.0e38f;
#pragma unroll
            for (int q = 0; q < 2; ++q)
#pragma unroll
                for (int i = 0; i < 16; ++i) { x[16 * q + i] = sacc[q][i] * (0.08838834764831845f * 1.4426950408889634f) + LUT[relbase + 32 * q + (i & 3) + 8 * (i >> 2)]; tmax = fmaxf(tmax, x[16 * q + i]); }
            tmax = fmaxf(tmax, __shfl_xor(tmax, 32));
            const float mnew = fmaxf(mrun, tmax);
            if (__ballot(mnew > mrun) != 0ull) {
                const float alpha = __builtin_amdgcn_exp2f(mrun - mnew); lrun *= alpha;
#pragma unroll
                for (int dt = 0; dt < 4; ++dt)
#pragma unroll
                    for (int i = 0; i < 16; ++i) oacc[dt][i] *= alpha;
            }
            mrun = mnew;
            float psum = 0.f;
#pragma unroll
            for (int i = 0; i < 32; ++i) { x[i] = __builtin_amdgcn_exp2f(x[i] - mnew); psum += x[i]; }
            psum += __shfl_xor(psum, 32);
            lrun += psum;
            bf16x8 pb[4];
#pragma unroll
            for (int s2 = 0; s2 < 4; ++s2) { v4u w; w.x = pkbf(x[8 * s2 + 0], x[8 * s2 + 1]); w.y = pkbf(x[8 * s2 + 2], x[8 * s2 + 3]); w.z = pkbf(x[8 * s2 + 4], x[8 * s2 + 5]); w.w = pkbf(x[8 * s2 + 6], x[8 * s2 + 7]); pb[s2] = __builtin_bit_cast(bf16x8, w); }
#pragma unroll
            for (int s2 = 0; s2 < 4; ++s2)
#pragma unroll
                for (int dt = 0; dt < 4; ++dt) { const LAS unsigned char* vp = lds + AT_VT + (32 * dt + r) * AT_P + (64 * kp + 16 * s2 + 4 * h) * 2;
                    const s16x4 lo = *(const LAS s16x4*)vp, hi = *(const LAS s16x4*)(vp + 16);
                    const bf16x8 a = __builtin_shufflevector(lo, hi, 0, 1, 2, 3, 4, 5, 6, 7);
                    oacc[dt] = MFMA32(a, pb[s2], oacc[dt]); }
        }
    }
#undef AT_LOADKV
    __syncthreads();
    const float inv = 1.0f / lrun;
    LAS unsigned char* ob = lds + F.wave * (32 * AT_P);
#pragma unroll
    for (int dt = 0; dt < 4; ++dt)
#pragma unroll
        for (int i = 0; i < 16; ++i) *(LAS bf16*)(ob + r * AT_P + (32 * dt + crow(i, h)) * 2) = f2bf1(oacc[dt][i] * inv);
    LDS_WAIT(); asm volatile("" ::: "memory");
    const size_t trow0 = (size_t)b * SEQ + blk * 128 + qrow0;
#pragma unroll
    for (int i = 0; i < 8; ++i) { const int c = lane + 64 * i, row = c >> 4, ch = c & 15;
        const v4u v = *(const LAS v4u*)(ob + row * AT_P + ch * 16);
        *(GAS v4u*)(CAT + (trow0 + row) * D + head * 128 + ch * 8) = v; }
}

constexpr int SS_XP = 66;
constexpr int SS_HP = 272;
constexpr int SS_SP = 20;
constexpr int SS_TILE8 = 64 * 36;
constexpr int SS_WAVE_BYTES = 32 * SS_HP + 32 * SS_SP * 4 + SS_TILE8;
constexpr int SS_C1 = SS_C1_, SS_C2 = SS_C2_;
struct HalfItem { const float* W; unsigned char* WT; int row_base, k0, n0; };
__device__ __forceinline__ HalfItem half_item_desc(Frame& F, int hid) { const ExpItem e = expert_item_desc(F, 0, hid >> 1); HalfItem h; h.W = e.W; h.WT = e.WT; h.row_base = e.row_base; h.k0 = e.k0 + 64 * (hid & 1); h.n0 = e.n0; return h; }
__device__ __forceinline__ void half_load(const HalfItem& h, int lane, f32x4 (&t)[8]) {
#pragma unroll
    for (int i = 0; i < 8; ++i) t[i] = *(const GAS f32x4*)(h.W + (size_t)(h.k0 + 8 * i + (lane >> 3)) * FF + h.n0 + 4 * (lane & 7));
}
__device__ __forceinline__ void half_finish(const HalfItem& h, const f32x4 (&t)[8], LAS unsigned* tile, int lane) {
#pragma unroll
    for (int i = 0; i < 8; ++i) tile[(8 * i + (lane >> 3)) * 9 + (lane & 7)] = pk4_fp8(t[i].x * WSC, t[i].y * WSC, t[i].z * WSC, t[i].w * WSC);
    LDS_WAIT(); asm volatile("" ::: "memory");
    const int kg = lane & 3, n4 = (lane >> 2) & 7, hf = lane >> 5;
    unsigned r[16];
#pragma unroll
    for (int j = 0; j < 16; ++j) r[j] = tile[(16 * kg + j) * 9 + n4];
    LDS_WAIT(); asm volatile("" ::: "memory");
    const unsigned selA = hf ? 0x07030602u : 0x05010400u;
    v4u o0, o1;
#pragma unroll
    for (int q = 0; q < 4; ++q) { const unsigned lo = bperm(r[4 * q + 1], r[4 * q], selA), hi = bperm(r[4 * q + 3], r[4 * q + 2], selA); o0[q] = bperm(hi, lo, 0x05040100u); o1[q] = bperm(hi, lo, 0x07060302u); }
    unsigned char* dst = h.WT + (size_t)(h.row_base + 4 * n4 + 2 * hf) * D + h.k0 + 16 * kg;
    *(GAS v4u*)dst = o0; *(GAS v4u*)(dst + D) = o1;
}
static_assert(NWAVES * SS_WAVE_BYTES <= SCR_BYTES && 32 * SS_XP * 4 <= 32 * SS_HP, "S5 scratch");

template <int DIR, int MODE>
__device__ __forceinline__ void ssm_superchunk(Frame& F, int b, int g, int sc, float& hre, float& him, int cv_first, int cv_n) {
    const bf16* PROJ = (const bf16*)(F.ws + WS_PROJ);
    const int lane = F.lane, r = lane & 31, h = lane >> 5, dg = DIR * 64 + g;
    LAS unsigned* XS = (LAS unsigned*)(F.lds + F.wave * SS_WAVE_BYTES); LAS unsigned char* HS = (LAS unsigned char*)XS;
    LAS float* ST = (LAS float*)(HS + 32 * SS_HP);
    LAS unsigned* tile8 = (LAS unsigned*)(HS + 32 * SS_HP + 32 * SS_SP * 4);
    const float2 lam = ((const float2*)(F.ws + WS_LAM))[dg * 64 + lane];
    bf16x8 bbf[4];
#pragma unroll
    for (int t = 0; t < 4; ++t) bbf[t] = *(const bf16x8*)((const bf16*)(F.ws + WS_BB) + ((size_t)dg * 128 + 32 * t + r) * 16 + 8 * h);
    const bf16* cmp_ = (const bf16*)(F.ws + WS_CM) + ((size_t)dg * 16 + (lane & 15)) * 128 + 8 * (lane >> 4);
    const size_t tsc = (size_t)b * SEQ + sc * 512;
    bf16* YF = (bf16*)(F.ws + WS_YF); bf16* G = (bf16*)(F.ws + WS_G);
    const int cb = g * 16 + 8 * h;
    f32x4 dsk0 = (f32x4){0.f, 0.f, 0.f, 0.f}, dsk1 = dsk0;
    if (MODE == 2) { dsk0 = *(const f32x4*)(F.in[I_SSMD] + cb); dsk1 = *(const f32x4*)(F.in[I_SSMD] + cb + 4); }
    const size_t tfirst = tsc + (DIR ? 15 : 0) * 32;
    bf16x8 uf = *(const bf16x8*)(PROJ + (tfirst + r) * EIN + UOFF + cb);
    v4u yfv = (v4u){0u, 0u, 0u, 0u};
    if (MODE == 2) yfv = *(const v4u*)(YF + (tfirst + r) * SW + cb);
    HalfItem cvh = {}; f32x4 cvt[8];
    if (cv_n > 0) { cvh = half_item_desc(F, cv_first); half_load(cvh, lane, cvt); }
#pragma unroll 1
    for (int ci = 0; ci < 16; ++ci) {
        const int ch = DIR ? 15 - ci : ci; const size_t t0 = tsc + ch * 32;
        const int chn = (ci < 15) ? (DIR ? ch - 1 : ch + 1) : ch; const size_t tn = tsc + chn * 32;
        const bf16x8 uf_n = *(const bf16x8*)(PROJ + (tn + r) * EIN + UOFF + cb);
        v4u yfn = (v4u){0u, 0u, 0u, 0u};
        if (MODE == 2) yfn = *(const v4u*)(YF + (tn + r) * SW + cb);

#pragma unroll
        for (int t = 0; t < 4; ++t) { f32x16 xa;
#pragma unroll
            for (int i = 0; i < 16; ++i) xa[i] = 0.f;
            xa = MFMA32(bbf[t], uf, xa);
#pragma unroll
            for (int k = 0; k < 4; ++k) { v2u w; w.x = pkbf(xa[4 * k], xa[4 * k + 1]); w.y = pkbf(xa[4 * k + 2], xa[4 * k + 3]);
                *(LAS v2u*)(XS + r * SS_XP + 16 * t + 4 * k + 2 * h) = w; } }
        LDS_WAIT(); asm volatile("" ::: "memory");
        float xr[32], xi[32];
#pragma unroll
        for (int s = 0; s < 32; ++s) { const unsigned x2 = XS[s * SS_XP + lane]; xr[s] = bflo(x2); xi[s] = bfhi(x2); }
        LDS_WAIT(); asm volatile("" ::: "memory");
#pragma unroll
        for (int st = 0; st < 32; ++st) { const int s = DIR ? 31 - st : st;
            const float nr = lam.x * hre - lam.y * him + xr[s], ni = lam.x * him + lam.y * hre + xi[s]; hre = nr; him = ni;
            if (MODE != 0) *(LAS unsigned*)(HS + s * SS_HP + lane * 4) = pkbf(nr, ni); }
        if (ci < cv_n) { half_finish(cvh, cvt, tile8, lane);
            if (ci + 1 < cv_n) { cvh = half_item_desc(F, cv_first + (ci + 1) * 2048); half_load(cvh, lane, cvt); } }
        if (MODE != 0) {
            LDS_WAIT(); asm volatile("" ::: "memory");
            f32x4 y[2]; bf16x8 cmf[4];
#pragma unroll
            for (int ks = 0; ks < 4; ++ks) cmf[ks] = *(const bf16x8*)(cmp_ + 32 * ks);
#pragma unroll
            for (int rt = 0; rt < 2; ++rt) { y[rt] = (f32x4){0.f, 0.f, 0.f, 0.f};
#pragma unroll
                for (int ks = 0; ks < 4; ++ks) { const bf16x8 a = *(const LAS bf16x8*)(HS + (16 * rt + (lane & 15)) * SS_HP + (32 * ks + 8 * (lane >> 4)) * 2); y[rt] = MFMA16(a, cmf[ks], y[rt]); } }
#pragma unroll
            for (int rt = 0; rt < 2; ++rt)
#pragma unroll
                for (int j = 0; j < 4; ++j) ST[(16 * rt + 4 * (lane >> 4) + j) * SS_SP + (lane & 15)] = y[rt][j];
            LDS_WAIT(); asm volatile("" ::: "memory");
            const f32x4 ya = *(const LAS f32x4*)(ST + r * SS_SP + 8 * h), yb = *(const LAS f32x4*)(ST + r * SS_SP + 8 * h + 4);
            LDS_WAIT(); asm volatile("" ::: "memory");
            v4u o;
            if (MODE == 1 || MODE == 3) { o.x = pkbf(ya.x, ya.y); o.y = pkbf(ya.z, ya.w); o.z = pkbf(yb.x, yb.y); o.w = pkbf(yb.z, yb.w); if (MODE == 1 || F.G == 12345) *(v4u*)(YF + (t0 + r) * SW + cb) = o; }
            else {
                const v4u uw = __builtin_bit_cast(v4u, uf);
                const float v0 = ya.x + bflo(yfv.x) + dsk0.x * bflo(uw.x), v1 = ya.y + bfhi(yfv.x) + dsk0.y * bfhi(uw.x), v2 = ya.z + bflo(yfv.y) + dsk0.z * bflo(uw.y), v3 = ya.w + bfhi(yfv.y) + dsk0.w * bfhi(uw.y);
                const float v4 = yb.x + bflo(yfv.z) + dsk1.x * bflo(uw.z), v5 = yb.y + bfhi(yfv.z) + dsk1.y * bfhi(uw.z), v6 = yb.z + bflo(yfv.w) + dsk1.z * bflo(uw.w), v7 = yb.w + bfhi(yfv.w) + dsk1.w * bfhi(uw.w);
                o.x = pkbf(gelu_tanh(v0), gelu_tanh(v1)); o.y = pkbf(gelu_tanh(v2), gelu_tanh(v3)); o.z = pkbf(gelu_tanh(v4), gelu_tanh(v5)); o.w = pkbf(gelu_tanh(v6), gelu_tanh(v7));
                *(v4u*)(G + (t0 + r) * SW + cb) = o; }
        }
        uf = uf_n; yfv = yfn;
    }
}
__device__ __forceinline__ void ssm_pass1(Frame& F) {
    float* E = (float*)(F.ws + WS_E);
    const bool cvon = F.G * NWAVES == 2048; const int wg = F.vcu * NWAVES + F.wave; int li0 = 0;
    for (int task = F.vcu * NWAVES + F.wave; task < BATCH * 64 * 2 * 8; task += F.G * NWAVES, li0 += 16) {
        const int sc = task & 7, dir = (task >> 3) & 1, g = (task >> 4) & 63, b = task >> 10;
        float hre = 0.f, him = 0.f;
        const int cn = cvon ? (SS_C1 - li0 < 0 ? 0 : (SS_C1 - li0 > 16 ? 16 : SS_C1 - li0)) : 0, cf = li0 * 2048 + wg;
        if (dir == 0) ssm_superchunk<0, 0>(F, b, g, sc, hre, him, cf, cn); else ssm_superchunk<1, 0>(F, b, g, sc, hre, him, cf, cn);
        E[(size_t)task * 128 + F.lane] = hre; E[(size_t)task * 128 + 64 + F.lane] = him;
    }
}
__device__ __forceinline__ void ssm_pass2(Frame& F) {
    const float* E = (const float*)(F.ws + WS_E);
    const bool cvon = F.G * NWAVES == 2048; const int wg = F.vcu * NWAVES + F.wave;
    for (int task = F.vcu * NWAVES + F.wave; task < BATCH * 64 * 8; task += F.G * NWAVES) {
        const int sc = task & 7, g = (task >> 3) & 63, b = task >> 9;
        const int c0 = cvon ? (SS_C2 > 16 ? 16 : SS_C2) : 0, c1n = cvon ? (SS_C2 > 16 ? SS_C2 - 16 : 0) : 0;
        { const float2 l5 = ((const float2*)(F.ws + WS_LAM512))[(0 * 64 + g) * 64 + F.lane]; float cr = 0.f, ci = 0.f;
          float er[7], ei[7];
#pragma unroll
          for (int s2 = 0; s2 < 7; ++s2) { const float* e = E + ((size_t)(((b * 64 + g) * 2 + 0) * 8 + s2)) * 128; er[s2] = e[F.lane]; ei[s2] = e[64 + F.lane]; }
#pragma unroll
          for (int s2 = 0; s2 < 7; ++s2) if (s2 < sc) { const float nr = l5.x * cr - l5.y * ci + er[s2], ni = l5.x * ci + l5.y * cr + ei[s2]; cr = nr; ci = ni; }
#if defined(PROBE_SSM_M1)
          { float c2r = cr, c2i = ci; ssm_superchunk<0, 1>(F, b, g, sc, c2r, c2i, 0, 0); }
#endif
#if defined(PROBE_SSM_M3)
          { float c2r = cr, c2i = ci; ssm_superchunk<0, 3>(F, b, g, sc, c2r, c2i, 0, 0); }
#endif
          ssm_superchunk<0, 1>(F, b, g, sc, cr, ci, SS_C1 * 2048 + wg, c0); }
        { const float2 l5 = ((const float2*)(F.ws + WS_LAM512))[(1 * 64 + g) * 64 + F.lane]; float cr = 0.f, ci = 0.f;
          float er[7], ei[7];
#pragma unroll
          for (int q = 0; q < 7; ++q) { const float* e = E + ((size_t)(((b * 64 + g) * 2 + 1) * 8 + 7 - q)) * 128; er[q] = e[F.lane]; ei[q] = e[64 + F.lane]; }
#pragma unroll
          for (int q = 0; q < 7; ++q) if (7 - q > sc) { const float nr = l5.x * cr - l5.y * ci + er[q], ni = l5.x * ci + l5.y * cr + ei[q]; cr = nr; ci = ni; }
          ssm_superchunk<1, 2>(F, b, g, sc, cr, ci, (SS_C1 + 16) * 2048 + wg, c1n); }
    }
}

__device__ __forceinline__ void router_phase(Frame& F, const bf16* X16, const float* gain, const float* router) {
    unsigned char* H = F.ws + WS_H; float* AFF = (float*)(F.ws + WS_AFF);
    LAS f32x4* RL = (LAS f32x4*)F.lds;
    __syncthreads();
    for (int q = F.tid; q < 2048 * 4; q += NT) { const int d = q >> 2, e4 = q & 3; const f32x4 v = *(const f32x4*)(router + d * 16 + e4 * 4);
        RL[(((d >> 8) * 4 + (d & 3)) * 4 + e4) * 64 + ((d & 255) >> 2)] = v; }
    __syncthreads();
    const int lane = F.lane;
    f32x4 gn[8];
#pragma unroll
    for (int j = 0; j < 8; ++j) gn[j] = *((const GAS f32x4*)gain + lane + 64 * j);
    for (int pr = F.vcu * NWAVES + F.wave; pr < M / 2; pr += F.G * NWAVES) {
        const size_t t0 = (size_t)pr * 2;
        f32x4 v0[8], v1[8]; float s0 = 0.f, s1 = 0.f;
#pragma unroll
        for (int j = 0; j < 8; ++j) {
            { const v2u x0 = *((const GAS v2u*)(X16 + t0 * D) + lane + 64 * j), x1 = *((const GAS v2u*)(X16 + (t0 + 1) * D) + lane + 64 * j);
                v0[j] = (f32x4){bflo(x0.x), bfhi(x0.x), bflo(x0.y), bfhi(x0.y)}; v1[j] = (f32x4){bflo(x1.x), bfhi(x1.x), bflo(x1.y), bfhi(x1.y)}; }
            s0 += (v0[j].x * v0[j].x + v0[j].y * v0[j].y) + (v0[j].z * v0[j].z + v0[j].w * v0[j].w); s1 += (v1[j].x * v1[j].x + v1[j].y * v1[j].y) + (v1[j].z * v1[j].z + v1[j].w * v1[j].w); }
        const float r0 = 1.0f / sqrtf(wave_sum(s0) * (1.f / D) + EPS), r1 = 1.0f / sqrtf(wave_sum(s1) * (1.f / D) + EPS);
        f32x4 a0[4], a1[4];
#pragma unroll
        for (int e4 = 0; e4 < 4; ++e4) { a0[e4] = (f32x4){0.f, 0.f, 0.f, 0.f}; a1[e4] = (f32x4){0.f, 0.f, 0.f, 0.f}; }
#pragma unroll
        for (int j = 0; j < 8; ++j) { v0[j] = v0[j] * r0 * gn[j]; v1[j] = v1[j] * r1 * gn[j];
            *((GAS unsigned*)(H + t0 * D) + lane + 64 * j) = pk4_fp8(v0[j].x * HSC, v0[j].y * HSC, v0[j].z * HSC, v0[j].w * HSC);
            *((GAS unsigned*)(H + (t0 + 1) * D) + lane + 64 * j) = pk4_fp8(v1[j].x * HSC, v1[j].y * HSC, v1[j].z * HSC, v1[j].w * HSC);
#pragma unroll
            for (int i = 0; i < 4; ++i) {
#pragma unroll
                for (int e4 = 0; e4 < 4; ++e4) { const f32x4 w = RL[((j * 4 + i) * 4 + e4) * 64 + lane]; a0[e4] += w * v0[j][i]; a1[e4] += w * v1[j][i]; }
                asm volatile("" ::: "memory"); } }
        int ln = lane; asm volatile("" : "+v"(ln));
        float lg[2];
#pragma unroll
        for (int t = 0; t < 2; ++t) { float v[16];
#pragma unroll
            for (int e4 = 0; e4 < 4; ++e4)
#pragma unroll
                for (int c = 0; c < 4; ++c) v[e4 * 4 + c] = t ? a1[e4][c] : a0[e4][c];
#pragma unroll
            for (int s = 0; s < 4; ++s) { const int m = 1 << s, half = 8 >> s; const bool up = (ln & m) != 0;
#pragma unroll
                for (int i = 0; i < half; ++i) { const float send = up ? v[i] : v[i + half], keep = up ? v[i + half] : v[i]; v[i] = keep + __shfl_xor(send, m); } }
            float r2 = v[0]; r2 += __shfl_xor(r2, 16); r2 += __shfl_xor(r2, 32); lg[t] = r2; }
        const int ee = ((ln & 1) << 3) | ((ln & 2) << 1) | ((ln & 4) >> 1) | ((ln & 8) >> 3);
        float mx0 = lg[0], mx1 = lg[1];
#pragma unroll
        for (int m = 1; m < 16; m <<= 1) { mx0 = fmaxf(mx0, __shfl_xor(mx0, m)); mx1 = fmaxf(mx1, __shfl_xor(mx1, m)); }
        const float ex0 = expf(lg[0] - mx0), ex1 = expf(lg[1] - mx1); float z0 = ex0, z1 = ex1;
#pragma unroll
        for (int m = 1; m < 16; m <<= 1) { z0 += __shfl_xor(z0, m); z1 += __shfl_xor(z1, m); }
        const int bb = (int)(t0 / SEQ), ss = (int)(t0 % SEQ);
        if (ln < 16) { AFF[((size_t)bb * NE + ee) * SEQ + ss] = ex0 / z0; AFF[((size_t)bb * NE + ee) * SEQ + ss + 1] = ex1 / z1; }
    }
    __syncthreads();
}

__device__ __forceinline__ void topk_unit(Frame& F, int unit) {
    const float* AFF = (const float*)(F.ws + WS_AFF) + (size_t)unit * SEQ;
    int* IDX = (int*)(F.ws + WS_IDX) + (size_t)unit * CAP; float* GATE = (float*)(F.ws + WS_GATE) + (size_t)unit * CAP; int* INV = (int*)(F.ws + WS_INV);
    const int b = unit >> 4, e = unit & 15, tid = F.tid, lane = F.lane;
    int* TOK = (int*)(F.ws + WS_TOK) + e * 2048 + b * 512;
    LAS unsigned* hist = (LAS unsigned*)F.lds;
    LAS unsigned* misc = hist + 256;
    unsigned v[8];
    { const v4u a = *(const v4u*)(AFF + tid * 8), c = *(const v4u*)(AFF + tid * 8 + 4); v[0] = a.x; v[1] = a.y; v[2] = a.z; v[3] = a.w; v[4] = c.x; v[5] = c.y; v[6] = c.z; v[7] = c.w; }
    unsigned prefix = 0u, need = CAP;
#pragma unroll 1
    for (int pass = 0; pass < 4; ++pass) {
        const int shift = 24 - 8 * pass;
        __syncthreads();
        if (tid < 256) hist[tid] = 0u;
        __syncthreads();
#pragma unroll
        for (int k = 0; k < 8; ++k) { const bool match = (pass == 0) || ((v[k] >> (shift + 8)) == prefix); if (match) (void)__hip_atomic_fetch_add(&hist[(v[k] >> shift) & 255u], 1u, __ATOMIC_RELAXED, __HIP_MEMORY_SCOPE_WORKGROUP); }
        __syncthreads();
        if (F.wave == 0) {
            const unsigned c0 = hist[4 * lane], c1 = hist[4 * lane + 1], c2 = hist[4 * lane + 2], c3 = hist[4 * lane + 3];
            unsigned suf = c0 + c1 + c2 + c3;
#pragma unroll
            for (int o = 1; o < 64; o <<= 1) { const unsigned t = __shfl_down(suf, o); if (lane + o < 64) suf += t; }
            const unsigned long long mask = __ballot(suf >= need);
            const int L = 63 - __builtin_clzll(mask);
            if (lane == L) { unsigned run = suf - (c0 + c1 + c2 + c3); unsigned dig, nd;
                if (run + c3 >= need) { dig = 3; nd = need - run; } else { run += c3;
                if (run + c2 >= need) { dig = 2; nd = need - run; } else { run += c2;
                if (run + c1 >= need) { dig = 1; nd = need - run; } else { run += c1; dig = 0; nd = need - run; } } }
                misc[0] = 4u * (unsigned)lane + dig; misc[1] = nd; }
        }
        __syncthreads();
        prefix = (prefix << 8) | misc[0]; need = misc[1];
    }
    const unsigned T = prefix;
    unsigned neq = 0u;
#pragma unroll
    for (int k = 0; k < 8; ++k) neq += (v[k] == T) ? 1u : 0u;
    unsigned inc = neq;
#pragma unroll
    for (int o = 1; o < 64; o <<= 1) { const unsigned t = __shfl_up(inc, o); if (lane >= o) inc += t; }
    __syncthreads();
    if (lane == 63) misc[16 + F.wave] = inc;
    __syncthreads();
    unsigned woff = 0u;
#pragma unroll
    for (int w = 0; w < NWAVES; ++w) woff += (w < F.wave) ? misc[16 + w] : 0u;
    unsigned eqrank = woff + inc - neq;
    unsigned sel = 0u; unsigned selm = 0u;
#pragma unroll
    for (int k = 0; k < 8; ++k) { bool s = v[k] > T; if (v[k] == T) { s = eqrank < need; ++eqrank; } if (s) { selm |= 1u << k; ++sel; } }
    unsigned inc2 = sel;
#pragma unroll
    for (int o = 1; o < 64; o <<= 1) { const unsigned t = __shfl_up(inc2, o); if (lane >= o) inc2 += t; }
    if (lane == 63) misc[32 + F.wave] = inc2;
    __syncthreads();
    unsigned woff2 = 0u;
#pragma unroll
    for (int w = 0; w < NWAVES; ++w) woff2 += (w < F.wave) ? misc[32 + w] : 0u;
    unsigned slot = woff2 + inc2 - sel;
#pragma unroll
    for (int k = 0; k < 8; ++k) { const int s = tid * 8 + k; int sl = -1;
        if (selm & (1u << k)) { sl = (int)slot; ++slot; IDX[sl] = s; TOK[sl] = b * SEQ + s; GATE[sl] = __builtin_bit_cast(float, v[k]); }
        INV[((size_t)b * SEQ + s) * NE + e] = sl; }
}

__device__ __forceinline__ void gather_phase(Frame& F) {
    const unsigned char* H = F.ws + WS_H; unsigned char* XS = F.ws + WS_XS; const int* IDX = (const int*)(F.ws + WS_IDX);
    for (int row = F.vcu * NWAVES + F.wave; row < MS; row += F.G * NWAVES) {
        const int e = row >> 11, b = (row >> 9) & 3, c = row & 511; const int s = IDX[(b * NE + e) * CAP + c];
        const GAS v4u* src = (const GAS v4u*)(H + ((size_t)b * SEQ + s) * D) + F.lane; GAS v4u* dst = (GAS v4u*)(XS + (size_t)row * D) + F.lane;
        const v4u t0 = src[0], t1 = src[64];
        dst[0] = t0; dst[64] = t1;
    }
}
template <bool FINAL>
__device__ __forceinline__ void combine_phase(Frame& F, const bf16* Xin, bf16* Xout, const float* gain) {
    const unsigned char* YS = F.ws + WS_YS; const int* INV = (const int*)(F.ws + WS_INV); const float* GATE = (const float*)(F.ws + WS_GATE);
    const int lane = F.lane;
    const int tstep = F.G * NWAVES; int t = F.vcu * NWAVES + F.wave;
    typedef float f2 __attribute__((ext_vector_type(2)));
#define CB_FIRST(inv_, tok_, W0, W1, G0, G1) do { const unsigned m_ = (unsigned)(__ballot((inv_) >= 0) & 0xffffull); \
        if (m_) { const int b_ = (tok_) / SEQ; const int e0_ = __builtin_ctz(m_); const unsigned mr_ = m_ & (m_ - 1u); const bool two_ = mr_ != 0u; const int e1_ = two_ ? __builtin_ctz(mr_) : e0_; \
            const int s0_ = __builtin_amdgcn_readlane((inv_), e0_), s1_ = __builtin_amdgcn_readlane((inv_), e1_); \
            G0 = GATE[(b_ * NE + e0_) * CAP + s0_] * (1.f / YSC); G1 = two_ ? GATE[(b_ * NE + e1_) * CAP + s1_] * (1.f / YSC) : 0.f; \
            const size_t r0_ = (size_t)e0_ * 2048 + b_ * 512 + s0_, r1_ = (size_t)e1_ * 2048 + b_ * 512 + s1_; \
            _Pragma("unroll") for (int j = 0; j < 8; ++j) { W0[j] = *((const GAS unsigned*)(YS + r0_ * D) + lane + 64 * j); W1[j] = *((const GAS unsigned*)(YS + r1_ * D) + lane + 64 * j); } } } while (0)
#define CB_ACC(W0, W1, G0, G1) do { _Pragma("unroll") for (int j = 0; j < 8; ++j) { \
            const f2 a0 = __builtin_amdgcn_cvt_pk_f32_fp8((int)W0[j], false), a1 = __builtin_amdgcn_cvt_pk_f32_fp8((int)W0[j], true), b0 = __builtin_amdgcn_cvt_pk_f32_fp8((int)W1[j], false), b1 = __builtin_amdgcn_cvt_pk_f32_fp8((int)W1[j], true); \
            v[j].x += G0 * a0.x + G1 * b0.x; v[j].y += G0 * a0.y + G1 * b0.y; v[j].z += G0 * a1.x + G1 * b1.x; v[j].w += G0 * a1.y + G1 * b1.y; } } while (0)
    f32x4 v[8]; int myinv = -1, inv1 = -1; unsigned pw0[8], pw1[8]; float pg0 = 0.f, pg1 = 0.f;
    f32x4 gn[8];
    if (FINAL) {
#pragma unroll
        for (int j = 0; j < 8; ++j) gn[j] = *((const GAS f32x4*)gain + lane + 64 * j);
    }
    if (t < M) {
        const int tn = (t + tstep < M) ? t + tstep : t;
#pragma unroll
        for (int j = 0; j < 8; ++j) { const v2u x = *((const GAS v2u*)(Xin + (size_t)t * D) + lane + 64 * j); v[j] = (f32x4){bflo(x.x), bfhi(x.x), bflo(x.y), bfhi(x.y)}; }
        myinv = INV[(size_t)t * NE + (lane & 15)]; inv1 = INV[(size_t)tn * NE + (lane & 15)];
        CB_FIRST(myinv, t, pw0, pw1, pg0, pg1);
    }
    for (; t < M; t += tstep) {
        const int b = t / SEQ; const int tn = (t + tstep < M) ? t + tstep : t, tn2 = (tn + tstep < M) ? tn + tstep : tn;
        v2u vnp[8];
#pragma unroll
        for (int j = 0; j < 8; ++j) vnp[j] = *((const GAS v2u*)(Xin + (size_t)tn * D) + lane + 64 * j);
        const int inv2 = INV[(size_t)tn2 * NE + (lane & 15)];
        unsigned w0n[8], w1n[8]; float g0n = 0.f, g1n = 0.f;
        CB_FIRST(inv1, tn, w0n, w1n, g0n, g1n);
        unsigned m = (unsigned)(__ballot(myinv >= 0) & 0xffffull);
        if (m) { CB_ACC(pw0, pw1, pg0, pg1); m &= m - 1u; m &= m - 1u; }
        while (m) {
            const int e0 = __builtin_ctz(m); m &= m - 1u; const bool two = m != 0u; const int e1 = two ? __builtin_ctz(m) : e0; m &= m - 1u;
            const int s0 = __builtin_amdgcn_readlane(myinv, e0), s1 = __builtin_amdgcn_readlane(myinv, e1);
            const float g0 = GATE[(b * NE + e0) * CAP + s0] * (1.f / YSC), g1 = two ? GATE[(b * NE + e1) * CAP + s1] * (1.f / YSC) : 0.f;
            const size_t r0 = (size_t)e0 * 2048 + b * 512 + s0, r1 = (size_t)e1 * 2048 + b * 512 + s1;
            unsigned w0[8], w1[8];
#pragma unroll
            for (int j = 0; j < 8; ++j) { w0[j] = *((const GAS unsigned*)(YS + r0 * D) + lane + 64 * j); w1[j] = *((const GAS unsigned*)(YS + r1 * D) + lane + 64 * j); }
            CB_ACC(w0, w1, g0, g1);
        }
        float s = 0.f;
#pragma unroll
        for (int j = 0; j < 8; ++j) { if (!FINAL) { v2u w; w.x = pkbf(v[j].x, v[j].y); w.y = pkbf(v[j].z, v[j].w); *((GAS v2u*)(Xout + (size_t)t * D) + lane + 64 * j) = w; } s += (v[j].x * v[j].x + v[j].y * v[j].y) + (v[j].z * v[j].z + v[j].w * v[j].w); }
        const float rstd = 1.0f / sqrtf(wave_sum(s) * (1.f / D) + EPS);
        if (FINAL) {
#pragma unroll
            for (int j = 0; j < 8; ++j) *((GAS f32x4*)(F.out + (size_t)t * D) + lane + 64 * j) = v[j] * rstd * gn[j];
        } else if (lane == 0) ((float*)(F.ws + WS_RSTD))[t] = rstd;
#pragma unroll
        for (int j = 0; j < 8; ++j) { v[j] = (f32x4){bflo(vnp[j].x), bfhi(vnp[j].x), bflo(vnp[j].y), bfhi(vnp[j].y)}; pw0[j] = w0n[j]; pw1[j] = w1n[j]; }
        myinv = inv1; inv1 = inv2; pg0 = g0n; pg1 = g1n;
    }
#undef CB_FIRST
#undef CB_ACC
}

constexpr int SG_VT = 0, SG_MX = 128 * AT_P, SG_MP = 132;
static_assert(SG_MX + 128 * SG_MP * 4 <= SCR_BYTES, "sgu scratch");
__device__ __forceinline__ void sgu_phase(Frame& F) {
    const bf16* Z = (const bf16*)(F.ws + WS_Z); bf16* G2 = (bf16*)(F.ws + WS_G2); const float* STAT = (const float*)(F.ws + WS_STATP);   const bf16* SG = (const bf16*)(F.ws + WS_SGU);
    int hd = blockIdx.x & 15; const int nunits = (M / 128) * 16;
    const int lane = F.lane, r = lane & 31, h = lane >> 5;
    LAS unsigned char* lds = F.lds; LAS float* MX = (LAS float*)(lds + SG_MX);
    const int rt = F.wave >> 1, dt0 = (F.wave & 1) * 2;
    bf16x8 af[8]; float sb[16];
#define SG_CONSTS() do { _Pragma("unroll") for (int ks = 0; ks < 8; ++ks) af[ks] = *(const bf16x8*)(SG + ((size_t)hd * 128 + 32 * rt + r) * 128 + 16 * ks + 8 * h); \
        _Pragma("unroll") for (int i = 0; i < 16; ++i) sb[i] = F.in[I_SGUB][hd * 128 + 32 * rt + crow(i, h)]; } while (0)
    SG_CONSTS();
    v4u uuN[4], vvN[4]; float2 stN[8];
    int unit = blockIdx.x;
    if (unit < nunits) { const size_t t0 = (size_t)(unit >> 4) * 128;
#pragma unroll
        for (int i = 0; i < 4; ++i) { const int c = F.tid + NT * i; uuN[i] = *(const v4u*)(Z + (t0 + (c >> 4)) * ZW + hd * 128 + (c & 15) * 8);
            vvN[i] = *(const v4u*)(Z + (t0 + (c & 127)) * ZW + GW + hd * 128 + (c >> 7) * 8); }
#pragma unroll
        for (int q = 0; q < 8; ++q) stN[q] = *(const float2*)(STAT + ((size_t)q * M + t0 + (F.tid & 127)) * 2); }
    for (; unit < nunits; unit += F.G) {
        const size_t t0 = (size_t)(unit >> 4) * 128;
        if ((unit & 15) != hd) { hd = unit & 15; SG_CONSTS(); }
        v4u uu[4];
#pragma unroll
        for (int i = 0; i < 4; ++i) uu[i] = uuN[i];
        __syncthreads();
        float sum1 = 0.f, sum2 = 0.f;
#pragma unroll
        for (int q = 0; q < 8; ++q) { sum1 += stN[q].x; sum2 += stN[q].y; }
        const float mu = sum1 * (1.f / GW); const float var = fmaxf(sum2 * (1.f / GW) - mu * mu, 0.f); const float rstd = 1.0f / sqrtf(var + EPS);
#pragma unroll
        for (int i = 0; i < 4; ++i) { const int c = F.tid + NT * i, row = c & 127, ch = c >> 7;
            const v4u vv = vvN[i];
            const f32x4 g0 = *(const f32x4*)(F.in[I_LNG] + hd * 128 + ch * 8), g1 = *(const f32x4*)(F.in[I_LNG] + hd * 128 + ch * 8 + 4);
            const f32x4 b0 = *(const f32x4*)(F.in[I_LNB] + hd * 128 + ch * 8), b1 = *(const f32x4*)(F.in[I_LNB] + hd * 128 + ch * 8 + 4);
            LAS bf16* vt = (LAS bf16*)(lds + SG_VT + (ch * 8) * AT_P + row * 2);
            vt[0 * (AT_P / 2)] = f2bf1((bflo(vv.x) - mu) * rstd * g0.x + b0.x); vt[1 * (AT_P / 2)] = f2bf1((bfhi(vv.x) - mu) * rstd * g0.y + b0.y);
            vt[2 * (AT_P / 2)] = f2bf1((bflo(vv.y) - mu) * rstd * g0.z + b0.z); vt[3 * (AT_P / 2)] = f2bf1((bfhi(vv.y) - mu) * rstd * g0.w + b0.w);
            vt[4 * (AT_P / 2)] = f2bf1((bflo(vv.z) - mu) * rstd * g1.x + b1.x); vt[5 * (AT_P / 2)] = f2bf1((bfhi(vv.z) - mu) * rstd * g1.y + b1.y);
            vt[6 * (AT_P / 2)] = f2bf1((bflo(vv.w) - mu) * rstd * g1.z + b1.z); vt[7 * (AT_P / 2)] = f2bf1((bfhi(vv.w) - mu) * rstd * g1.w + b1.w); }
        if (unit + F.G < nunits) { const size_t t1 = (size_t)((unit + F.G) >> 4) * 128; const int h1 = (unit + F.G) & 15;
#pragma unroll
            for (int i = 0; i < 4; ++i) { const int c = F.tid + NT * i; uuN[i] = *(const v4u*)(Z + (t1 + (c >> 4)) * ZW + h1 * 128 + (c & 15) * 8);
                vvN[i] = *(const v4u*)(Z + (t1 + (c & 127)) * ZW + GW + h1 * 128 + (c >> 7) * 8); }
#pragma unroll
            for (int q = 0; q < 8; ++q) stN[q] = *(const float2*)(STAT + ((size_t)q * M + t1 + (F.tid & 127)) * 2); }
        __syncthreads();
        f32x16 acc[2];
#pragma unroll
        for (int q = 0; q < 2; ++q)
#pragma unroll
            for (int i = 0; i < 16; ++i) acc[q][i] = 0.f;
#pragma unroll
        for (int ks = 0; ks < 8; ++ks) {
#pragma unroll
            for (int q = 0; q < 2; ++q) { const bf16x8 bv = *(const LAS bf16x8*)(lds + SG_VT + (32 * (dt0 + q) + r) * AT_P + (16 * ks + 8 * h) * 2); acc[q] = MFMA32(af[ks], bv, acc[q]); } }
#pragma unroll
        for (int q = 0; q < 2; ++q)
#pragma unroll
            for (int i = 0; i < 16; ++i) { const int t = 32 * rt + crow(i, h); MX[t * SG_MP + 32 * (dt0 + q) + r] = acc[q][i] + sb[i]; }
        __syncthreads();
#pragma unroll
        for (int i = 0; i < 4; ++i) { const int c = F.tid + NT * i, row = c >> 4, ch = c & 15;
            const f32x4 m0 = *(const LAS f32x4*)(MX + row * SG_MP + ch * 8), m1 = *(const LAS f32x4*)(MX + row * SG_MP + ch * 8 + 4);
            v4u o; o.x = pkbf(bflo(uu[i].x) * m0.x, bfhi(uu[i].x) * m0.y); o.y = pkbf(bflo(uu[i].y) * m0.z, bfhi(uu[i].y) * m0.w);
            o.z = pkbf(bflo(uu[i].z) * m1.x, bfhi(uu[i].z) * m1.y); o.w = pkbf(bflo(uu[i].w) * m1.z, bfhi(uu[i].w) * m1.w);
            *(GAS v4u*)(G2 + (t0 + row) * GW + hd * 128 + ch * 8) = o; }
    }
#undef SG_CONSTS
}

constexpr int N_PHASES = 21;
struct Args { const float* in[28]; float* out; unsigned char* ws; int ph_lo, ph_hi; };
static_assert(sizeof(Args) == 28 * 8 + 8 + 8 + 8, "Args has no padding");

__global__ void __launch_bounds__(NT, 2) enc_fwd(Args args) {
    extern __shared__ __attribute__((aligned(16))) unsigned char lds[];
    Frame F;
    F.lds = (LAS unsigned char*)lds;
    F.MISC = (volatile LAS unsigned*)(F.lds + MISC_OFF);
    F.tid = threadIdx.x; F.lane = F.tid & 63; F.wave = __builtin_amdgcn_readfirstlane(F.tid >> 6);
    F.G = gridDim.x; { const int bx = blockIdx.x; F.vcu = (F.G % 8 == 0) ? (bx % 8) * (F.G / 8) + bx / 8 : bx; }
    F.ws = args.ws; F.ctl = (gu32*)(args.ws + WS_CTL); F.out = args.out;
#pragma unroll
    for (int i = 0; i < 28; ++i) F.in[i] = args.in[i];
    for (int u = F.tid; u < (LDS_BYTES - LDSCTL_OFF) / 4; u += NT) ((LAS unsigned*)(F.lds + LDSCTL_OFF))[u] = 0u;
    __syncthreads();
    const int lo = args.ph_lo, hi = args.ph_hi;
    const bool multi = (hi - lo) > 1;
    XcdBarrier bar; bar.bar = (unsigned*)(F.ctl + CW_BAR); bar.x = 0; bar.st = nullptr;
    if (multi) bar = xcd_barrier_post((unsigned*)(F.ctl + CW_BAR), F.MISC + 8);
#ifdef ONLY_PHASE
#define IN(k) ((k) == ONLY_PHASE && lo <= (k) && (k) < hi)
#else
#define IN(k) (lo <= (k) && (k) < hi)
#endif
#ifndef PROBE_DUP_MASK
#define PROBE_DUP_MASK 0u
#endif
#define PH(k) for (int _r = 0; _r < (((PROBE_DUP_MASK >> (k)) & 1u) ? 2 : 1); ++_r) if (IN(k))
#define STOP_THR(nunits, gw) ((unsigned)(((nunits) % (gw)) ? ((gw) - (nunits) % (gw) + 1) : 1))
#ifdef PROBE_DBLBAR
#define SEAM(k) do { if (IN((k) + 1)) { xcd_barrier(bar); xcd_barrier(bar); } } while (0)
#else
#define SEAM(k) do { if (IN((k) + 1)) xcd_barrier(bar); } while (0)
#endif
    LAS unsigned char* ring = F.lds;
    bf16* const H = (bf16*)(F.ws + WS_H); bf16* const DL = (bf16*)(F.ws + WS_XA);     bf16* const XB = (bf16*)(F.ws + WS_XB);
    unsigned char* const HID = F.ws + WS_HID; unsigned char* const YS = F.ws + WS_YS;

    PH(0) { p0_prologue(F);
#if defined(PROBE_P0)
        __syncthreads(); p0_prologue(F);
#endif
        SEAM(0); }
    PH(1) {
        const int NC1 = (F.G >= 64) ? ((F.G * 5 / 32) & ~7) : 0, GW1 = F.G - NC1;
        if ((int)blockIdx.x >= GW1) conv_bg(F, 0, F.ctl + CW_DONE1, STOP_THR((M / 256) * (EIN / 256), GW1));
        else {
        pg8::Gemm g{(const bf16*)(F.ws + WS_X16), (const bf16*)(F.ws + WS_WIN0), M, EIN, D}; pg8::StaticOrder S; S.init(M, EIN, GW1, (int)blockIdx.x);
        pg8::EpiStoreRS E{(bf16*)(F.ws + WS_PROJ), EIN, EIN / 256, (const float*)(F.ws + WS_RSTD0)};
        pg8::gemm_phase<pg8::EpiStoreRS, pg8::StaticOrder, true, true>(ring, g, S, E);
        __syncthreads(); if (F.tid == 0) (void)__hip_atomic_fetch_add(F.ctl + CW_DONE1, 1u, RLX_AGENT);
        conv_bg(F, 0, F.ctl + CW_DONE1, STOP_THR((M / 256) * (EIN / 256), GW1));
        }
        SEAM(1);
    }
    PH(2) {
        for (int u = blockIdx.x; u < BATCH * 32 * 2 * 2; u += F.G) attn_unit(F, u);
        __syncthreads();
        ssm_pass1(F);
#if defined(PROBE_SSM1)
        __syncthreads(); ssm_pass1(F);
#endif
#if defined(PROBE_ATTN)
        __syncthreads(); for (int u = blockIdx.x; u < BATCH * 32 * 2 * 2; u += F.G) attn_unit(F, u);
#endif
        SEAM(2);
    }
    PH(3) { ssm_pass2(F);
#if defined(PROBE_P3)
        __syncthreads(); ssm_pass2(F);
#endif
        SEAM(3); }
    PH(4) {
        pg8::Gemm g{(const bf16*)(F.ws + WS_G), (const bf16*)(F.ws + WS_GLU), M, SW, SW}; pg8::StaticOrder S; S.init(M, SW, F.G, (int)blockIdx.x);
        pg8::EpiGlu E{(const bf16*)(F.ws + WS_G), SW, (bf16*)(F.ws + WS_CAT), D, AW, F.in[I_GLUB]};
        pg8::gemm_phase<pg8::EpiGlu, pg8::StaticOrder, true, true>(ring, g, S, E);
#if defined(PROBE_G4)
        pg8::gemm_phase<pg8::EpiGlu, pg8::StaticOrder, true, true>(ring, g, S, E);
#endif
        SEAM(4);
    }
    PH(5) {
        pg8::Gemm g{(const bf16*)(F.ws + WS_CAT), (const bf16*)(F.ws + WS_WOUT0), M, D, D}; pg8::StaticOrder S; S.init(M, D, F.G, (int)blockIdx.x);
        pg8::EpiStoreRes E{DL, D, D / 256, (const bf16*)(F.ws + WS_X16)};
        pg8::gemm_phase<pg8::EpiStoreRes, pg8::StaticOrder, true, true>(ring, g, S, E);
        SEAM(5);
    }
    PH(6) { router_phase(F, DL, F.in[I_FFNN], F.in[I_ROUTER]);
        SEAM(6); }
    PH(7) { for (int u = blockIdx.x; u < BATCH * NE; u += F.G) topk_unit(F, u);
        __syncthreads(); conv_bg(F, 0, nullptr, 0u);
#if defined(PROBE_P7)
        __syncthreads(); for (int u = blockIdx.x; u < BATCH * NE; u += F.G) topk_unit(F, u);
#endif
        if (IN(9)) xcd_barrier(bar); }
    #ifndef NCONV_NUM
#define NCONV_NUM 3
#endif
    const int NCONV = (F.G >= 64) ? ((F.G * NCONV_NUM / 16) & ~7) : 0, GWG = F.G - NCONV; const bool is_conv = (int)blockIdx.x >= GWG;
    PH(9) {
        if (is_conv) conv_bg(F, 1, F.ctl + CW_DONE9, STOP_THR((MS / 256) * (2 * FF / 256), GWG));
        else {
        pg8::Gemm g{(const bf16*)(F.ws + WS_H), (const bf16*)(F.ws + WS_W13), MS, 2 * FF, D / 2, (const int*)(F.ws + WS_TOK)}; pg8::GroupedOrder S; S.init(MS, 2 * FF, GWG, (int)blockIdx.x); S.npg = 2 * FF / 256;
        pg8::EpiSwiglu8 E{HID, FF, 2 * FF / 256, 1.f / (HSC * WSC), HIDSC, 0};
        pg8::gemm_phase<pg8::EpiSwiglu8, pg8::GroupedOrder, true, true, true, true>(ring, g, S, E);
        __syncthreads(); if (F.tid == 0) (void)__hip_atomic_fetch_add(F.ctl + CW_DONE9, 1u, RLX_AGENT);
        conv_bg(F, 1, F.ctl + CW_DONE9, STOP_THR((MS / 256) * (2 * FF / 256), GWG));
        }
        SEAM(9);
    }
    PH(10) {
        if (!is_conv) {
        pg8::Gemm g{(const bf16*)HID, (const bf16*)(F.ws + WS_W2), MS, D, FF / 2}; pg8::GroupedOrder S; S.init(MS, D, GWG, (int)blockIdx.x); S.npg = D / 256;
        pg8::EpiStore8 E{YS, D, D / 256, YSC / (HIDSC * WSC)};
        pg8::gemm_phase<pg8::EpiStore8, pg8::GroupedOrder, true, true, true>(ring, g, S, E);
        __syncthreads();
        }
        conv_bg(F, 1, nullptr, 0u);
        SEAM(10);
    }
    PH(11) { combine_phase<false>(F, DL, XB, F.in[I_MIXN] + D);
        SEAM(11); }
    PH(12) {
        pg8::Gemm g{XB, (const bf16*)(F.ws + WS_WIN1), M, ZW, D}; pg8::StaticOrder S; S.init(M, ZW, F.G, (int)blockIdx.x);
        pg8::EpiGelu E{(bf16*)(F.ws + WS_Z), ZW, (float*)(F.ws + WS_STATP), GW / 256, (const float*)(F.ws + WS_RSTD), (LAS float*)(F.lds + 131072 + 1024), M};
        pg8::gemm_phase<pg8::EpiGelu, pg8::StaticOrder, true, true>(ring, g, S, E);
#if defined(PROBE_G12)
        { pg8::EpiGelu E2{(bf16*)(F.ws + WS_Z), ZW, (float*)(F.ws + WS_XS), GW / 256, (const float*)(F.ws + WS_RSTD), (LAS float*)(F.lds + 131072 + 1024), M}; pg8::gemm_phase<pg8::EpiGelu, pg8::StaticOrder, true, true>(ring, g, S, E2); }
#endif
        SEAM(12);
    }
    PH(13) { sgu_phase(F); SEAM(13); }
    PH(14) {
        pg8::Gemm g{(const bf16*)(F.ws + WS_G2), (const bf16*)(F.ws + WS_WOUT1), M, D, GW}; pg8::StaticOrder S; S.init(M, D, F.G, (int)blockIdx.x);
        pg8::EpiStoreRes E{DL, D, D / 256, XB};
        pg8::gemm_phase<pg8::EpiStoreRes, pg8::StaticOrder, true, true>(ring, g, S, E);
        SEAM(14);
    }
    PH(15) { router_phase(F, DL, F.in[I_FFNN] + D, F.in[I_ROUTER] + D * NE); SEAM(15); }
    PH(16) { for (int u = blockIdx.x; u < BATCH * NE; u += F.G) topk_unit(F, u); if (IN(18)) xcd_barrier(bar); }
    PH(18) {
        pg8::Gemm g{(const bf16*)(F.ws + WS_H), (const bf16*)(F.ws + WS_W13) + (size_t)NE * 2 * FF * D / 2, MS, 2 * FF, D / 2, (const int*)(F.ws + WS_TOK)}; pg8::GroupedOrder S; S.init(MS, 2 * FF, F.G, (int)blockIdx.x); S.npg = 2 * FF / 256;
        pg8::EpiSwiglu8 E{HID, FF, 2 * FF / 256, 1.f / (HSC * WSC), HIDSC, 0};
        pg8::gemm_phase<pg8::EpiSwiglu8, pg8::GroupedOrder, true, true, true, true>(ring, g, S, E);
#if defined(PROBE_G18H)
        { pg8::EpiSwiglu8 E2{HID, FF, 2 * FF / 256, 1.f / (HSC * WSC), HIDSC, F.G + 12089}; pg8::gemm_phase<pg8::EpiSwiglu8, pg8::GroupedOrder, true, true, true, true>(ring, g, S, E2); }
#endif
#if defined(PROBE_G18L)
        { pg8::EpiSwiglu8 E2{(unsigned char*)(F.ws + WS_XS), FF, 2 * FF / 256, 1.f / (HSC * WSC), HIDSC, F.G + 12090}; pg8::gemm_phase<pg8::EpiSwiglu8, pg8::GroupedOrder, true, true, true, true>(ring, g, S, E2); }
#endif
#if defined(PROBE_G18)
        pg8::gemm_phase<pg8::EpiSwiglu8, pg8::GroupedOrder, true, true, true, true>(ring, g, S, E);
#endif
        SEAM(18);
    }
    PH(19) {
        pg8::Gemm g{(const bf16*)HID, (const bf16*)(F.ws + WS_W2) + (size_t)NE * FF * D / 2, MS, D, FF / 2}; pg8::GroupedOrder S; S.init(MS, D, F.G, (int)blockIdx.x); S.npg = D / 256;
        pg8::EpiStore8 E{YS, D, D / 256, YSC / (HIDSC * WSC)};
        pg8::gemm_phase<pg8::EpiStore8, pg8::GroupedOrder, true, true, true>(ring, g, S, E);
        SEAM(19);
    }
    PH(20) { combine_phase<true>(F, DL, nullptr, F.in[I_FINN]); }
#undef IN
#undef SEAM
}

extern "C" void kernel_launch(void* const* d_in, const int* in_sizes, int n_in, void* d_out, int out_size, void* d_ws, size_t ws_size, hipStream_t stream) {
    static int grid = 0;
    if (grid == 0) {
        if (n_in != 28 || in_sizes[0] != M * D || out_size != M * D || ws_size < WS_END) { fprintf(stderr, "kernel_launch: shape/workspace mismatch (n_in %d, in0 %d, out %d, ws %zu, need %zu)\n", n_in, n_in > 0 ? in_sizes[0] : -1, out_size, ws_size, (size_t)WS_END); grid = -1; return; }
        int dev = 0, cus = 0, per_cu = 0;
        if (hipGetDevice(&dev) != hipSuccess || hipDeviceGetAttribute(&cus, hipDeviceAttributeMultiprocessorCount, dev) != hipSuccess) { grid = -1; return; }
        if (hipFuncSetAttribute((const void*)enc_fwd, hipFuncAttributeMaxDynamicSharedMemorySize, LDS_BYTES) != hipSuccess) { fprintf(stderr, "kernel_launch: hipFuncSetAttribute failed\n"); grid = -1; return; }
        if (hipOccupancyMaxActiveBlocksPerMultiprocessor(&per_cu, (const void*)enc_fwd, NT, LDS_BYTES) != hipSuccess || per_cu < 1) fprintf(stderr, "kernel_launch: occupancy query reports %d\n", per_cu);
        (void)hipGetLastError();
        grid = cus;
    }
    if (grid < 0) return;
    (void)hipMemsetAsync((char*)d_ws + WS_CTL, 0, CTL_ZERO_BYTES, stream);
    Args a{};
    for (int i = 0; i < 28; ++i) a.in[i] = (const float*)d_in[i];
    a.out = (float*)d_out; a.ws = (unsigned char*)d_ws;
#if MK_N_LAUNCHES == 1
    a.ph_lo = 0; a.ph_hi = N_PHASES;
    hipLaunchKernelGGL(enc_fwd, dim3(grid), dim3(NT), LDS_BYTES, stream, a);
#else
    for (int p = 0; p < N_PHASES; ++p) { a.ph_lo = p; a.ph_hi = p + 1; hipLaunchKernelGGL(enc_fwd, dim3(grid), dim3(NT), LDS_BYTES, stream, a); }
#endif
}
```

```cpp
#include <hip/hip_runtime.h>
#include <cstdio>
#include <cstdint>
namespace pg8 {
#define PG8_LAS __attribute__((address_space(3)))
typedef unsigned short bf16_t;
typedef short bf16x8 __attribute__((ext_vector_type(8)));
typedef float f32x4 __attribute__((ext_vector_type(4)));
typedef unsigned u32x4 __attribute__((ext_vector_type(4)));
constexpr int BM = 256, BK = 64, HALF = 128, HTB = HALF * BK * 2  , STAGE_BYTES = 8 * HTB, NXCD = 8, WGM = 8;

__host__ __device__ __forceinline__ int lds_byte(int r, int c) { const int st = (r >> 4) * 2 + (c >> 5), rr = r & 15, cc = c & 31, ob = rr * 64 + cc * 2; return st * 1024 + (ob ^ (((ob >> 9) & 1) << 5)); }
__host__ __device__ __forceinline__ void stage_rc(int b, int& R, int& C) { const int st = b / 1024, sb = b % 1024, swz = sb ^ (((sb >> 9) & 1) << 5); R = (st >> 1) * 16 + swz / 64; C = (st & 1) * 32 + (swz % 64) / 2; }
__host__ __device__ __forceinline__ int perm32(int rho) { const int n = rho >> 4, i = rho & 15; return 8 * (i >> 2) + 4 * n + (i & 3); }

struct Unit { int pm, pn; };
struct Gemm { const bf16_t* A; const bf16_t* Bt; int M, N, K; const int* rowtok; };

struct StaticOrder {
    int nM, nN, nwg, G, c;
    __host__ __device__ void init(int M, int N, int G_, int c_) { nM = M / BM; nN = N / BM; nwg = nM * nN; G = G_; c = c_; }
    __host__ __device__ bool next(int i, Unit& u) const {
        const long L = (long)i * G + c; if (L >= nwg) return false;
        int wgid = (int)L; { const int q = nwg / NXCD, r = nwg % NXCD, xcd = wgid % NXCD, off = wgid / NXCD; wgid = (xcd < r ? xcd * (q + 1) : r * (q + 1) + (xcd - r) * q) + off; }
        const int nig = WGM * nN, gid = wgid / nig, fm = gid * WGM, gsz = (nM - fm) < WGM ? (nM - fm) : WGM;
        u.pm = fm + ((wgid % nig) % gsz); u.pn = (wgid % nig) / gsz; return true;
    }
    __device__ __forceinline__ void a_ready(const Unit&) const {}
    __device__ __forceinline__ void done(const Unit&) const {}
};
__device__ __forceinline__ unsigned cvt_pk_bf16(float lo, float hi) { unsigned r; asm volatile("v_cvt_pk_bf16_f32 %0, %1, %2" : "=v"(r) : "v"(lo), "v"(hi)); return r; }
struct GroupedOrder : StaticOrder {
    int npg;
    __device__ __forceinline__ bool next(int i, Unit& u) const { if (!StaticOrder::next(i, u)) return false; u.pn += (u.pm >> 3) * npg; return true; }
};
typedef unsigned u32x2 __attribute__((ext_vector_type(2)));
typedef int i32x4_t __attribute__((ext_vector_type(4)));
typedef int i32x8_t __attribute__((ext_vector_type(8)));
__device__ __forceinline__ i32x8_t cat8(bf16x8 a, bf16x8 b) { return __builtin_shufflevector(__builtin_bit_cast(i32x4_t, a), __builtin_bit_cast(i32x4_t, b), 0, 1, 2, 3, 4, 5, 6, 7); }
typedef __bf16 bf16x2_t __attribute__((ext_vector_type(2)));
typedef float f32x2_t __attribute__((ext_vector_type(2)));
__device__ __forceinline__ unsigned pkbf(float a, float b) { f32x2_t v = {a, b}; bf16x2_t r = __builtin_convertvector(v, bf16x2_t); return __builtin_bit_cast(unsigned, r); }
__device__ __forceinline__ float clamp8(float x) { return fminf(fmaxf(x, -448.f), 448.f); }
__device__ __forceinline__ unsigned pk4_fp8(float a, float b, float c, float d) {
    unsigned w = (unsigned)__builtin_amdgcn_cvt_pk_fp8_f32(clamp8(a), clamp8(b), 0, false); return (unsigned)__builtin_amdgcn_cvt_pk_fp8_f32(clamp8(c), clamp8(d), (int)w, true); }
__device__ __forceinline__ float bflo(unsigned w) { return __builtin_bit_cast(float, w << 16); }
__device__ __forceinline__ float bfhi(unsigned w) { return __builtin_bit_cast(float, w & 0xffff0000u); }
__device__ __forceinline__ float sigmoidf_(float v) { return __builtin_amdgcn_rcpf(1.f + __expf(-v)); }
__device__ __forceinline__ float gelu_tanh(float x) { const float u = x * (1.5957691216f + 0.0713548163f * x * x); return x * sigmoidf_(u); }
typedef float f2v __attribute__((ext_vector_type(2)));
__device__ __forceinline__ f2v gelu_tanh2(f2v x) {
    const f2v x2 = x * x, u = x * (x2 * (-0.1029432397f) + (-2.3022082480f));
    f2v e; e.x = __builtin_amdgcn_exp2f(u.x); e.y = __builtin_amdgcn_exp2f(u.y);
    const f2v d = e + 1.0f; f2v r; r.x = __builtin_amdgcn_rcpf(d.x); r.y = __builtin_amdgcn_rcpf(d.y);
    return x * r;
}
__device__ __forceinline__ f2v swiglu2(f2v a, f2v b, float c1, float c2) {
    const f2v t = a * c1; f2v e; e.x = __builtin_amdgcn_exp2f(t.x); e.y = __builtin_amdgcn_exp2f(t.y);
    const f2v d = e + 1.0f; f2v r; r.x = __builtin_amdgcn_rcpf(d.x); r.y = __builtin_amdgcn_rcpf(d.y);
    return (a * b) * (r * c2);
}

struct EpiStore {
    static constexpr bool PERM = true, AFTER_DRAIN = false;
    bf16_t* O; int ldc; int npn; float osc;
    __device__ __forceinline__ void operator()(const f32x4 (&acc)[2][2][4][2], const Unit& u, int wr, int wc, int fr, int fq) const {
        const int row0 = u.pm * BM + wr * 64 + fr, col0 = (u.pn % npn) * BM + wc * 32 + 8 * fq;
#pragma unroll
        for (int ai = 0; ai < 2; ++ai)
#pragma unroll
            for (int m = 0; m < 4; ++m) { bf16_t* rowp = O + (size_t)(row0 + ai * HALF + m * 16) * ldc + col0;
#pragma unroll
                for (int bj = 0; bj < 2; ++bj) { const f32x4 v0 = acc[ai][bj][m][0] * osc, v1 = acc[ai][bj][m][1] * osc;
                    u32x4 w; w.x = pkbf(v0[0], v0[1]); w.y = pkbf(v0[2], v0[3]); w.z = pkbf(v1[0], v1[1]); w.w = pkbf(v1[2], v1[3]);
                    *(u32x4*)(rowp + bj * HALF) = w; } }
    }
};
struct EpiStoreRes {
    static constexpr bool PERM = true, AFTER_DRAIN = false;
    bf16_t* O; int ldc; int npn; const bf16_t* R;
    __device__ __forceinline__ void operator()(const f32x4 (&acc)[2][2][4][2], const Unit& u, int wr, int wc, int fr, int fq) const {
        const int row0 = u.pm * BM + wr * 64 + fr, col0 = (u.pn % npn) * BM + wc * 32 + 8 * fq;
        u32x4 res[2][4][2];
#pragma unroll
        for (int ai = 0; ai < 2; ++ai)
#pragma unroll
            for (int m = 0; m < 4; ++m)
#pragma unroll
                for (int bj = 0; bj < 2; ++bj) res[ai][m][bj] = *(const u32x4*)(R + (size_t)(row0 + ai * HALF + m * 16) * ldc + col0 + bj * HALF);
#pragma unroll
        for (int ai = 0; ai < 2; ++ai)
#pragma unroll
            for (int m = 0; m < 4; ++m) { bf16_t* rowp = O + (size_t)(row0 + ai * HALF + m * 16) * ldc + col0;
#pragma unroll
                for (int bj = 0; bj < 2; ++bj) { const f32x4 v0 = acc[ai][bj][m][0], v1 = acc[ai][bj][m][1]; const u32x4 r = res[ai][m][bj];
                    u32x4 w; w.x = pkbf(v0[0] + bflo(r.x), v0[1] + bfhi(r.x)); w.y = pkbf(v0[2] + bflo(r.y), v0[3] + bfhi(r.y)); w.z = pkbf(v1[0] + bflo(r.z), v1[1] + bfhi(r.z)); w.w = pkbf(v1[2] + bflo(r.w), v1[3] + bfhi(r.w));
                    *(u32x4*)(rowp + bj * HALF) = w; } }
    }
};
struct EpiStoreRS {
    static constexpr bool PERM = true, AFTER_DRAIN = false;
    bf16_t* O; int ldc; int npn; const float* rs;
    __device__ __forceinline__ void operator()(const f32x4 (&acc)[2][2][4][2], const Unit& u, int wr, int wc, int fr, int fq) const {
        const int row0 = u.pm * BM + wr * 64 + fr, col0 = (u.pn % npn) * BM + wc * 32 + 8 * fq;
        float rsall[2][4];
#pragma unroll
        for (int ai = 0; ai < 2; ++ai)
#pragma unroll
            for (int m = 0; m < 4; ++m) rsall[ai][m] = rs[row0 + ai * HALF + m * 16];
#pragma unroll
        for (int ai = 0; ai < 2; ++ai)
#pragma unroll
            for (int m = 0; m < 4; ++m) { const int row = row0 + ai * HALF + m * 16; bf16_t* rowp = O + (size_t)row * ldc + col0; const float osc = rsall[ai][m];
#pragma unroll
                for (int bj = 0; bj < 2; ++bj) { const f32x4 v0 = acc[ai][bj][m][0] * osc, v1 = acc[ai][bj][m][1] * osc;
                    u32x4 w; w.x = pkbf(v0[0], v0[1]); w.y = pkbf(v0[2], v0[3]); w.z = pkbf(v1[0], v1[1]); w.w = pkbf(v1[2], v1[3]);
                    *(u32x4*)(rowp + bj * HALF) = w; } }
    }
};
struct EpiStore8 {
    static constexpr bool PERM = true, AFTER_DRAIN = false;
    unsigned char* O; int ldc; int npn; float osc;
    __device__ __forceinline__ void operator()(const f32x4 (&acc)[2][2][4][2], const Unit& u, int wr, int wc, int fr, int fq) const {
        const int row0 = u.pm * BM + wr * 64 + fr, col0 = (u.pn % npn) * BM + wc * 32 + 8 * fq;
#pragma unroll
        for (int ai = 0; ai < 2; ++ai)
#pragma unroll
            for (int m = 0; m < 4; ++m) { unsigned char* rowp = O + (size_t)(row0 + ai * HALF + m * 16) * ldc + col0;
#pragma unroll
                for (int bj = 0; bj < 2; ++bj) { const f32x4 v0 = acc[ai][bj][m][0] * osc, v1 = acc[ai][bj][m][1] * osc;
                    u32x2 w; w.x = pk4_fp8(v0[0], v0[1], v0[2], v0[3]); w.y = pk4_fp8(v1[0], v1[1], v1[2], v1[3]);
                    *(u32x2*)(rowp + bj * HALF) = w; } }
    }
};
struct EpiGelu {
    static constexpr bool PERM = true, AFTER_DRAIN = false;
    bf16_t* O; int ldc; float* stat; int vtile0; const float* rs; PG8_LAS float* red; int nrows;
    __device__ __forceinline__ void operator()(const f32x4 (&acc)[2][2][4][2], const Unit& u, int wr, int wc, int fr, int fq) const {
        const int row0 = u.pm * BM + wr * 64 + fr, col0 = u.pn * BM + wc * 32 + 8 * fq;
        const bool isv = u.pn >= vtile0;
        float rsall[2][4];
#pragma unroll
        for (int ai = 0; ai < 2; ++ai)
#pragma unroll
            for (int m = 0; m < 4; ++m) rsall[ai][m] = rs[row0 + ai * HALF + m * 16];
#pragma unroll
        for (int ai = 0; ai < 2; ++ai)
#pragma unroll
            for (int m = 0; m < 4; ++m) { const int row = row0 + ai * HALF + m * 16; bf16_t* rowp = O + (size_t)row * ldc + col0; float s1 = 0.f, s2 = 0.f; const float rsc = rsall[ai][m];
                f2v s1v = (f2v){0.f, 0.f}, s2v = (f2v){0.f, 0.f};
#pragma unroll
                for (int bj = 0; bj < 2; ++bj) { const f32x4 v0 = acc[ai][bj][m][0] * rsc, v1 = acc[ai][bj][m][1] * rsc;
                    const f2v g0 = gelu_tanh2((f2v){v0[0], v0[1]}), g1 = gelu_tanh2((f2v){v0[2], v0[3]}), g2 = gelu_tanh2((f2v){v1[0], v1[1]}), g3 = gelu_tanh2((f2v){v1[2], v1[3]});
                    s1v += (g0 + g1) + (g2 + g3); s2v += g0 * g0; s2v += g1 * g1; s2v += g2 * g2; s2v += g3 * g3;
                    u32x4 w; w.x = pkbf(g0.x, g0.y); w.y = pkbf(g1.x, g1.y); w.z = pkbf(g2.x, g2.y); w.w = pkbf(g3.x, g3.y);
                    *(u32x4*)(rowp + bj * HALF) = w; }
                s1 = s1v.x + s1v.y; s2 = s2v.x + s2v.y;
                if (isv) { s1 += __shfl_xor(s1, 16); s1 += __shfl_xor(s1, 32); s2 += __shfl_xor(s2, 16); s2 += __shfl_xor(s2, 32);
                    if (fq == 0) { PG8_LAS float* rp = red + (((wr * 4 + wc) * 128 + ai * 64 + m * 16 + fr) << 1); rp[0] = s1; rp[1] = s2; } } }
        if (isv) {
            asm volatile("s_waitcnt lgkmcnt(0)" ::: "memory"); __builtin_amdgcn_s_barrier(); asm volatile("" ::: "memory");
            if (wc == 0) {
#pragma unroll
                for (int k = 0; k < 2; ++k) { const int rl = fq * 16 + fr + 64 * k; float t1 = 0.f, t2 = 0.f;
#pragma unroll
                    for (int w = 0; w < 4; ++w) { const PG8_LAS float* rp = red + (((wr * 4 + w) * 128 + rl) << 1); t1 += rp[0]; t2 += rp[1]; }
                    const int row = u.pm * BM + (rl >> 6) * HALF + wr * 64 + (rl & 63);
                    f2v o; o.x = t1; o.y = t2; *(f2v*)(stat + ((size_t)(u.pn - vtile0) * nrows + row) * 2) = o; } }
        }
    }
};
struct EpiGlu {
    static constexpr bool PERM = true, AFTER_DRAIN = false;
    const bf16_t* G; int ldg; bf16_t* O; int ldo; int ocol0; const float* bias;
    __device__ __forceinline__ void operator()(const f32x4 (&acc)[2][2][4][2], const Unit& u, int wr, int wc, int fr, int fq) const {
        const int row0 = u.pm * BM + wr * 64 + fr, col0 = u.pn * BM + wc * 32 + 8 * fq;
        f32x4 bv[2][2];
#pragma unroll
        for (int bj = 0; bj < 2; ++bj)
#pragma unroll
            for (int n = 0; n < 2; ++n) bv[bj][n] = *(const f32x4*)(bias + col0 + bj * HALF + 4 * n);
        u32x4 gall[2][4][2];
#pragma unroll
        for (int ai = 0; ai < 2; ++ai)
#pragma unroll
            for (int m = 0; m < 4; ++m)
#pragma unroll
                for (int bj = 0; bj < 2; ++bj) gall[ai][m][bj] = *(const u32x4*)(G + (size_t)(row0 + ai * HALF + m * 16) * ldg + col0 + bj * HALF);
#pragma unroll
        for (int ai = 0; ai < 2; ++ai)
#pragma unroll
            for (int m = 0; m < 4; ++m) { const int row = row0 + ai * HALF + m * 16;
#pragma unroll
                for (int bj = 0; bj < 2; ++bj) { const f32x4 v0 = acc[ai][bj][m][0] + bv[bj][0], v1 = acc[ai][bj][m][1] + bv[bj][1];
                    const u32x4 gw = gall[ai][m][bj];
                    u32x4 w;
                    w.x = pkbf(bflo(gw.x) * sigmoidf_(v0[0]), bfhi(gw.x) * sigmoidf_(v0[1]));
                    w.y = pkbf(bflo(gw.y) * sigmoidf_(v0[2]), bfhi(gw.y) * sigmoidf_(v0[3]));
                    w.z = pkbf(bflo(gw.z) * sigmoidf_(v1[0]), bfhi(gw.z) * sigmoidf_(v1[1]));
                    w.w = pkbf(bflo(gw.w) * sigmoidf_(v1[2]), bfhi(gw.w) * sigmoidf_(v1[3]));
                    *(u32x4*)(O + (size_t)row * ldo + ocol0 + col0 + bj * HALF) = w; } }
    }
};
struct EpiSwiglu8 {
    static constexpr bool PERM = true, AFTER_DRAIN = false;
    unsigned char* O; int ldc; int npn; float osc, hsc; int guard;
    __device__ __forceinline__ void operator()(const f32x4 (&acc)[2][2][4][2], const Unit& u, int wr, int wc, int fr, int fq) const {
        const int row0 = (guard == 12346 ? (int)blockIdx.x : u.pm) * BM + wr * 64 + fr, col0 = (guard == 12346 ? 0 : (u.pn % npn)) * HALF + wc * 32 + 8 * fq;
#pragma unroll
        for (int ai = 0; ai < 2; ++ai)
#pragma unroll
            for (int m = 0; m < 4; ++m) { const f32x4 a0 = acc[ai][0][m][0], a1 = acc[ai][0][m][1], b0 = acc[ai][1][m][0], b1 = acc[ai][1][m][1];
                const float c1 = osc * (-1.4426950408889634f), c2 = osc * osc * hsc;
                const f2v h0 = swiglu2((f2v){a0[0], a0[1]}, (f2v){b0[0], b0[1]}, c1, c2), h1 = swiglu2((f2v){a0[2], a0[3]}, (f2v){b0[2], b0[3]}, c1, c2);
                const f2v h2 = swiglu2((f2v){a1[0], a1[1]}, (f2v){b1[0], b1[1]}, c1, c2), h3 = swiglu2((f2v){a1[2], a1[3]}, (f2v){b1[2], b1[3]}, c1, c2);
                u32x2 w; w.x = pk4_fp8(h0.x, h0.y, h1.x, h1.y); w.y = pk4_fp8(h2.x, h2.y, h3.x, h3.y);
                if (guard != 12345 || wr == 1) *(u32x2*)(O + (size_t)(row0 + ai * HALF + m * 16) * ldc + col0) = w; }
    }
};
struct EpiRes {
    static constexpr bool PERM = false, AFTER_DRAIN = false;
    const float* base; float* out; int ldc;
    __device__ __forceinline__ void operator()(const f32x4 (&acc)[2][2][4][2], const Unit& u, int wr, int wc, int fr, int fq) const {
        const int row0 = u.pm * BM + wr * 64 + fr, col0 = u.pn * BM + wc * 32 + 4 * fq;
#pragma unroll
        for (int ai = 0; ai < 2; ++ai)
#pragma unroll
            for (int m = 0; m < 4; ++m) { const size_t off = (size_t)(row0 + ai * HALF + m * 16) * ldc + col0;
#pragma unroll
                for (int bj = 0; bj < 2; ++bj)
#pragma unroll
                    for (int n = 0; n < 2; ++n) { const f32x4 bs = *(const f32x4*)(base + off + bj * HALF + n * 16); *(f32x4*)(out + off + bj * HALF + n * 16) = bs + acc[ai][bj][m][n]; } }
    }
};
template <class Epi, class Sched, bool ALIGN_EPI = false, bool SP2 = false, bool F8 = false, bool GATHER = false>
__device__ __forceinline__ void gemm_phase(PG8_LAS unsigned char* lds, const Gemm g, const Sched& S, const Epi& E) {
    int tid_ = threadIdx.x; asm volatile("" : "+v"(tid_));
    const int tid = tid_, wid = __builtin_amdgcn_readfirstlane(tid >> 6), lane = tid & 63, wr = wid >> 2, wc = wid & 3, fr = lane & 15, fq = lane >> 4;
    const int K = g.K, nt = K / BK;
    unsigned voffA[2], voffB[2];
#pragma unroll
    for (int i = 0; i < 2; ++i) { int R, C; stage_rc(tid * 16 + i * 8192, R, C); const int Rb = Epi::PERM ? ((R & ~31) + perm32(R & 31)) : R;
        voffA[i] = (unsigned)(R * K + C) * 2u; voffB[i] = (unsigned)(Rb * K + C) * 2u; }
    PG8_LAS int* rowtab = (PG8_LAS int*)(lds + STAGE_BYTES);
    unsigned vAc[2][2] = {{0u, 0u}, {0u, 0u}};
#define PG8_ROWDMA(pm_) do { if (wid < 4) __builtin_amdgcn_global_load_lds((const unsigned*)(g.rowtok + (pm_) * BM + wid * 64 + lane), (PG8_LAS unsigned*)(rowtab + wid * 64), 4, 0, 0); } while (0)
#define PG8_ROWREAD(dst) do { int tt_ = tid; asm volatile("" : "+v"(tt_));   \
        _Pragma("unroll") for (int i_ = 0; i_ < 2; ++i_) { int R_, C_; stage_rc(tt_ * 16 + i_ * 8192, R_, C_); \
            _Pragma("unroll") for (int h_ = 0; h_ < 2; ++h_) dst[h_][i_] = (unsigned)rowtab[h_ * HALF + R_] * (unsigned)(K * 2) + (unsigned)C_ * 2u; } } while (0)
#define PG8_STAGE_A(bufoff, gbase, half, usenext) do { if constexpr (GATHER) { PG8_STAGE(bufoff, gbase, vAc[half]); } \
        else { PG8_STAGE(bufoff, (gbase) + ((half) ? hstep : (size_t)0), voffA); } } while (0)
    const size_t kstep = (size_t)(BK * 2);
    const size_t hstep = (size_t)HALF * K * 2;
    const size_t tstep = 2 * hstep;
    const unsigned ldsw = (unsigned)wid * 1024u;
    const int aoff = lds_byte(wr * 64 + fr, fq * 8), boff = lds_byte(wc * 32 + fr, fq * 8);
#define PG8_SA(b, h) (((b) * 2 + (h)) * HTB)
#define PG8_SB(b, h) ((4 + (b) * 2 + (h)) * HTB)
#define PG8_STAGE(bufoff, gbase, voff) do { _Pragma("unroll") for (int _i = 0; _i < 2; ++_i) \
        __builtin_amdgcn_global_load_lds((const unsigned*)((const char*)(gbase) + (voff)[_i]), (PG8_LAS unsigned*)(lds + (bufoff) + ldsw + _i * 8192), 16, 0, 0); } while (0)
#define PG8_LDA(dst, b, h) do { _Pragma("unroll") for (int m = 0; m < 4; ++m) _Pragma("unroll") for (int k = 0; k < 2; ++k) dst[m][k] = *(const PG8_LAS bf16x8*)(lds + PG8_SA(b, h) + aoff + m * 2048 + k * 1024); } while (0)
#define PG8_LDB(dst, b, h) do { _Pragma("unroll") for (int n = 0; n < 2; ++n) _Pragma("unroll") for (int k = 0; k < 2; ++k) dst[n][k] = *(const PG8_LAS bf16x8*)(lds + PG8_SB(b, h) + boff + n * 2048 + k * 1024); } while (0)
#define PG8_MMA(ai, bj, At, Bt) do { __builtin_amdgcn_s_setprio(1); \
        if constexpr (F8) { _Pragma("unroll") for (int m = 0; m < 4; ++m) _Pragma("unroll") for (int n = 0; n < 2; ++n) \
            asm volatile("v_mfma_scale_f32_16x16x128_f8f6f4 %0, %1, %2, %0, %3, %3 op_sel_hi:[0,0,0]" : "+v"(acc[ai][bj][m][n]) : "v"(cat8(Bt[n][0], Bt[n][1])), "v"(cat8(At[m][0], At[m][1])), "v"(0x7f7f7f7f)); } \
        else { _Pragma("unroll") for (int m = 0; m < 4; ++m) _Pragma("unroll") for (int n = 0; n < 2; ++n) _Pragma("unroll") for (int k = 0; k < 2; ++k) \
            acc[ai][bj][m][n] = __builtin_amdgcn_mfma_f32_16x16x32_bf16(Bt[n][k], At[m][k], acc[ai][bj][m][n], 0, 0, 0); } \
        __builtin_amdgcn_s_setprio(0); } while (0)
#define PG8_WAIT_V(n) asm volatile("s_waitcnt vmcnt(" #n ")" ::: "memory")
#define PG8_WAIT_L(n) asm volatile("s_waitcnt lgkmcnt(" #n ")" ::: "memory")
#define PG8_BAR __builtin_amdgcn_s_barrier()
#define PG8_SCHED __builtin_amdgcn_sched_barrier(0)
#define PG8_ACCFENCE(NOPS) do { if constexpr (F8) { _Pragma("unroll") for (int a_ = 0; a_ < 2; ++a_) _Pragma("unroll") for (int b_ = 0; b_ < 2; ++b_) \
        asm volatile(NOPS : "+v"(acc[a_][b_][0][0]), "+v"(acc[a_][b_][0][1]), "+v"(acc[a_][b_][1][0]), "+v"(acc[a_][b_][1][1]), "+v"(acc[a_][b_][2][0]), "+v"(acc[a_][b_][2][1]), "+v"(acc[a_][b_][3][0]), "+v"(acc[a_][b_][3][1])); } } while (0)
    Unit cur, nxt; int ui = 0;
    if (!S.next(0, cur)) return;
    f32x4 acc[2][2][4][2];
#pragma unroll
    for (int a = 0; a < 2; ++a)
#pragma unroll
        for (int b = 0; b < 2; ++b)
#pragma unroll
            for (int m = 0; m < 4; ++m)
#pragma unroll
                for (int n = 0; n < 2; ++n) acc[a][b][m][n] = (f32x4){0.f, 0.f, 0.f, 0.f};
    PG8_ACCFENCE("s_nop 1");
    bf16x8 At[4][2], B0[2][2], B1[2][2];
    const char* cA = GATHER ? (const char*)g.A : (const char*)g.A + (size_t)cur.pm * tstep; const char* cB = (const char*)g.Bt + (size_t)cur.pn * tstep;
    S.a_ready(cur);
    if constexpr (GATHER) { PG8_ROWDMA(cur.pm); PG8_WAIT_V(0); PG8_BAR; PG8_ROWREAD(vAc); PG8_WAIT_L(0); PG8_BAR; }
    if constexpr (SP2) {
        PG8_STAGE(PG8_SB(0, 0), cB, voffB); PG8_STAGE(PG8_SB(0, 1), cB + hstep, voffB); PG8_STAGE_A(PG8_SA(0, 0), cA, 0, false); PG8_STAGE_A(PG8_SA(0, 1), cA, 1, false);
        if (wr == 1) PG8_BAR;
        PG8_WAIT_V(2); PG8_BAR;
        PG8_STAGE(PG8_SB(1, 0), cB + kstep, voffB); PG8_STAGE_A(PG8_SA(1, 0), cA + kstep, 0, false); PG8_STAGE(PG8_SB(1, 1), cB + hstep + kstep, voffB);
        PG8_WAIT_V(6); PG8_BAR;
    } else {
        PG8_STAGE(PG8_SB(0, 0), cB, voffB); PG8_STAGE(PG8_SA(0, 0), cA, voffA); PG8_STAGE(PG8_SB(0, 1), cB + hstep, voffB); PG8_STAGE(PG8_SA(0, 1), cA + hstep, voffA);
        if (wr == 1) PG8_BAR;
        PG8_WAIT_V(4); PG8_BAR;
        PG8_STAGE(PG8_SB(1, 0), cB + kstep, voffB); PG8_STAGE(PG8_SA(1, 0), cA + kstep, voffA); PG8_STAGE(PG8_SB(1, 1), cB + hstep + kstep, voffB);
        PG8_WAIT_V(6); PG8_BAR;
    }
    for (;;) {
        const bool has_next = S.next(ui + 1, nxt);
        const char* nA = (has_next && !GATHER) ? (const char*)g.A + (size_t)nxt.pm * tstep : cA;
        if constexpr (GATHER) { if (has_next) PG8_ROWDMA(nxt.pm); } const char* nB = has_next ? (const char*)g.Bt + (size_t)nxt.pn * tstep : cB;
        for (int t = 0; t < nt; t += 2) {
            const bool last = (t == nt - 2);
            const char* a1 = cA + (size_t)(t + 1) * kstep;
            const char* a2 = last ? nA : cA + (size_t)(t + 2) * kstep; const char* b2 = last ? nB : cB + (size_t)(t + 2) * kstep;
            const char* a3 = a2 + kstep; const char* b3 = b2 + kstep;
            if (last && has_next) S.a_ready(nxt);

            if constexpr (SP2) {
            PG8_LDB(B0, 0, 0); PG8_LDB(B1, 0, 1); PG8_SCHED; PG8_LDA(At, 0, 0); PG8_STAGE_A(PG8_SA(1, 1), a1, 1, false);
            if constexpr (GATHER) { if (last && has_next) PG8_ROWREAD(vAc); }
            PG8_WAIT_V(8); PG8_WAIT_L(0); PG8_BAR; PG8_MMA(0, 0, At, B0); PG8_MMA(0, 1, At, B1); PG8_BAR; PG8_SCHED;
            PG8_LDA(At, 0, 1); PG8_STAGE(PG8_SB(0, 0), b2, voffB); PG8_STAGE(PG8_SB(0, 1), b2 + hstep, voffB); PG8_STAGE_A(PG8_SA(0, 0), a2, 0, last);
            PG8_WAIT_V(8); PG8_WAIT_L(0); PG8_BAR; PG8_MMA(1, 0, At, B0); PG8_MMA(1, 1, At, B1); PG8_BAR; PG8_SCHED;
            PG8_LDB(B0, 1, 0); PG8_LDB(B1, 1, 1); PG8_SCHED; PG8_LDA(At, 1, 0); PG8_STAGE_A(PG8_SA(0, 1), a2, 1, last);
            PG8_WAIT_V(8); PG8_WAIT_L(0); PG8_BAR; PG8_MMA(0, 0, At, B0); PG8_MMA(0, 1, At, B1); PG8_BAR; PG8_SCHED;
            PG8_LDA(At, 1, 1); PG8_STAGE(PG8_SB(1, 0), b3, voffB); PG8_STAGE(PG8_SB(1, 1), b3 + hstep, voffB); PG8_STAGE_A(PG8_SA(1, 0), a3, 0, last);
            PG8_WAIT_V(8); PG8_WAIT_L(0); PG8_BAR; PG8_MMA(1, 0, At, B0); PG8_MMA(1, 1, At, B1); PG8_BAR; PG8_SCHED;
            } else {
            PG8_LDB(B0, 0, 0); PG8_SCHED; PG8_LDA(At, 0, 0); PG8_STAGE(PG8_SA(1, 1), a1 + hstep, voffA);
            PG8_WAIT_L(8); PG8_BAR; PG8_WAIT_L(0); PG8_MMA(0, 0, At, B0); PG8_BAR; PG8_SCHED;
            PG8_LDB(B1, 0, 1); PG8_STAGE(PG8_SB(0, 0), b2, voffB);
            PG8_BAR; PG8_WAIT_L(0); PG8_MMA(0, 1, At, B1); PG8_BAR;
            PG8_LDA(At, 0, 1); PG8_STAGE(PG8_SA(0, 0), a2, voffA);
            PG8_BAR; PG8_WAIT_L(0); PG8_MMA(1, 0, At, B0); PG8_BAR; PG8_SCHED;
            PG8_STAGE(PG8_SB(0, 1), b2 + hstep, voffB);
            PG8_WAIT_V(6); PG8_BAR; PG8_MMA(1, 1, At, B1); PG8_BAR;
            PG8_LDB(B0, 1, 0); PG8_SCHED; PG8_LDA(At, 1, 0); PG8_STAGE(PG8_SA(0, 1), a2 + hstep, voffA);
            PG8_WAIT_L(8); PG8_BAR; PG8_WAIT_L(0); PG8_MMA(0, 0, At, B0); PG8_BAR; PG8_SCHED;
            PG8_LDB(B1, 1, 1); PG8_STAGE(PG8_SB(1, 0), b3, voffB);
            PG8_BAR; PG8_WAIT_L(0); PG8_MMA(0, 1, At, B1); PG8_BAR;
            PG8_LDA(At, 1, 1); PG8_STAGE(PG8_SA(1, 0), a3, voffA);
            PG8_BAR; PG8_WAIT_L(0); PG8_MMA(1, 0, At, B0); PG8_BAR; PG8_SCHED;
            PG8_STAGE(PG8_SB(1, 1), b3 + hstep, voffB);
            PG8_WAIT_V(6); PG8_BAR; PG8_MMA(1, 1, At, B1); PG8_BAR;
            }
        }
        PG8_ACCFENCE("s_nop 15\n\ts_nop 7");
        if constexpr (ALIGN_EPI) { if (wr == 0) PG8_BAR; }
        if constexpr (!Epi::AFTER_DRAIN) { E(acc, cur, wr, wc, fr, fq); S.done(cur); }
        if (!has_next) break;
#pragma unroll
        for (int a = 0; a < 2; ++a)
#pragma unroll
            for (int b = 0; b < 2; ++b)
#pragma unroll
                for (int m = 0; m < 4; ++m)
#pragma unroll
                    for (int n = 0; n < 2; ++n) acc[a][b][m][n] = (f32x4){0.f, 0.f, 0.f, 0.f};
        PG8_ACCFENCE("s_nop 1");
        cur = nxt; cA = nA; cB = nB; ++ui;
        if constexpr (ALIGN_EPI) { if (wr == 1) PG8_BAR; }
    }
    PG8_WAIT_V(0);
    if constexpr (!ALIGN_EPI) { if (wr == 0) PG8_BAR; }
    PG8_BAR;
    if constexpr (Epi::AFTER_DRAIN) { E.fused(acc, cur, wr, wc, fr, fq, lds, wid, lane); S.done(cur); }
#undef PG8_SA
#undef PG8_SB
#undef PG8_STAGE
#undef PG8_LDA
#undef PG8_LDB
#undef PG8_MMA
#undef PG8_WAIT_V
#undef PG8_WAIT_L
#undef PG8_BAR
#undef PG8_SCHED
#undef PG8_ROWDMA
#undef PG8_ROWREAD
#undef PG8_STAGE_A
#undef PG8_ACCFENCE
}
}

constexpr int NWAVES = 8, NT = NWAVES * 64;
#ifndef MK_N_LAUNCHES
#define MK_N_LAUNCHES 1
#endif
constexpr int BATCH = 4, SEQ = 4096, D = 2048, M = BATCH * SEQ;
constexpr int AW = 1024, KVW = 256, SW = 1024, EIN = 2560;
constexpr int QOFF = 0, KOFF = 1024, VOFF = 1280, UOFF = 1536;
constexpr int NE = 16, CAP = 512, FF = 2048, MS = NE * BATCH * CAP;
constexpr int GW = 2048, ZW = 4096;
constexpr float EPS = 1e-6f;

constexpr size_t MiB = 1u << 20, KiB = 1u << 10;
constexpr size_t WS_CTL = 0, CTL_ZERO_BYTES = 1 * MiB;
constexpr int CW_TMO = 0, CW_CODE = 1, CW_BAR = 4096;
constexpr size_t WS_STAT = 256 * KiB;
constexpr size_t WS_LUT = 1 * MiB;
constexpr size_t WS_LAM = WS_LUT + 16 * KiB;
constexpr size_t WS_LAM512 = WS_LAM + 64 * KiB;
constexpr size_t WS_BB = WS_LAM512 + 64 * KiB;
constexpr size_t WS_CM = WS_BB + 512 * KiB;
constexpr size_t WS_SGU = WS_CM + 512 * KiB;
constexpr size_t WS_E = 4 * MiB;
constexpr size_t WS_AFF = 6 * MiB;
constexpr size_t WS_IDX = 7 * MiB;
constexpr size_t WS_GATE = WS_IDX + 128 * KiB;
constexpr size_t WS_TOK = WS_IDX + 256 * KiB;
constexpr size_t WS_INV = 8 * MiB;
constexpr size_t WS_STATP = 11 * MiB;
constexpr size_t WS_RSTD0 = 10 * MiB + 64 * KiB;
constexpr size_t WS_RSTD = 10 * MiB;
constexpr size_t WS_WIN0 = 16 * MiB, WS_GLU = 26 * MiB, WS_WOUT0 = 28 * MiB, WS_WIN1 = 36 * MiB, WS_WOUT1 = 52 * MiB;
constexpr size_t WS_W13 = 64 * MiB, WS_W2 = 576 * MiB;
constexpr float WSC = 256.f, HSC = 8.f, HIDSC = 8.f, YSC = 32.f;
constexpr size_t WS_H = 832 * MiB, WS_XA = 896 * MiB, WS_XB = 1024 * MiB;
constexpr size_t WS_X16 = WS_XB + 64 * MiB;
constexpr size_t WS_XS = 1152 * MiB, WS_HID = 1280 * MiB, WS_YS = 1408 * MiB;
constexpr size_t WS_PROJ = 1536 * MiB, WS_CAT = 1616 * MiB, WS_G = 1680 * MiB, WS_YF = 1712 * MiB;
constexpr size_t WS_Z = 1536 * MiB, WS_G2 = 1664 * MiB;
constexpr size_t WS_END = 1776 * MiB;

constexpr int SCR_BYTES = 143360;
constexpr int LDSCTL_OFF = SCR_BYTES, MISC_OFF = LDSCTL_OFF + 320;
constexpr int LDS_BYTES = 151552;
constexpr int EPI_STG_OFF = 131072 + 1024;
static_assert(EPI_STG_OFF + 2 * 32 * 136 <= SCR_BYTES, "epilogue staging");

#define GAS __attribute__((address_space(1)))
#define LAS __attribute__((address_space(3)))
typedef unsigned short bf16;
typedef unsigned v4u __attribute__((ext_vector_type(4)));
typedef unsigned v2u __attribute__((ext_vector_type(2)));
typedef float f32x4 __attribute__((ext_vector_type(4)));
typedef float f32x16 __attribute__((ext_vector_type(16)));
typedef short bf16x8 __attribute__((ext_vector_type(8)));
typedef short s16x4 __attribute__((ext_vector_type(4)));
typedef GAS unsigned gu32;
#define RLX_AGENT __ATOMIC_RELAXED, __HIP_MEMORY_SCOPE_AGENT
#define LDS_WAIT() asm volatile("s_waitcnt lgkmcnt(0)" ::: "memory")
#define VM_WAIT() asm volatile("s_waitcnt vmcnt(0)" ::: "memory")
using pg8::pkbf; using pg8::pk4_fp8; using pg8::bflo; using pg8::bfhi; using pg8::gelu_tanh;
__device__ __forceinline__ bf16 f2bf1(float f) { return (bf16)(pkbf(f, 0.f) & 0xffffu); }
__device__ __forceinline__ float bf2f(bf16 b) { return __builtin_bit_cast(float, ((unsigned)b) << 16); }
#define MFMA32(a, b, c) __builtin_amdgcn_mfma_f32_32x32x16_bf16((a), (b), (c), 0, 0, 0)
#define MFMA16(a, b, c) __builtin_amdgcn_mfma_f32_16x16x32_bf16((a), (b), (c), 0, 0, 0)
__device__ __forceinline__ int crow(int reg, int h) { return (reg & 3) + 8 * (reg >> 2) + 4 * h; }
__device__ __forceinline__ float wave_sum(float v) {
#pragma unroll
    for (int o = 1; o < 64; o <<= 1) v += __shfl_xor(v, o);
    return v;
}
#define XB_TMO      128
#define XB_XCNT(j)  (256  + 64 * (j))
#define XB_XSUB(j)  (1280 + 64 * (j))
#define XB_XGEN(j)  (2304 + 64 * (j))
#define XB_TOP      3328
#define XB_TOPGEN   3392
#define XCD_BAR_WORDS 3456
#define XB_SPIN_CAP (1u << 18)

__device__ __forceinline__ unsigned xb_ld(unsigned* p)              { return __hip_atomic_load(p, __ATOMIC_RELAXED, __HIP_MEMORY_SCOPE_AGENT); }
__device__ __forceinline__ unsigned xb_add(unsigned* p, unsigned v) { return __hip_atomic_fetch_add(p, v, __ATOMIC_RELAXED, __HIP_MEMORY_SCOPE_AGENT); }
__device__ __forceinline__ unsigned xb_xcc_id() { return (unsigned)__builtin_amdgcn_s_getreg((3 << 11) | 20) & 0xFu; }
#define XB_SPIN(cond, bar) do { unsigned _sp = 0; while (cond) { __builtin_amdgcn_s_sleep(1); \
    if ((++_sp & 255u) == 0u) { if (xb_ld(&(bar)[XB_TMO])) break; if (_sp > XB_SPIN_CAP) { atomicAdd(&(bar)[XB_TMO], 1u); break; } } } } while (0)

struct XcdBarrier {
    unsigned* bar; unsigned x;
    volatile LAS unsigned* st;
};

__device__ __forceinline__ XcdBarrier xcd_barrier_post(unsigned* bar, volatile LAS unsigned* st) {
    XcdBarrier b; b.bar = bar; b.x = xb_xcc_id(); b.st = st;
    if (threadIdx.x == 0) (void)xb_add(&bar[XB_XCNT(b.x)], 1u);
    return b;
}
__device__ __forceinline__ void xcd_barrier_complete(unsigned* bar, unsigned x, unsigned& nloc, unsigned& nx) {
    const unsigned G = gridDim.x * gridDim.y * gridDim.z;
    unsigned sum, cnt, mine, sp = 0u;
    for (;;) {
        sum = 0u; cnt = 0u; mine = 0u;
#pragma unroll
        for (unsigned j = 0; j < 16; ++j) { const unsigned c = xb_ld(&bar[XB_XCNT(j)]); sum += c; cnt += (c > 0u) ? 1u : 0u; mine = (j == x) ? c : mine; }
        if (sum == G) break;
        __builtin_amdgcn_s_sleep(1);
        if ((++sp & 255u) == 0u) { if (xb_ld(&bar[XB_TMO])) break; if (sp > XB_SPIN_CAP) { atomicAdd(&bar[XB_TMO], 1u); break; } }
    }
    nloc = mine > 0u ? mine : 1u; nx = cnt > 0u ? cnt : 1u;
}

__device__ __forceinline__ void xcd_barrier(const XcdBarrier& b) {
    asm volatile("s_waitcnt vmcnt(0)" ::: "memory");
    __syncthreads();
    if (threadIdx.x == 0) {
        unsigned* bar = b.bar;
        __builtin_amdgcn_s_waitcnt(0);
        unsigned nloc = b.st[0], nx = b.st[1];
        if (nloc == 0u) { xcd_barrier_complete(bar, b.x, nloc, nx); b.st[0] = nloc; b.st[1] = nx; }
        const unsigned old = xb_add(&bar[XB_XSUB(b.x)], 1u);
        const unsigned gen = old / nloc;
        if (old + 1u == (gen + 1u) * nloc) {
            __builtin_amdgcn_fence(__ATOMIC_RELEASE, "agent");
            asm volatile("s_waitcnt vmcnt(0)" ::: "memory");
            const unsigned og = xb_add(&bar[XB_TOP], 1u);
            const unsigned tg = og / nx;
            if (og + 1u == (tg + 1u) * nx) xb_add(&bar[XB_TOPGEN], 1u);
            else XB_SPIN(xb_ld(&bar[XB_TOPGEN]) == tg, bar);
            __builtin_amdgcn_fence(__ATOMIC_ACQUIRE, "agent");
            xb_add(&bar[XB_XGEN(b.x)], 1u);
            asm volatile("s_waitcnt vmcnt(0)" ::: "memory");
        } else {
            XB_SPIN(xb_ld(&bar[XB_XGEN(b.x)]) == gen, bar);
            __builtin_amdgcn_fence(__ATOMIC_ACQUIRE, "agent");
            asm volatile("s_waitcnt vmcnt(0)" ::: "memory");
        }
    }
    __syncthreads();
}

struct Frame {
    LAS unsigned char* lds;
    volatile LAS unsigned* MISC;
    gu32* ctl;
    unsigned char* ws;
    int tid, lane, wave, vcu, G;
    const float* in[28];
    float* out;
};
enum { I_X = 0, I_RELB, I_MIXN, I_FFNN, I_FINN, I_EWIN, I_SINK, I_ARE, I_AIM, I_LDT, I_BRE, I_BIM, I_CRE, I_CIM, I_SSMD, I_GLUW, I_GLUB, I_EWOUT,
       I_OWIN, I_LNG, I_LNB, I_SGUW, I_SGUB, I_OWOUT, I_ROUTER, I_W1, I_W3, I_W2 };

__device__ __forceinline__ void p0_transpose_item(const float* W, int K, int N, bf16* WT, int row_base, LAS float* scr, int k0, int n0, int lane, const float* kgain = nullptr) {
#pragma unroll 8
    for (int i = 0; i < 32; ++i) { const int kk = 2 * i + (lane >> 5); float w = W[(size_t)(k0 + kk) * N + n0 + (lane & 31)]; if (kgain) w *= kgain[k0 + kk]; scr[kk * 33 + (lane & 31)] = w; }
    LDS_WAIT(); asm volatile("" ::: "memory");
    const int c = lane & 7;
#pragma unroll
    for (int j = 0; j < 4; ++j) { const int n = (lane >> 3) + 8 * j; const LAS float* s = scr + (8 * c) * 33 + n;
        v4u o; o.x = pkbf(s[0 * 33], s[1 * 33]); o.y = pkbf(s[2 * 33], s[3 * 33]); o.z = pkbf(s[4 * 33], s[5 * 33]); o.w = pkbf(s[6 * 33], s[7 * 33]);
        *(GAS v4u*)(WT + (size_t)(row_base + n) * K + k0 + 8 * c) = o; }
    LDS_WAIT(); asm volatile("" ::: "memory");
}
__device__ __forceinline__ void p0_item8_load(const float* W, int N, int k0, int n0, int lane, f32x4 (&t)[16]) {
#pragma unroll
    for (int i = 0; i < 16; ++i) t[i] = *(const GAS f32x4*)(W + (size_t)(k0 + 8 * i + (lane >> 3)) * N + n0 + 4 * (lane & 7));
}
__device__ __forceinline__ unsigned bperm(unsigned hi, unsigned lo, unsigned sel) { return __builtin_amdgcn_perm(hi, lo, sel); }
__device__ __forceinline__ void p0_item8_finish(const f32x4 (&t)[16], int K, unsigned char* WT, int row_base, LAS float* scr, int k0, int lane, float sc) {
    LAS unsigned* tile = (LAS unsigned*)scr;
#pragma unroll
    for (int i = 0; i < 16; ++i) tile[(8 * i + (lane >> 3)) * 9 + (lane & 7)] = pk4_fp8(t[i].x * sc, t[i].y * sc, t[i].z * sc, t[i].w * sc);
    LDS_WAIT(); asm volatile("" ::: "memory");
    const int n4 = lane >> 3, kg = lane & 7;
    unsigned r[16];
#pragma unroll
    for (int j = 0; j < 16; ++j) r[j] = tile[(16 * kg + j) * 9 + n4];
    LDS_WAIT(); asm volatile("" ::: "memory");
    v4u o[4];
#pragma unroll
    for (int q = 0; q < 4; ++q) { const unsigned a = bperm(r[4 * q + 1], r[4 * q], 0x05010400u), b = bperm(r[4 * q + 1], r[4 * q], 0x07030602u), c = bperm(r[4 * q + 3], r[4 * q + 2], 0x05010400u), d = bperm(r[4 * q + 3], r[4 * q + 2], 0x07030602u);
        o[0][q] = bperm(c, a, 0x05040100u); o[1][q] = bperm(c, a, 0x07060302u); o[2][q] = bperm(d, b, 0x05040100u); o[3][q] = bperm(d, b, 0x07060302u); }
#pragma unroll
    for (int b = 0; b < 4; ++b) *(GAS v4u*)(WT + (size_t)(row_base + 4 * n4 + b) * K + k0 + 16 * kg) = o[b];
}
__device__ __forceinline__ int t5_bucket(int rel) {
    const int n = rel < 0 ? -rel : rel; int b;
    if (n < 8) b = n; else { b = 8 + (31 - __clz(n * n)) - 6; if (b > 15) b = 15; }
    return b + (rel > 0 ? 16 : 0);
}
__device__ __forceinline__ void sincos_d(double x, double& s, double& c) {
    const double q = __builtin_rint(x * 0.63661977236758134308);
    const double r = (x - q * 1.57079632673412561417) - q * 6.07710050650619224932e-11;
    const double r2 = r * r;
    const double sp = r * (1.0 + r2 * (-1.0 / 6 + r2 * (1.0 / 120 + r2 * (-1.0 / 5040 + r2 * (1.0 / 362880 + r2 * (-1.0 / 39916800 + r2 * (1.0 / 6227020800.0)))))));
    const double cp = 1.0 + r2 * (-0.5 + r2 * (1.0 / 24 + r2 * (-1.0 / 720 + r2 * (1.0 / 40320 + r2 * (-1.0 / 3628800 + r2 * (1.0 / 479001600.0 + r2 * (-1.0 / 87178291200.0)))))));
    const int qi = (int)((long long)q & 3);
    s = (qi == 0) ? sp : (qi == 1) ? cp : (qi == 2) ? -sp : -cp;
    c = (qi == 0) ? cp : (qi == 1) ? -sp : (qi == 2) ? -cp : sp;
}
constexpr int SS_C1_ = 12, SS_C2_ = 22;
constexpr int IPM = (D / 128) * (FF / 32);
constexpr int EXP_ITEMS = 3 * NE * IPM;
struct ExpItem { const float* W; unsigned char* WT; int row_base, k0, n0; };
__device__ __forceinline__ ExpItem expert_item_desc(Frame& F, int layer, int it) {
    const int which = it / (NE * IPM), r0 = it % (NE * IPM), mat = layer * NE + r0 / IPM, r = r0 % IPM, nb = FF / 32, k0 = 128 * (r / nb), n0 = 32 * (r % nb);
    const size_t moff = (size_t)mat * D * FF; ExpItem e; e.k0 = k0; e.n0 = n0;
    if (which == 0) { e.W = F.in[I_W1] + moff; e.WT = F.ws + WS_W13 + (size_t)mat * 2 * FF * D; e.row_base = (n0 >> 7) * 256 + (n0 & 127); }
    else if (which == 1) { e.W = F.in[I_W3] + moff; e.WT = F.ws + WS_W13 + (size_t)mat * 2 * FF * D; e.row_base = (n0 >> 7) * 256 + 128 + (n0 & 127); }
    else { e.W = F.in[I_W2] + moff; e.WT = F.ws + WS_W2 + (size_t)mat * FF * D; e.row_base = n0; }
    return e;
}
__device__ __forceinline__ void expert_items(Frame& F, LAS float* scr, int layer, int first, int step, int end) {
    for (int it = first; it < end; it += 2 * step) { f32x4 ta[16], tb[16]; const ExpItem ea = expert_item_desc(F, layer, it); const bool hb = it + step < end;
        const ExpItem eb = expert_item_desc(F, layer, hb ? it + step : it);
        p0_item8_load(ea.W, FF, ea.k0, ea.n0, F.lane, ta);
        if (hb) p0_item8_load(eb.W, FF, eb.k0, eb.n0, F.lane, tb);
        p0_item8_finish(ta, D, ea.WT, ea.row_base, scr, ea.k0, F.lane, WSC);
        if (hb) p0_item8_finish(tb, D, eb.WT, eb.row_base, scr, eb.k0, F.lane, WSC); }
}
constexpr int CW_Q = 2048, CW_DONE9 = 2112, CW_Q0 = 2176, CW_DONE1 = 2240, CW_DONE5 = 2304, CW_DONE10 = 2368, CW_DONE12 = 2432, QBATCH = 4;
__device__ __forceinline__ void conv_bg(Frame& F, int layer, gu32* stop, unsigned stopcount) {
    LAS float* scr = (LAS float*)(F.lds + F.wave * 17408);
    for (;;) {
        if (stop) { unsigned d = 0u; if (F.lane == 0) d = __hip_atomic_load(stop, RLX_AGENT); d = (unsigned)__builtin_amdgcn_readfirstlane((int)d); if (d >= stopcount) break; }
        unsigned it0 = 0u; if (F.lane == 0) it0 = __hip_atomic_fetch_add(F.ctl + (layer ? CW_Q : CW_Q0), (unsigned)QBATCH, RLX_AGENT); it0 = (unsigned)__builtin_amdgcn_readfirstlane((int)it0);
        if (layer == 0 && F.G * NWAVES == 2048) it0 += (unsigned)((SS_C1_ + SS_C2_) * 1024);
        if (it0 >= (unsigned)EXP_ITEMS) break;
        expert_items(F, scr, layer, (int)it0, 1, (int)it0 + QBATCH);
    }
}
__device__ __forceinline__ void p0_prologue(Frame& F) {
    LAS float* scr = (LAS float*)(F.lds + F.wave * 17408);
    const int gw = F.vcu * NWAVES + F.wave, NGW = F.G * NWAVES;
    bf16* WIN0 = (bf16*)(F.ws + WS_WIN0); bf16* GLU = (bf16*)(F.ws + WS_GLU); bf16* WOUT0 = (bf16*)(F.ws + WS_WOUT0); bf16* WIN1 = (bf16*)(F.ws + WS_WIN1); bf16* WOUT1 = (bf16*)(F.ws + WS_WOUT1);
    constexpr int I0 = (D / 64) * (EIN / 32), I1 = (SW / 64) * (SW / 32), I2 = (D / 64) * (D / 32), I3 = (D / 64) * (ZW / 32), I4 = I2;
    constexpr int NSM = I0 + I1 + I2 + I3 + I4;
    for (int it = gw; it < NSM; it += NGW) {
        int r = it;
        if (r < I0) { const int nb = EIN / 32; p0_transpose_item(F.in[I_EWIN], D, EIN, WIN0, 32 * (r % nb), scr, 64 * (r / nb), 32 * (r % nb), F.lane, F.in[I_MIXN]); continue; } r -= I0;
        if (r < I1) { const int nb = SW / 32; p0_transpose_item(F.in[I_GLUW], SW, SW, GLU, 32 * (r % nb), scr, 64 * (r / nb), 32 * (r % nb), F.lane); continue; } r -= I1;
        if (r < I2) { const int nb = D / 32; p0_transpose_item(F.in[I_EWOUT], D, D, WOUT0, 32 * (r % nb), scr, 64 * (r / nb), 32 * (r % nb), F.lane); continue; } r -= I2;
        if (r < I3) { const int nb = ZW / 32; p0_transpose_item(F.in[I_OWIN], D, ZW, WIN1, 32 * (r % nb), scr, 64 * (r / nb), 32 * (r % nb), F.lane, F.in[I_MIXN] + D); continue; } r -= I3;
        { const int nb = D / 32; p0_transpose_item(F.in[I_OWOUT], D, D, WOUT1, 32 * (r % nb), scr, 64 * (r / nb), 32 * (r % nb), F.lane); }
    }
    { bf16* SG = (bf16*)(F.ws + WS_SGU); const float* sw = F.in[I_SGUW];
      for (int i = (F.vcu * NT + F.tid) * 4; i < 16 * 128 * 128; i += F.G * NT * 4) { const f32x4 v = *(const f32x4*)(sw + i); v2u w; w.x = pkbf(v.x, v.y); w.y = pkbf(v.z, v.w); *(v2u*)(SG + i) = w; } }
    { float* LUT = (float*)(F.ws + WS_LUT); const float* rb = F.in[I_RELB];
      for (int i = F.vcu * NT + F.tid; i < 8 * 512; i += F.G * NT) { const int hd = i >> 9, rel = (i & 511) - 256; float v = -1e30f; if (rel >= -128 && rel <= 128) v = rb[t5_bucket(rel) * 8 + hd]; LUT[i] = v; } }
    { float* LAM = (float*)(F.ws + WS_LAM); float* LAM512 = (float*)(F.ws + WS_LAM512); bf16* BB = (bf16*)(F.ws + WS_BB); bf16* CM = (bf16*)(F.ws + WS_CM);
      for (int i = F.vcu * NT + F.tid; i < 2 * 64 * 64; i += F.G * NT) {
          const int p = i & 63, dg = i >> 6;
          const double dt = (double)expf(F.in[I_LDT][dg]); const double ar = (double)F.in[I_ARE][i], ai = (double)F.in[I_AIM][i];
          const double mag = (double)expf((float)(ar * dt)); double sn, cs; sincos_d(ai * dt, sn, cs);
          const double lbr = mag * cs, lbi = mag * sn, den = ar * ar + ai * ai, nr = lbr - 1.0;
          const double cr = (nr * ar + lbi * ai) / den, ci = (lbi * ar - nr * ai) / den;
          LAM[2 * i] = (float)lbr; LAM[2 * i + 1] = (float)lbi;
          const double mag5 = (double)expf((float)(512.0 * ar * dt)); double s5, c5; sincos_d(512.0 * ai * dt, s5, c5);
          LAM512[2 * i] = (float)(mag5 * c5); LAM512[2 * i + 1] = (float)(mag5 * s5);
#pragma unroll
          for (int c = 0; c < 16; ++c) { const double br = (double)F.in[I_BRE][(size_t)i * 16 + c], bi = (double)F.in[I_BIM][(size_t)i * 16 + c];
              BB[((size_t)dg * 128 + 2 * p) * 16 + c] = f2bf1((float)(cr * br - ci * bi)); BB[((size_t)dg * 128 + 2 * p + 1) * 16 + c] = f2bf1((float)(cr * bi + ci * br));
              CM[((size_t)dg * 16 + c) * 128 + 2 * p] = f2bf1(F.in[I_CRE][((size_t)dg * 16 + c) * 64 + p]); CM[((size_t)dg * 16 + c) * 128 + 2 * p + 1] = f2bf1(-F.in[I_CIM][((size_t)dg * 16 + c) * 64 + p]); }
      } }
    { bf16* X16 = (bf16*)(F.ws + WS_X16); float* RS0 = (float*)(F.ws + WS_RSTD0);
      for (int m = gw; m < M; m += NGW) { const GAS f32x4* xr = (const GAS f32x4*)(F.in[I_X] + (size_t)m * D) + F.lane; f32x4 v[8]; float s = 0.f;
#pragma unroll
          for (int j = 0; j < 8; ++j) { v[j] = xr[64 * j]; s += (v[j].x * v[j].x + v[j].y * v[j].y) + (v[j].z * v[j].z + v[j].w * v[j].w); }
#pragma unroll
          for (int j = 0; j < 8; ++j) { v2u w; w.x = pkbf(v[j].x, v[j].y); w.y = pkbf(v[j].z, v[j].w); *((GAS v2u*)(X16 + (size_t)m * D) + F.lane + 64 * j) = w; }
          const float rstd = 1.0f / sqrtf(wave_sum(s) * (1.f / D) + EPS); if (F.lane == 0) RS0[m] = rstd; } }
}

constexpr int AT_P = 272;
constexpr int AT_K = 0, AT_VT = 128 * AT_P, AT_LUT = 2 * 128 * AT_P;
__device__ __forceinline__ void attn_unit(Frame& F, int unit) {
    const bf16* PROJ = (const bf16*)(F.ws + WS_PROJ); bf16* CAT = (bf16*)(F.ws + WS_CAT); const float* LUTG = (const float*)(F.ws + WS_LUT);
    const int hp = unit & 1, kvh = (unit >> 1) & 1, blk = (unit >> 2) & 31, b = unit >> 7;
    const int lane = F.lane, r = lane & 31, h = lane >> 5, hh = F.wave >> 2, head = kvh * 4 + hp * 2 + hh, qrow0 = (F.wave & 3) * 32;
    LAS unsigned char* lds = F.lds; LAS float* LUT = (LAS float*)(lds + AT_LUT);
    __syncthreads();
    for (int i = F.tid; i < 1024; i += NT) LUT[i] = LUTG[(kvh * 4 + hp * 2 + (i >> 9)) * 512 + (i & 511)] * 1.4426950408889634f;
    const size_t tq = (size_t)b * SEQ + blk * 128 + qrow0 + r;
    bf16x8 qf[8];
#pragma unroll
    for (int s = 0; s < 8; ++s) qf[s] = *(const bf16x8*)(PROJ + tq * EIN + QOFF + head * 128 + 16 * s + 8 * h);
    float mrun = F.in[I_SINK][head] * 1.4426950408889634f, lrun = 1.0f;
    f32x16 oacc[4];
#pragma unroll
    for (int dt = 0; dt < 4; ++dt)
#pragma unroll
        for (int i = 0; i < 16; ++i) oacc[dt][i] = 0.f;
    const int kb0 = blk > 0 ? blk - 1 : 0, kb1 = blk < SEQ / 128 - 1 ? blk + 1 : SEQ / 128 - 1;
    v4u kreg[4], vreg[4];
#define AT_LOADKV(kb_) do { const size_t tok0_ = (size_t)b * SEQ + (kb_) * 128; _Pragma("unroll") for (int i = 0; i < 4; ++i) { const int c = F.tid + NT * i, row = c >> 4, ch = c & 15, row2 = c & 127, ch2 = c >> 7; \
        kreg[i] = *(const v4u*)(PROJ + (tok0_ + row) * EIN + KOFF + kvh * 128 + ch * 8); vreg[i] = *(const v4u*)(PROJ + (tok0_ + row2) * EIN + VOFF + kvh * 128 + ch2 * 8); } } while (0)
    AT_LOADKV(kb0);
    for (int kb = kb0; kb <= kb1; ++kb) {
        __syncthreads();
#pragma unroll
        for (int i = 0; i < 4; ++i) { const int c = F.tid + NT * i, row = c >> 4, ch = c & 15, row2 = c & 127, ch2 = c >> 7;
            const v4u kv = kreg[i], vv = vreg[i];
            *(LAS v4u*)(lds + AT_K + row * AT_P + ch * 16) = kv;
            LAS bf16* vt = (LAS bf16*)(lds + AT_VT + (ch2 * 8) * AT_P + row2 * 2);
            vt[0 * (AT_P / 2)] = (bf16)(vv.x & 0xffffu); vt[1 * (AT_P / 2)] = (bf16)(vv.x >> 16); vt[2 * (AT_P / 2)] = (bf16)(vv.y & 0xffffu); vt[3 * (AT_P / 2)] = (bf16)(vv.y >> 16);
            vt[4 * (AT_P / 2)] = (bf16)(vv.z & 0xffffu); vt[5 * (AT_P / 2)] = (bf16)(vv.z >> 16); vt[6 * (AT_P / 2)] = (bf16)(vv.w & 0xffffu); vt[7 * (AT_P / 2)] = (bf16)(vv.w >> 16); }
        if (kb < kb1) AT_LOADKV(kb + 1);
        __syncthreads();
#pragma unroll 1
        for (int kp = 0; kp < 2; ++kp) {
            if ((kb < blk && kp == 0 && qrow0 >= 64) || (kb > blk && kp == 1 && qrow0 < 64)) continue;
            f32x16 sacc[2];
#pragma unroll
            for (int q = 0; q < 2; ++q)
#pragma unroll
                for (int i = 0; i < 16; ++i) sacc[q][i] = 0.f;
#pragma unroll
            for (int s = 0; s < 8; ++s) {
                const bf16x8 a0 = *(const LAS bf16x8*)(lds + AT_K + (64 * kp + r) * AT_P + (16 * s + 8 * h) * 2);
                const bf16x8 a1 = *(const LAS bf16x8*)(lds + AT_K + (64 * kp + 32 + r) * AT_P + (16 * s + 8 * h) * 2);
                sacc[0] = MFMA32(a0, qf[s], sacc[0]); sacc[1] = MFMA32(a1, qf[s], sacc[1]); }
            const int relbase = (kb - blk) * 128 + 64 * kp + 4 * h - qrow0 - r + 256 + hh * 512;
            float x[32]; float tmax = -3.0e38f;
#pragma unroll
            for (int q = 0; q < 2; ++q)
#pragma unroll
                for (int i = 0; i < 16; ++i) { x[16 * q + i] = sacc[q][i] * (0.08838834764831845f * 1.4426950408889634f) + LUT[relbase + 32 * q + (i & 3) + 8 * (i >> 2)]; tmax = fmaxf(tmax, x[16 * q + i]); }
            tmax = fmaxf(tmax, __shfl_xor(tmax, 32));
            const float mnew = fmaxf(mrun, tmax);
            if (__ballot(mnew > mrun) != 0ull) {
                const float alpha = __builtin_amdgcn_exp2f(mrun - mnew); lrun *= alpha;
#pragma unroll
                for (int dt = 0; dt < 4; ++dt)
#pragma unroll
                    for (int i = 0; i < 16; ++i) oacc[dt][i] *= alpha;
            }
            mrun = mnew;
            float psum = 0.f;
#pragma unroll
            for (int i = 0; i < 32; ++i) { x[i] = __builtin_amdgcn_exp2f(x[i] - mnew); psum += x[i]; }
            psum += __shfl_xor(psum, 32);
            lrun += psum;
            bf16x8 pb[4];
#pragma unroll
            for (int s2 = 0; s2 < 4; ++s2) { v4u w; w.x = pkbf(x[8 * s2 + 0], x[8 * s2 + 1]); w.y = pkbf(x[8 * s2 + 2], x[8 * s2 + 3]); w.z = pkbf(x[8 * s2 + 4], x[8 * s2 + 5]); w.w = pkbf(x[8 * s2 + 6], x[8 * s2 + 7]); pb[s2] = __builtin_bit_cast(bf16x8, w); }
#pragma unroll
            for (int s2 = 0; s2 < 4; ++s2)
#pragma unroll
                for (int dt = 0; dt < 4; ++dt) { const LAS unsigned char* vp = lds + AT_VT + (32 * dt + r) * AT_P + (64 * kp + 16 * s2 + 4 * h) * 2;
                    const s16x4 lo = *(const LAS s16x4*)vp, hi = *(const LAS s16x4*)(vp + 16);
                    const bf16x8 a = __builtin_shufflevector(lo, hi, 0, 1, 2, 3, 4, 5, 6, 7);
                    oacc[dt] = MFMA32(a, pb[s2], oacc[dt]); }
        }
    }
#undef AT_LOADKV
    __syncthreads();
    const float inv = 1.0f / lrun;
    LAS unsigned char* ob = lds + F.wave * (32 * AT_P);
#pragma unroll
    for (int dt = 0; dt < 4; ++dt)
#pragma unroll
        for (int i = 0; i < 16; ++i) *(LAS bf16*)(ob + r * AT_P + (32 * dt + crow(i, h)) * 2) = f2bf1(oacc[dt][i] * inv);
    LDS_WAIT(); asm volatile("" ::: "memory");
    const size_t trow0 = (size_t)b * SEQ + blk * 128 + qrow0;
#pragma unroll
    for (int i = 0; i < 8; ++i) { const int c = lane + 64 * i, row = c >> 4, ch = c & 15;
        const v4u v = *(const LAS v4u*)(ob + row * AT_P + ch * 16);
        *(GAS v4u*)(CAT + (trow0 + row) * D + head * 128 + ch * 8) = v; }
}

constexpr int SS_XP = 66;
constexpr int SS_HP = 272;
constexpr int SS_SP = 20;
constexpr int SS_TILE8 = 64 * 36;
constexpr int SS_WAVE_BYTES = 32 * SS_HP + 32 * SS_SP * 4 + SS_TILE8;
constexpr int SS_C1 = SS_C1_, SS_C2 = SS_C2_;
struct HalfItem { const float* W; unsigned char* WT; int row_base, k0, n0; };
__device__ __forceinline__ HalfItem half_item_desc(Frame& F, int hid) { const ExpItem e = expert_item_desc(F, 0, hid >> 1); HalfItem h; h.W = e.W; h.WT = e.WT; h.row_base = e.row_base; h.k0 = e.k0 + 64 * (hid & 1); h.n0 = e.n0; return h; }
__device__ __forceinline__ void half_load(const HalfItem& h, int lane, f32x4 (&t)[8]) {
#pragma unroll
    for (int i = 0; i < 8; ++i) t[i] = *(const GAS f32x4*)(h.W + (size_t)(h.k0 + 8 * i + (lane >> 3)) * FF + h.n0 + 4 * (lane & 7));
}
__device__ __forceinline__ void half_finish(const HalfItem& h, const f32x4 (&t)[8], LAS unsigned* tile, int lane) {
#pragma unroll
    for (int i = 0; i < 8; ++i) tile[(8 * i + (lane >> 3)) * 9 + (lane & 7)] = pk4_fp8(t[i].x * WSC, t[i].y * WSC, t[i].z * WSC, t[i].w * WSC);
    LDS_WAIT(); asm volatile("" ::: "memory");
    const int kg = lane & 3, n4 = (lane >> 2) & 7, hf = lane >> 5;
    unsigned r[16];
#pragma unroll
    for (int j = 0; j < 16; ++j) r[j] = tile[(16 * kg + j) * 9 + n4];
    LDS_WAIT(); asm volatile("" ::: "memory");
    const unsigned selA = hf ? 0x07030602u : 0x05010400u;
    v4u o0, o1;
#pragma unroll
    for (int q = 0; q < 4; ++q) { const unsigned lo = bperm(r[4 * q + 1], r[4 * q], selA), hi = bperm(r[4 * q + 3], r[4 * q + 2], selA); o0[q] = bperm(hi, lo, 0x05040100u); o1[q] = bperm(hi, lo, 0x07060302u); }
    unsigned char* dst = h.WT + (size_t)(h.row_base + 4 * n4 + 2 * hf) * D + h.k0 + 16 * kg;
    *(GAS v4u*)dst = o0; *(GAS v4u*)(dst + D) = o1;
}
static_assert(NWAVES * SS_WAVE_BYTES <= SCR_BYTES && 32 * SS_XP * 4 <= 32 * SS_HP, "S5 scratch");

template <int DIR, int MODE>
__device__ __forceinline__ void ssm_superchunk(Frame& F, int b, int g, int sc, float& hre, float& him, int cv_first, int cv_n) {
    const bf16* PROJ = (const bf16*)(F.ws + WS_PROJ);
    const int lane = F.lane, r = lane & 31, h = lane >> 5, dg = DIR * 64 + g;
    LAS unsigned* XS = (LAS unsigned*)(F.lds + F.wave * SS_WAVE_BYTES); LAS unsigned char* HS = (LAS unsigned char*)XS;
    LAS float* ST = (LAS float*)(HS + 32 * SS_HP);
    LAS unsigned* tile8 = (LAS unsigned*)(HS + 32 * SS_HP + 32 * SS_SP * 4);
    const float2 lam = ((const float2*)(F.ws + WS_LAM))[dg * 64 + lane];
    bf16x8 bbf[4];
#pragma unroll
    for (int t = 0; t < 4; ++t) bbf[t] = *(const bf16x8*)((const bf16*)(F.ws + WS_BB) + ((size_t)dg * 128 + 32 * t + r) * 16 + 8 * h);
    const bf16* cmp_ = (const bf16*)(F.ws + WS_CM) + ((size_t)dg * 16 + (lane & 15)) * 128 + 8 * (lane >> 4);
    const size_t tsc = (size_t)b * SEQ + sc * 512;
    bf16* YF = (bf16*)(F.ws + WS_YF); bf16* G = (bf16*)(F.ws + WS_G);
    const int cb = g * 16 + 8 * h;
    f32x4 dsk0 = (f32x4){0.f, 0.f, 0.f, 0.f}, dsk1 = dsk0;
    if (MODE == 2) { dsk0 = *(const f32x4*)(F.in[I_SSMD] + cb); dsk1 = *(const f32x4*)(F.in[I_SSMD] + cb + 4); }
    const size_t tfirst = tsc + (DIR ? 15 : 0) * 32;
    bf16x8 uf = *(const bf16x8*)(PROJ + (tfirst + r) * EIN + UOFF + cb);
    v4u yfv = (v4u){0u, 0u, 0u, 0u};
    if (MODE == 2) yfv = *(const v4u*)(YF + (tfirst + r) * SW + cb);
    HalfItem cvh = {}; f32x4 cvt[8];
    if (cv_n > 0) { cvh = half_item_desc(F, cv_first); half_load(cvh, lane, cvt); }
#pragma unroll 1
    for (int ci = 0; ci < 16; ++ci) {
        const int ch = DIR ? 15 - ci : ci; const size_t t0 = tsc + ch * 32;
        const int chn = (ci < 15) ? (DIR ? ch - 1 : ch + 1) : ch; const size_t tn = tsc + chn * 32;
        const bf16x8 uf_n = *(const bf16x8*)(PROJ + (tn + r) * EIN + UOFF + cb);
        v4u yfn = (v4u){0u, 0u, 0u, 0u};
        if (MODE == 2) yfn = *(const v4u*)(YF + (tn + r) * SW + cb);

#pragma unroll
        for (int t = 0; t < 4; ++t) { f32x16 xa;
#pragma unroll
            for (int i = 0; i < 16; ++i) xa[i] = 0.f;
            xa = MFMA32(bbf[t], uf, xa);
#pragma unroll
            for (int k = 0; k < 4; ++k) { v2u w; w.x = pkbf(xa[4 * k], xa[4 * k + 1]); w.y = pkbf(xa[4 * k + 2], xa[4 * k + 3]);
                *(LAS v2u*)(XS + r * SS_XP + 16 * t + 4 * k + 2 * h) = w; } }
        LDS_WAIT(); asm volatile("" ::: "memory");
        float xr[32], xi[32];
#pragma unroll
        for (int s = 0; s < 32; ++s) { const unsigned x2 = XS[s * SS_XP + lane]; xr[s] = bflo(x2); xi[s] = bfhi(x2); }
        LDS_WAIT(); asm volatile("" ::: "memory");
#pragma unroll
        for (int st = 0; st < 32; ++st) { const int s = DIR ? 31 - st : st;
            const float nr = lam.x * hre - lam.y * him + xr[s], ni = lam.x * him + lam.y * hre + xi[s]; hre = nr; him = ni;
            if (MODE != 0) *(LAS unsigned*)(HS + s * SS_HP + lane * 4) = pkbf(nr, ni); }
        if (ci < cv_n) { half_finish(cvh, cvt, tile8, lane);
            if (ci + 1 < cv_n) { cvh = half_item_desc(F, cv_first + (ci + 1) * 2048); half_load(cvh, lane, cvt); } }
        if (MODE != 0) {
            LDS_WAIT(); asm volatile("" ::: "memory");
            f32x4 y[2]; bf16x8 cmf[4];
#pragma unroll
            for (int ks = 0; ks < 4; ++ks) cmf[ks] = *(const bf16x8*)(cmp_ + 32 * ks);
#pragma unroll
            for (int rt = 0; rt < 2; ++rt) { y[rt] = (f32x4){0.f, 0.f, 0.f, 0.f};
#pragma unroll
                for (int ks = 0; ks < 4; ++ks) { const bf16x8 a = *(const LAS bf16x8*)(HS + (16 * rt + (lane & 15)) * SS_HP + (32 * ks + 8 * (lane >> 4)) * 2); y[rt] = MFMA16(a, cmf[ks], y[rt]); } }
#pragma unroll
            for (int rt = 0; rt < 2; ++rt)
#pragma unroll
                for (int j = 0; j < 4; ++j) ST[(16 * rt + 4 * (lane >> 4) + j) * SS_SP + (lane & 15)] = y[rt][j];
            LDS_WAIT(); asm volatile("" ::: "memory");
            const f32x4 ya = *(const LAS f32x4*)(ST + r * SS_SP + 8 * h), yb = *(const LAS f32x4*)(ST + r * SS_SP + 8 * h + 4);
            LDS_WAIT(); asm volatile("" ::: "memory");
            v4u o;
            if (MODE == 1 || MODE == 3) { o.x = pkbf(ya.x, ya.y); o.y = pkbf(ya.z, ya.w); o.z = pkbf(yb.x, yb.y); o.w = pkbf(yb.z, yb.w); if (MODE == 1 || F.G == 12345) *(v4u*)(YF + (t0 + r) * SW + cb) = o; }
            else {
                const v4u uw = __builtin_bit_cast(v4u, uf);
                const float v0 = ya.x + bflo(yfv.x) + dsk0.x * bflo(uw.x), v1 = ya.y + bfhi(yfv.x) + dsk0.y * bfhi(uw.x), v2 = ya.z + bflo(yfv.y) + dsk0.z * bflo(uw.y), v3 = ya.w + bfhi(yfv.y) + dsk0.w * bfhi(uw.y);
                const float v4 = yb.x + bflo(yfv.z) + dsk1.x * bflo(uw.z), v5 = yb.y + bfhi(yfv.z) + dsk1.y * bfhi(uw.z), v6 = yb.z + bflo(yfv.w) + dsk1.z * bflo(uw.w), v7 = yb.w + bfhi(yfv.w) + dsk1.w * bfhi(uw.w);
                o.x = pkbf(gelu_tanh(v0), gelu_tanh(v1)); o.y = pkbf(gelu_tanh(v2), gelu_tanh(v3)); o.z = pkbf(gelu_tanh(v4), gelu_tanh(v5)); o.w = pkbf(gelu_tanh(v6), gelu_tanh(v7));
                *(v4u*)(G + (t0 + r) * SW + cb) = o; }
        }
        uf = uf_n; yfv = yfn;
    }
}
__device__ __forceinline__ void ssm_pass1(Frame& F) {
    float* E = (float*)(F.ws + WS_E);
    const bool cvon = F.G * NWAVES == 2048; const int wg = F.vcu * NWAVES + F.wave; int li0 = 0;
    for (int task = F.vcu * NWAVES + F.wave; task < BATCH * 64 * 2 * 8; task += F.G * NWAVES, li0 += 16) {
        const int sc = task & 7, dir = (task >> 3) & 1, g = (task >> 4) & 63, b = task >> 10;
        float hre = 0.f, him = 0.f;
        const int cn = cvon ? (SS_C1 - li0 < 0 ? 0 : (SS_C1 - li0 > 16 ? 16 : SS_C1 - li0)) : 0, cf = li0 * 2048 + wg;
        if (dir == 0) ssm_superchunk<0, 0>(F, b, g, sc, hre, him, cf, cn); else ssm_superchunk<1, 0>(F, b, g, sc, hre, him, cf, cn);
        E[(size_t)task * 128 + F.lane] = hre; E[(size_t)task * 128 + 64 + F.lane] = him;
    }
}
__device__ __forceinline__ void ssm_pass2(Frame& F) {
    const float* E = (const float*)(F.ws + WS_E);
    const bool cvon = F.G * NWAVES == 2048; const int wg = F.vcu * NWAVES + F.wave;
    for (int task = F.vcu * NWAVES + F.wave; task < BATCH * 64 * 8; task += F.G * NWAVES) {
        const int sc = task & 7, g = (task >> 3) & 63, b = task >> 9;
        const int c0 = cvon ? (SS_C2 > 16 ? 16 : SS_C2) : 0, c1n = cvon ? (SS_C2 > 16 ? SS_C2 - 16 : 0) : 0;
        { const float2 l5 = ((const float2*)(F.ws + WS_LAM512))[(0 * 64 + g) * 64 + F.lane]; float cr = 0.f, ci = 0.f;
          float er[7], ei[7];
#pragma unroll
          for (int s2 = 0; s2 < 7; ++s2) { const float* e = E + ((size_t)(((b * 64 + g) * 2 + 0) * 8 + s2)) * 128; er[s2] = e[F.lane]; ei[s2] = e[64 + F.lane]; }
#pragma unroll
          for (int s2 = 0; s2 < 7; ++s2) if (s2 < sc) { const float nr = l5.x * cr - l5.y * ci + er[s2], ni = l5.x * ci + l5.y * cr + ei[s2]; cr = nr; ci = ni; }
#if defined(PROBE_SSM_M1)
          { float c2r = cr, c2i = ci; ssm_superchunk<0, 1>(F, b, g, sc, c2r, c2i, 0, 0); }
#endif
#if defined(PROBE_SSM_M3)
          { float c2r = cr, c2i = ci; ssm_superchunk<0, 3>(F, b, g, sc, c2r, c2i, 0, 0); }
#endif
          ssm_superchunk<0, 1>(F, b, g, sc, cr, ci, SS_C1 * 2048 + wg, c0); }
        { const float2 l5 = ((const float2*)(F.ws + WS_LAM512))[(1 * 64 + g) * 64 + F.lane]; float cr = 0.f, ci = 0.f;
          float er[7], ei[7];
#pragma unroll
          for (int q = 0; q < 7; ++q) { const float* e = E + ((size_t)(((b * 64 + g) * 2 + 1) * 8 + 7 - q)) * 128; er[q] = e[F.lane]; ei[q] = e[64 + F.lane]; }
#pragma unroll
          for (int q = 0; q < 7; ++q) if (7 - q > sc) { const float nr = l5.x * cr - l5.y * ci + er[q], ni = l5.x * ci + l5.y * cr + ei[q]; cr = nr; ci = ni; }
          ssm_superchunk<1, 2>(F, b, g, sc, cr, ci, (SS_C1 + 16) * 2048 + wg, c1n); }
    }
}

__device__ __forceinline__ void router_phase(Frame& F, const bf16* X16, const float* gain, const float* router) {
    unsigned char* H = F.ws + WS_H; float* AFF = (float*)(F.ws + WS_AFF);
    LAS f32x4* RL = (LAS f32x4*)F.lds;
    __syncthreads();
    for (int q = F.tid; q < 2048 * 4; q += NT) { const int d = q >> 2, e4 = q & 3; const f32x4 v = *(const f32x4*)(router + d * 16 + e4 * 4);
        RL[(((d >> 8) * 4 + (d & 3)) * 4 + e4) * 64 + ((d & 255) >> 2)] = v; }
    __syncthreads();
    const int lane = F.lane;
    f32x4 gn[8];
#pragma unroll
    for (int j = 0; j < 8; ++j) gn[j] = *((const GAS f32x4*)gain + lane + 64 * j);
    for (int pr = F.vcu * NWAVES + F.wave; pr < M / 2; pr += F.G * NWAVES) {
        const size_t t0 = (size_t)pr * 2;
        f32x4 v0[8], v1[8]; float s0 = 0.f, s1 = 0.f;
#pragma unroll
        for (int j = 0; j < 8; ++j) {
            { const v2u x0 = *((const GAS v2u*)(X16 + t0 * D) + lane + 64 * j), x1 = *((const GAS v2u*)(X16 + (t0 + 1) * D) + lane + 64 * j);
                v0[j] = (f32x4){bflo(x0.x), bfhi(x0.x), bflo(x0.y), bfhi(x0.y)}; v1[j] = (f32x4){bflo(x1.x), bfhi(x1.x), bflo(x1.y), bfhi(x1.y)}; }
            s0 += (v0[j].x * v0[j].x + v0[j].y * v0[j].y) + (v0[j].z * v0[j].z + v0[j].w * v0[j].w); s1 += (v1[j].x * v1[j].x + v1[j].y * v1[j].y) + (v1[j].z * v1[j].z + v1[j].w * v1[j].w); }
        const float r0 = 1.0f / sqrtf(wave_sum(s0) * (1.f / D) + EPS), r1 = 1.0f / sqrtf(wave_sum(s1) * (1.f / D) + EPS);
        f32x4 a0[4], a1[4];
#pragma unroll
        for (int e4 = 0; e4 < 4; ++e4) { a0[e4] = (f32x4){0.f, 0.f, 0.f, 0.f}; a1[e4] = (f32x4){0.f, 0.f, 0.f, 0.f}; }
#pragma unroll
        for (int j = 0; j < 8; ++j) { v0[j] = v0[j] * r0 * gn[j]; v1[j] = v1[j] * r1 * gn[j];
            *((GAS unsigned*)(H + t0 * D) + lane + 64 * j) = pk4_fp8(v0[j].x * HSC, v0[j].y * HSC, v0[j].z * HSC, v0[j].w * HSC);
            *((GAS unsigned*)(H + (t0 + 1) * D) + lane + 64 * j) = pk4_fp8(v1[j].x * HSC, v1[j].y * HSC, v1[j].z * HSC, v1[j].w * HSC);
#pragma unroll
            for (int i = 0; i < 4; ++i) {
#pragma unroll
                for (int e4 = 0; e4 < 4; ++e4) { const f32x4 w = RL[((j * 4 + i) * 4 + e4) * 64 + lane]; a0[e4] += w * v0[j][i]; a1[e4] += w * v1[j][i]; }
                asm volatile("" ::: "memory"); } }
        int ln = lane; asm volatile("" : "+v"(ln));
        float lg[2];
#pragma unroll
        for (int t = 0; t < 2; ++t) { float v[16];
#pragma unroll
            for (int e4 = 0; e4 < 4; ++e4)
#pragma unroll
                for (int c = 0; c < 4; ++c) v[e4 * 4 + c] = t ? a1[e4][c] : a0[e4][c];
#pragma unroll
            for (int s = 0; s < 4; ++s) { const int m = 1 << s, half = 8 >> s; const bool up = (ln & m) != 0;
#pragma unroll
                for (int i = 0; i < half; ++i) { const float send = up ? v[i] : v[i + half], keep = up ? v[i + half] : v[i]; v[i] = keep + __shfl_xor(send, m); } }
            float r2 = v[0]; r2 += __shfl_xor(r2, 16); r2 += __shfl_xor(r2, 32); lg[t] = r2; }
        const int ee = ((ln & 1) << 3) | ((ln & 2) << 1) | ((ln & 4) >> 1) | ((ln & 8) >> 3);
        float mx0 = lg[0], mx1 = lg[1];
#pragma unroll
        for (int m = 1; m < 16; m <<= 1) { mx0 = fmaxf(mx0, __shfl_xor(mx0, m)); mx1 = fmaxf(mx1, __shfl_xor(mx1, m)); }
        const float ex0 = expf(lg[0] - mx0), ex1 = expf(lg[1] - mx1); float z0 = ex0, z1 = ex1;
#pragma unroll
        for (int m = 1; m < 16; m <<= 1) { z0 += __shfl_xor(z0, m); z1 += __shfl_xor(z1, m); }
        const int bb = (int)(t0 / SEQ), ss = (int)(t0 % SEQ);
        if (ln < 16) { AFF[((size_t)bb * NE + ee) * SEQ + ss] = ex0 / z0; AFF[((size_t)bb * NE + ee) * SEQ + ss + 1] = ex1 / z1; }
    }
    __syncthreads();
}

__device__ __forceinline__ void topk_unit(Frame& F, int unit) {
    const float* AFF = (const float*)(F.ws + WS_AFF) + (size_t)unit * SEQ;
    int* IDX = (int*)(F.ws + WS_IDX) + (size_t)unit * CAP; float* GATE = (float*)(F.ws + WS_GATE) + (size_t)unit * CAP; int* INV = (int*)(F.ws + WS_INV);
    const int b = unit >> 4, e = unit & 15, tid = F.tid, lane = F.lane;
    int* TOK = (int*)(F.ws + WS_TOK) + e * 2048 + b * 512;
    LAS unsigned* hist = (LAS unsigned*)F.lds;
    LAS unsigned* misc = hist + 256;
    unsigned v[8];
    { const v4u a = *(const v4u*)(AFF + tid * 8), c = *(const v4u*)(AFF + tid * 8 + 4); v[0] = a.x; v[1] = a.y; v[2] = a.z; v[3] = a.w; v[4] = c.x; v[5] = c.y; v[6] = c.z; v[7] = c.w; }
    unsigned prefix = 0u, need = CAP;
#pragma unroll 1
    for (int pass = 0; pass < 4; ++pass) {
        const int shift = 24 - 8 * pass;
        __syncthreads();
        if (tid < 256) hist[tid] = 0u;
        __syncthreads();
#pragma unroll
        for (int k = 0; k < 8; ++k) { const bool match = (pass == 0) || ((v[k] >> (shift + 8)) == prefix); if (match) (void)__hip_atomic_fetch_add(&hist[(v[k] >> shift) & 255u], 1u, __ATOMIC_RELAXED, __HIP_MEMORY_SCOPE_WORKGROUP); }
        __syncthreads();
        if (F.wave == 0) {
            const unsigned c0 = hist[4 * lane], c1 = hist[4 * lane + 1], c2 = hist[4 * lane + 2], c3 = hist[4 * lane + 3];
            unsigned suf = c0 + c1 + c2 + c3;
#pragma unroll
            for (int o = 1; o < 64; o <<= 1) { const unsigned t = __shfl_down(suf, o); if (lane + o < 64) suf += t; }
            const unsigned long long mask = __ballot(suf >= need);
            const int L = 63 - __builtin_clzll(mask);
            if (lane == L) { unsigned run = suf - (c0 + c1 + c2 + c3); unsigned dig, nd;
                if (run + c3 >= need) { dig = 3; nd = need - run; } else { run += c3;
                if (run + c2 >= need) { dig = 2; nd = need - run; } else { run += c2;
                if (run + c1 >= need) { dig = 1; nd = need - run; } else { run += c1; dig = 0; nd = need - run; } } }
                misc[0] = 4u * (unsigned)lane + dig; misc[1] = nd; }
        }
        __syncthreads();
        prefix = (prefix << 8) | misc[0]; need = misc[1];
    }
    const unsigned T = prefix;
    unsigned neq = 0u;
#pragma unroll
    for (int k = 0; k < 8; ++k) neq += (v[k] == T) ? 1u : 0u;
    unsigned inc = neq;
#pragma unroll
    for (int o = 1; o < 64; o <<= 1) { const unsigned t = __shfl_up(inc, o); if (lane >= o) inc += t; }
    __syncthreads();
    if (lane == 63) misc[16 + F.wave] = inc;
    __syncthreads();
    unsigned woff = 0u;
#pragma unroll
    for (int w = 0; w < NWAVES; ++w) woff += (w < F.wave) ? misc[16 + w] : 0u;
    unsigned eqrank = woff + inc - neq;
    unsigned sel = 0u; unsigned selm = 0u;
#pragma unroll
    for (int k = 0; k < 8; ++k) { bool s = v[k] > T; if (v[k] == T) { s = eqrank < need; ++eqrank; } if (s) { selm |= 1u << k; ++sel; } }
    unsigned inc2 = sel;
#pragma unroll
    for (int o = 1; o < 64; o <<= 1) { const unsigned t = __shfl_up(inc2, o); if (lane >= o) inc2 += t; }
    if (lane == 63) misc[32 + F.wave] = inc2;
    __syncthreads();
    unsigned woff2 = 0u;
#pragma unroll
    for (int w = 0; w < NWAVES; ++w) woff2 += (w < F.wave) ? misc[32 + w] : 0u;
    unsigned slot = woff2 + inc2 - sel;
#pragma unroll
    for (int k = 0; k < 8; ++k) { const int s = tid * 8 + k; int sl = -1;
        if (selm & (1u << k)) { sl = (int)slot; ++slot; IDX[sl] = s; TOK[sl] = b * SEQ + s; GATE[sl] = __builtin_bit_cast(float, v[k]); }
        INV[((size_t)b * SEQ + s) * NE + e] = sl; }
}

__device__ __forceinline__ void gather_phase(Frame& F) {
    const unsigned char* H = F.ws + WS_H; unsigned char* XS = F.ws + WS_XS; const int* IDX = (const int*)(F.ws + WS_IDX);
    for (int row = F.vcu * NWAVES + F.wave; row < MS; row += F.G * NWAVES) {
        const int e = row >> 11, b = (row >> 9) & 3, c = row & 511; const int s = IDX[(b * NE + e) * CAP + c];
        const GAS v4u* src = (const GAS v4u*)(H + ((size_t)b * SEQ + s) * D) + F.lane; GAS v4u* dst = (GAS v4u*)(XS + (size_t)row * D) + F.lane;
        const v4u t0 = src[0], t1 = src[64];
        dst[0] = t0; dst[64] = t1;
    }
}
template <bool FINAL>
__device__ __forceinline__ void combine_phase(Frame& F, const bf16* Xin, bf16* Xout, const float* gain) {
    const unsigned char* YS = F.ws + WS_YS; const int* INV = (const int*)(F.ws + WS_INV); const float* GATE = (const float*)(F.ws + WS_GATE);
    const int lane = F.lane;
    const int tstep = F.G * NWAVES; int t = F.vcu * NWAVES + F.wave;
    typedef float f2 __attribute__((ext_vector_type(2)));
#define CB_FIRST(inv_, tok_, W0, W1, G0, G1) do { const unsigned m_ = (unsigned)(__ballot((inv_) >= 0) & 0xffffull); \
        if (m_) { const int b_ = (tok_) / SEQ; const int e0_ = __builtin_ctz(m_); const unsigned mr_ = m_ & (m_ - 1u); const bool two_ = mr_ != 0u; const int e1_ = two_ ? __builtin_ctz(mr_) : e0_; \
            const int s0_ = __builtin_amdgcn_readlane((inv_), e0_), s1_ = __builtin_amdgcn_readlane((inv_), e1_); \
            G0 = GATE[(b_ * NE + e0_) * CAP + s0_] * (1.f / YSC); G1 = two_ ? GATE[(b_ * NE + e1_) * CAP + s1_] * (1.f / YSC) : 0.f; \
            const size_t r0_ = (size_t)e0_ * 2048 + b_ * 512 + s0_, r1_ = (size_t)e1_ * 2048 + b_ * 512 + s1_; \
            _Pragma("unroll") for (int j = 0; j < 8; ++j) { W0[j] = *((const GAS unsigned*)(YS + r0_ * D) + lane + 64 * j); W1[j] = *((const GAS unsigned*)(YS + r1_ * D) + lane + 64 * j); } } } while (0)
#define CB_ACC(W0, W1, G0, G1) do { _Pragma("unroll") for (int j = 0; j < 8; ++j) { \
            const f2 a0 = __builtin_amdgcn_cvt_pk_f32_fp8((int)W0[j], false), a1 = __builtin_amdgcn_cvt_pk_f32_fp8((int)W0[j], true), b0 = __builtin_amdgcn_cvt_pk_f32_fp8((int)W1[j], false), b1 = __builtin_amdgcn_cvt_pk_f32_fp8((int)W1[j], true); \
            v[j].x += G0 * a0.x + G1 * b0.x; v[j].y += G0 * a0.y + G1 * b0.y; v[j].z += G0 * a1.x + G1 * b1.x; v[j].w += G0 * a1.y + G1 * b1.y; } } while (0)
    f32x4 v[8]; int myinv = -1, inv1 = -1; unsigned pw0[8], pw1[8]; float pg0 = 0.f, pg1 = 0.f;
    f32x4 gn[8];
    if (FINAL) {
#pragma unroll
        for (int j = 0; j < 8; ++j) gn[j] = *((const GAS f32x4*)gain + lane + 64 * j);
    }
    if (t < M) {
        const int tn = (t + tstep < M) ? t + tstep : t;
#pragma unroll
        for (int j = 0; j < 8; ++j) { const v2u x = *((const GAS v2u*)(Xin + (size_t)t * D) + lane + 64 * j); v[j] = (f32x4){bflo(x.x), bfhi(x.x), bflo(x.y), bfhi(x.y)}; }
        myinv = INV[(size_t)t * NE + (lane & 15)]; inv1 = INV[(size_t)tn * NE + (lane & 15)];
        CB_FIRST(myinv, t, pw0, pw1, pg0, pg1);
    }
    for (; t < M; t += tstep) {
        const int b = t / SEQ; const int tn = (t + tstep < M) ? t + tstep : t, tn2 = (tn + tstep < M) ? tn + tstep : tn;
        v2u vnp[8];
#pragma unroll
        for (int j = 0; j < 8; ++j) vnp[j] = *((const GAS v2u*)(Xin + (size_t)tn * D) + lane + 64 * j);
        const int inv2 = INV[(size_t)tn2 * NE + (lane & 15)];
        unsigned w0n[8], w1n[8]; float g0n = 0.f, g1n = 0.f;
        CB_FIRST(inv1, tn, w0n, w1n, g0n, g1n);
        unsigned m = (unsigned)(__ballot(myinv >= 0) & 0xffffull);
        if (m) { CB_ACC(pw0, pw1, pg0, pg1); m &= m - 1u; m &= m - 1u; }
        while (m) {
            const int e0 = __builtin_ctz(m); m &= m - 1u; const bool two = m != 0u; const int e1 = two ? __builtin_ctz(m) : e0; m &= m - 1u;
            const int s0 = __builtin_amdgcn_readlane(myinv, e0), s1 = __builtin_amdgcn_readlane(myinv, e1);
            const float g0 = GATE[(b * NE + e0) * CAP + s0] * (1.f / YSC), g1 = two ? GATE[(b * NE + e1) * CAP + s1] * (1.f / YSC) : 0.f;
            const size_t r0 = (size_t)e0 * 2048 + b * 512 + s0, r1 = (size_t)e1 * 2048 + b * 512 + s1;
            unsigned w0[8], w1[8];
#pragma unroll
            for (int j = 0; j < 8; ++j) { w0[j] = *((const GAS unsigned*)(YS + r0 * D) + lane + 64 * j); w1[j] = *((const GAS unsigned*)(YS + r1 * D) + lane + 64 * j); }
            CB_ACC(w0, w1, g0, g1);
        }
        float s = 0.f;
#pragma unroll
        for (int j = 0; j < 8; ++j) { if (!FINAL) { v2u w; w.x = pkbf(v[j].x, v[j].y); w.y = pkbf(v[j].z, v[j].w); *((GAS v2u*)(Xout + (size_t)t * D) + lane + 64 * j) = w; } s += (v[j].x * v[j].x + v[j].y * v[j].y) + (v[j].z * v[j].z + v[j].w * v[j].w); }
        const float rstd = 1.0f / sqrtf(wave_sum(s) * (1.f / D) + EPS);
        if (FINAL) {
#pragma unroll
            for (int j = 0; j < 8; ++j) *((GAS f32x4*)(F.out + (size_t)t * D) + lane + 64 * j) = v[j] * rstd * gn[j];
        } else if (lane == 0) ((float*)(F.ws + WS_RSTD))[t] = rstd;
#pragma unroll
        for (int j = 0; j < 8; ++j) { v[j] = (f32x4){bflo(vnp[j].x), bfhi(vnp[j].x), bflo(vnp[j].y), bfhi(vnp[j].y)}; pw0[j] = w0n[j]; pw1[j] = w1n[j]; }
        myinv = inv1; inv1 = inv2; pg0 = g0n; pg1 = g1n;
    }
#undef CB_FIRST
#undef CB_ACC
}

constexpr int SG_VT = 0, SG_MX = 128 * AT_P, SG_MP = 132;
static_assert(SG_MX + 128 * SG_MP * 4 <= SCR_BYTES, "sgu scratch");
__device__ __forceinline__ void sgu_phase(Frame& F) {
    const bf16* Z = (const bf16*)(F.ws + WS_Z); bf16* G2 = (bf16*)(F.ws + WS_G2); const float* STAT = (const float*)(F.ws + WS_STATP);   const bf16* SG = (const bf16*)(F.ws + WS_SGU);
    int hd = F.vcu & 15; const int nunits = (M / 128) * 16;
    const int lane = F.lane, r = lane & 31, h = lane >> 5;
    LAS unsigned char* lds = F.lds; LAS float* MX = (LAS float*)(lds + SG_MX);
    const int rt = F.wave >> 1, dt0 = (F.wave & 1) * 2;
    bf16x8 af[8]; float sb[16];
#define SG_CONSTS() do { _Pragma("unroll") for (int ks = 0; ks < 8; ++ks) af[ks] = *(const bf16x8*)(SG + ((size_t)hd * 128 + 32 * rt + r) * 128 + 16 * ks + 8 * h); \
        _Pragma("unroll") for (int i = 0; i < 16; ++i) sb[i] = F.in[I_SGUB][hd * 128 + 32 * rt + crow(i, h)]; } while (0)
    SG_CONSTS();
    v4u uuN[4], vvN[4]; float2 stN[8];
    int unit = F.vcu;
    if (unit < nunits) { const size_t t0 = (size_t)(unit >> 4) * 128;
#pragma unroll
        for (int i = 0; i < 4; ++i) { const int c = F.tid + NT * i; uuN[i] = *(const v4u*)(Z + (t0 + (c >> 4)) * ZW + hd * 128 + (c & 15) * 8);
            vvN[i] = *(const v4u*)(Z + (t0 + (c & 127)) * ZW + GW + hd * 128 + (c >> 7) * 8); }
#pragma unroll
        for (int q = 0; q < 8; ++q) stN[q] = *(const float2*)(STAT + ((size_t)q * M + t0 + (F.tid & 127)) * 2); }
    for (; unit < nunits; unit += F.G) {
        const size_t t0 = (size_t)(unit >> 4) * 128;
        if ((unit & 15) != hd) { hd = unit & 15; SG_CONSTS(); }
        v4u uu[4];
#pragma unroll
        for (int i = 0; i < 4; ++i) uu[i] = uuN[i];
        __syncthreads();
        float sum1 = 0.f, sum2 = 0.f;
#pragma unroll
        for (int q = 0; q < 8; ++q) { sum1 += stN[q].x; sum2 += stN[q].y; }
        const float mu = sum1 * (1.f / GW); const float var = fmaxf(sum2 * (1.f / GW) - mu * mu, 0.f); const float rstd = 1.0f / sqrtf(var + EPS);
#pragma unroll
        for (int i = 0; i < 4; ++i) { const int c = F.tid + NT * i, row = c & 127, ch = c >> 7;
            const v4u vv = vvN[i];
            const f32x4 g0 = *(const f32x4*)(F.in[I_LNG] + hd * 128 + ch * 8), g1 = *(const f32x4*)(F.in[I_LNG] + hd * 128 + ch * 8 + 4);
            const f32x4 b0 = *(const f32x4*)(F.in[I_LNB] + hd * 128 + ch * 8), b1 = *(const f32x4*)(F.in[I_LNB] + hd * 128 + ch * 8 + 4);
            LAS bf16* vt = (LAS bf16*)(lds + SG_VT + (ch * 8) * AT_P + row * 2);
            vt[0 * (AT_P / 2)] = f2bf1((bflo(vv.x) - mu) * rstd * g0.x + b0.x); vt[1 * (AT_P / 2)] = f2bf1((bfhi(vv.x) - mu) * rstd * g0.y + b0.y);
            vt[2 * (AT_P / 2)] = f2bf1((bflo(vv.y) - mu) * rstd * g0.z + b0.z); vt[3 * (AT_P / 2)] = f2bf1((bfhi(vv.y) - mu) * rstd * g0.w + b0.w);
            vt[4 * (AT_P / 2)] = f2bf1((bflo(vv.z) - mu) * rstd * g1.x + b1.x); vt[5 * (AT_P / 2)] = f2bf1((bfhi(vv.z) - mu) * rstd * g1.y + b1.y);
            vt[6 * (AT_P / 2)] = f2bf1((bflo(vv.w) - mu) * rstd * g1.z + b1.z); vt[7 * (AT_P / 2)] = f2bf1((bfhi(vv.w) - mu) * rstd * g1.w + b1.w); }
        if (unit + F.G < nunits) { const size_t t1 = (size_t)((unit + F.G) >> 4) * 128; const int h1 = (unit + F.G) & 15;
#pragma unroll
            for (int i = 0; i < 4; ++i) { const int c = F.tid + NT * i; uuN[i] = *(const v4u*)(Z + (t1 + (c >> 4)) * ZW + h1 * 128 + (c & 15) * 8);
                vvN[i] = *(const v4u*)(Z + (t1 + (c & 127)) * ZW + GW + h1 * 128 + (c >> 7) * 8); }
#pragma unroll
            for (int q = 0; q < 8; ++q) stN[q] = *(const float2*)(STAT + ((size_t)q * M + t1 + (F.tid & 127)) * 2); }
        __syncthreads();
        f32x16 acc[2];
#pragma unroll
        for (int q = 0; q < 2; ++q)
#pragma unroll
            for (int i = 0; i < 16; ++i) acc[q][i] = 0.f;
#pragma unroll
        for (int ks = 0; ks < 8; ++ks) {
#pragma unroll
            for (int q = 0; q < 2; ++q) { const bf16x8 bv = *(const LAS bf16x8*)(lds + SG_VT + (32 * (dt0 + q) + r) * AT_P + (16 * ks + 8 * h) * 2); acc[q] = MFMA32(af[ks], bv, acc[q]); } }
#pragma unroll
        for (int q = 0; q < 2; ++q)
#pragma unroll
            for (int i = 0; i < 16; ++i) { const int t = 32 * rt + crow(i, h); MX[t * SG_MP + 32 * (dt0 + q) + r] = acc[q][i] + sb[i]; }
        __syncthreads();
#pragma unroll
        for (int i = 0; i < 4; ++i) { const int c = F.tid + NT * i, row = c >> 4, ch = c & 15;
            const f32x4 m0 = *(const LAS f32x4*)(MX + row * SG_MP + ch * 8), m1 = *(const LAS f32x4*)(MX + row * SG_MP + ch * 8 + 4);
            v4u o; o.x = pkbf(bflo(uu[i].x) * m0.x, bfhi(uu[i].x) * m0.y); o.y = pkbf(bflo(uu[i].y) * m0.z, bfhi(uu[i].y) * m0.w);
            o.z = pkbf(bflo(uu[i].z) * m1.x, bfhi(uu[i].z) * m1.y); o.w = pkbf(bflo(uu[i].w) * m1.z, bfhi(uu[i].w) * m1.w);
            *(GAS v4u*)(G2 + (t0 + row) * GW + hd * 128 + ch * 8) = o; }
    }
#undef SG_CONSTS
}

constexpr int N_PHASES = 21;
struct Args { const float* in[28]; float* out; unsigned char* ws; int ph_lo, ph_hi; };
static_assert(sizeof(Args) == 28 * 8 + 8 + 8 + 8, "Args has no padding");

__global__ void __launch_bounds__(NT, 2) enc_fwd(Args args) {
    extern __shared__ __attribute__((aligned(16))) unsigned char lds[];
    Frame F;
    F.lds = (LAS unsigned char*)lds;
    F.MISC = (volatile LAS unsigned*)(F.lds + MISC_OFF);
    F.tid = threadIdx.x; F.lane = F.tid & 63; F.wave = __builtin_amdgcn_readfirstlane(F.tid >> 6);
    F.G = gridDim.x; { const int bx = blockIdx.x; F.vcu = (F.G % 8 == 0) ? (bx % 8) * (F.G / 8) + bx / 8 : bx; }
    F.ws = args.ws; F.ctl = (gu32*)(args.ws + WS_CTL); F.out = args.out;
#pragma unroll
    for (int i = 0; i < 28; ++i) F.in[i] = args.in[i];
    for (int u = F.tid; u < (LDS_BYTES - LDSCTL_OFF) / 4; u += NT) ((LAS unsigned*)(F.lds + LDSCTL_OFF))[u] = 0u;
    __syncthreads();
    const int lo = args.ph_lo, hi = args.ph_hi;
    const bool multi = (hi - lo) > 1;
    XcdBarrier bar; bar.bar = (unsigned*)(F.ctl + CW_BAR); bar.x = 0; bar.st = nullptr;
    if (multi) bar = xcd_barrier_post((unsigned*)(F.ctl + CW_BAR), F.MISC + 8);
#ifdef ONLY_PHASE
#define IN(k) ((k) == ONLY_PHASE && lo <= (k) && (k) < hi)
#else
#define IN(k) (lo <= (k) && (k) < hi)
#endif
#ifndef PROBE_DUP_MASK
#define PROBE_DUP_MASK 0u
#endif
#define PH(k) for (int _r = 0; _r < (((PROBE_DUP_MASK >> (k)) & 1u) ? 2 : 1); ++_r) if (IN(k))
#define STOP_THR(nunits, gw) ((unsigned)(((nunits) % (gw)) ? ((gw) - (nunits) % (gw) + 1) : 1))
#ifdef PROBE_DBLBAR
#define SEAM(k) do { if (IN((k) + 1)) { xcd_barrier(bar); xcd_barrier(bar); } } while (0)
#else
#define SEAM(k) do { if (IN((k) + 1)) xcd_barrier(bar); } while (0)
#endif
    LAS unsigned char* ring = F.lds;
    bf16* const H = (bf16*)(F.ws + WS_H); bf16* const DL = (bf16*)(F.ws + WS_XA);     bf16* const XB = (bf16*)(F.ws + WS_XB);
    unsigned char* const HID = F.ws + WS_HID; unsigned char* const YS = F.ws + WS_YS;

    PH(0) { p0_prologue(F);
#if defined(PROBE_P0)
        __syncthreads(); p0_prologue(F);
#endif
        SEAM(0); }
    PH(1) {
        const int NC1 = (F.G >= 64) ? ((F.G * 5 / 32) & ~7) : 0, GW1 = F.G - NC1;
        if ((int)blockIdx.x >= GW1) conv_bg(F, 0, F.ctl + CW_DONE1, STOP_THR((M / 256) * (EIN / 256), GW1));
        else {
        pg8::Gemm g{(const bf16*)(F.ws + WS_X16), (const bf16*)(F.ws + WS_WIN0), M, EIN, D}; pg8::StaticOrder S; S.init(M, EIN, GW1, (int)blockIdx.x);
        pg8::EpiStoreRS E{(bf16*)(F.ws + WS_PROJ), EIN, EIN / 256, (const float*)(F.ws + WS_RSTD0)};
        pg8::gemm_phase<pg8::EpiStoreRS, pg8::StaticOrder, true, true>(ring, g, S, E);
        __syncthreads(); if (F.tid == 0) (void)__hip_atomic_fetch_add(F.ctl + CW_DONE1, 1u, RLX_AGENT);
        conv_bg(F, 0, F.ctl + CW_DONE1, STOP_THR((M / 256) * (EIN / 256), GW1));
        }
        SEAM(1);
    }
    PH(2) {
        for (int u = F.vcu; u < BATCH * 32 * 2 * 2; u += F.G) attn_unit(F, u);
        __syncthreads();
        ssm_pass1(F);
#if defined(PROBE_SSM1)
        __syncthreads(); ssm_pass1(F);
#endif
#if defined(PROBE_ATTN)
        __syncthreads(); for (int u = blockIdx.x; u < BATCH * 32 * 2 * 2; u += F.G) attn_unit(F, u);
#endif
        SEAM(2);
    }
    PH(3) { ssm_pass2(F);
#if defined(PROBE_P3)
        __syncthreads(); ssm_pass2(F);
#endif
        SEAM(3); }
    PH(4) {
        pg8::Gemm g{(const bf16*)(F.ws + WS_G), (const bf16*)(F.ws + WS_GLU), M, SW, SW}; pg8::StaticOrder S; S.init(M, SW, F.G, (int)blockIdx.x);
        pg8::EpiGlu E{(const bf16*)(F.ws + WS_G), SW, (bf16*)(F.ws + WS_CAT), D, AW, F.in[I_GLUB]};
        pg8::gemm_phase<pg8::EpiGlu, pg8::StaticOrder, true, true>(ring, g, S, E);
#if defined(PROBE_G4)
        pg8::gemm_phase<pg8::EpiGlu, pg8::StaticOrder, true, true>(ring, g, S, E);
#endif
        SEAM(4);
    }
    PH(5) {
        pg8::Gemm g{(const bf16*)(F.ws + WS_CAT), (const bf16*)(F.ws + WS_WOUT0), M, D, D}; pg8::StaticOrder S; S.init(M, D, F.G, (int)blockIdx.x);
        pg8::EpiStoreRes E{DL, D, D / 256, (const bf16*)(F.ws + WS_X16)};
        pg8::gemm_phase<pg8::EpiStoreRes, pg8::StaticOrder, true, true>(ring, g, S, E);
        SEAM(5);
    }
    PH(6) { router_phase(F, DL, F.in[I_FFNN], F.in[I_ROUTER]);
        SEAM(6); }
    PH(7) { for (int u = blockIdx.x; u < BATCH * NE; u += F.G) topk_unit(F, u);
        __syncthreads(); conv_bg(F, 0, nullptr, 0u);
#if defined(PROBE_P7)
        __syncthreads(); for (int u = blockIdx.x; u < BATCH * NE; u += F.G) topk_unit(F, u);
#endif
        if (IN(9)) xcd_barrier(bar); }
    #ifndef NCONV_NUM
#define NCONV_NUM 3
#endif
    const int NCONV = (F.G >= 64) ? ((F.G * NCONV_NUM / 16) & ~7) : 0, GWG = F.G - NCONV; const bool is_conv = (int)blockIdx.x >= GWG;
    PH(9) {
        if (is_conv) conv_bg(F, 1, F.ctl + CW_DONE9, STOP_THR((MS / 256) * (2 * FF / 256), GWG));
        else {
        pg8::Gemm g{(const bf16*)(F.ws + WS_H), (const bf16*)(F.ws + WS_W13), MS, 2 * FF, D / 2, (const int*)(F.ws + WS_TOK)}; pg8::GroupedOrder S; S.init(MS, 2 * FF, GWG, (int)blockIdx.x); S.npg = 2 * FF / 256;
        pg8::EpiSwiglu8 E{HID, FF, 2 * FF / 256, 1.f / (HSC * WSC), HIDSC, 0};
        pg8::gemm_phase<pg8::EpiSwiglu8, pg8::GroupedOrder, true, true, true, true>(ring, g, S, E);
        __syncthreads(); if (F.tid == 0) (void)__hip_atomic_fetch_add(F.ctl + CW_DONE9, 1u, RLX_AGENT);
        conv_bg(F, 1, F.ctl + CW_DONE9, STOP_THR((MS / 256) * (2 * FF / 256), GWG));
        }
        SEAM(9);
    }
    PH(10) {
        if (!is_conv) {
        pg8::Gemm g{(const bf16*)HID, (const bf16*)(F.ws + WS_W2), MS, D, FF / 2}; pg8::GroupedOrder S; S.init(MS, D, GWG, (int)blockIdx.x); S.npg = D / 256;
        pg8::EpiStore8 E{YS, D, D / 256, YSC / (HIDSC * WSC)};
        pg8::gemm_phase<pg8::EpiStore8, pg8::GroupedOrder, true, true, true>(ring, g, S, E);
        __syncthreads();
        }
        conv_bg(F, 1, nullptr, 0u);
        SEAM(10);
    }
    PH(11) { combine_phase<false>(F, DL, XB, F.in[I_MIXN] + D);
        SEAM(11); }
    PH(12) {
        pg8::Gemm g{XB, (const bf16*)(F.ws + WS_WIN1), M, ZW, D}; pg8::StaticOrder S; S.init(M, ZW, F.G, (int)blockIdx.x);
        pg8::EpiGelu E{(bf16*)(F.ws + WS_Z), ZW, (float*)(F.ws + WS_STATP), GW / 256, (const float*)(F.ws + WS_RSTD), (LAS float*)(F.lds + 131072 + 1024), M};
        pg8::gemm_phase<pg8::EpiGelu, pg8::StaticOrder, true, true>(ring, g, S, E);
#if defined(PROBE_G12)
        { pg8::EpiGelu E2{(bf16*)(F.ws + WS_Z), ZW, (float*)(F.ws + WS_XS), GW / 256, (const float*)(F.ws + WS_RSTD), (LAS float*)(F.lds + 131072 + 1024), M}; pg8::gemm_phase<pg8::EpiGelu, pg8::StaticOrder, true, true>(ring, g, S, E2); }
#endif
        SEAM(12);
    }
    PH(13) { sgu_phase(F); SEAM(13); }
    PH(14) {
        pg8::Gemm g{(const bf16*)(F.ws + WS_G2), (const bf16*)(F.ws + WS_WOUT1), M, D, GW}; pg8::StaticOrder S; S.init(M, D, F.G, (int)blockIdx.x);
        pg8::EpiStoreRes E{DL, D, D / 256, XB};
        pg8::gemm_phase<pg8::EpiStoreRes, pg8::StaticOrder, true, true>(ring, g, S, E);
        SEAM(14);
    }
    PH(15) { router_phase(F, DL, F.in[I_FFNN] + D, F.in[I_ROUTER] + D * NE); SEAM(15); }
    PH(16) { for (int u = blockIdx.x; u < BATCH * NE; u += F.G) topk_unit(F, u); if (IN(18)) xcd_barrier(bar); }
    PH(18) {
        pg8::Gemm g{(const bf16*)(F.ws + WS_H), (const bf16*)(F.ws + WS_W13) + (size_t)NE * 2 * FF * D / 2, MS, 2 * FF, D / 2, (const int*)(F.ws + WS_TOK)}; pg8::GroupedOrder S; S.init(MS, 2 * FF, F.G, (int)blockIdx.x); S.npg = 2 * FF / 256;
        pg8::EpiSwiglu8 E{HID, FF, 2 * FF / 256, 1.f / (HSC * WSC), HIDSC, 0};
        pg8::gemm_phase<pg8::EpiSwiglu8, pg8::GroupedOrder, true, true, true, true>(ring, g, S, E);
#if defined(PROBE_G18H)
        { pg8::EpiSwiglu8 E2{HID, FF, 2 * FF / 256, 1.f / (HSC * WSC), HIDSC, F.G + 12089}; pg8::gemm_phase<pg8::EpiSwiglu8, pg8::GroupedOrder, true, true, true, true>(ring, g, S, E2); }
#endif
#if defined(PROBE_G18L)
        { pg8::EpiSwiglu8 E2{(unsigned char*)(F.ws + WS_XS), FF, 2 * FF / 256, 1.f / (HSC * WSC), HIDSC, F.G + 12090}; pg8::gemm_phase<pg8::EpiSwiglu8, pg8::GroupedOrder, true, true, true, true>(ring, g, S, E2); }
#endif
#if defined(PROBE_G18)
        pg8::gemm_phase<pg8::EpiSwiglu8, pg8::GroupedOrder, true, true, true, true>(ring, g, S, E);
#endif
        SEAM(18);
    }
    PH(19) {
        pg8::Gemm g{(const bf16*)HID, (const bf16*)(F.ws + WS_W2) + (size_t)NE * FF * D / 2, MS, D, FF / 2}; pg8::GroupedOrder S; S.init(MS, D, F.G, (int)blockIdx.x); S.npg = D / 256;
        pg8::EpiStore8 E{YS, D, D / 256, YSC / (HIDSC * WSC)};
        pg8::gemm_phase<pg8::EpiStore8, pg8::GroupedOrder, true, true, true>(ring, g, S, E);
        SEAM(19);
    }
    PH(20) { combine_phase<true>(F, DL, nullptr, F.in[I_FINN]); }
#undef IN
#undef SEAM
}

extern "C" void kernel_launch(void* const* d_in, const int* in_sizes, int n_in, void* d_out, int out_size, void* d_ws, size_t ws_size, hipStream_t stream) {
    static int grid = 0;
    if (grid == 0) {
        if (n_in != 28 || in_sizes[0] != M * D || out_size != M * D || ws_size < WS_END) { fprintf(stderr, "kernel_launch: shape/workspace mismatch (n_in %d, in0 %d, out %d, ws %zu, need %zu)\n", n_in, n_in > 0 ? in_sizes[0] : -1, out_size, ws_size, (size_t)WS_END); grid = -1; return; }
        int dev = 0, cus = 0, per_cu = 0;
        if (hipGetDevice(&dev) != hipSuccess || hipDeviceGetAttribute(&cus, hipDeviceAttributeMultiprocessorCount, dev) != hipSuccess) { grid = -1; return; }
        if (hipFuncSetAttribute((const void*)enc_fwd, hipFuncAttributeMaxDynamicSharedMemorySize, LDS_BYTES) != hipSuccess) { fprintf(stderr, "kernel_launch: hipFuncSetAttribute failed\n"); grid = -1; return; }
        if (hipOccupancyMaxActiveBlocksPerMultiprocessor(&per_cu, (const void*)enc_fwd, NT, LDS_BYTES) != hipSuccess || per_cu < 1) fprintf(stderr, "kernel_launch: occupancy query reports %d\n", per_cu);
        (void)hipGetLastError();
        grid = cus;
    }
    if (grid < 0) return;
    (void)hipMemsetAsync((char*)d_ws + WS_CTL, 0, CTL_ZERO_BYTES, stream);
    Args a{};
    for (int i = 0; i < 28; ++i) a.in[i] = (const float*)d_in[i];
    a.out = (float*)d_out; a.ws = (unsigned char*)d_ws;
#if MK_N_LAUNCHES == 1
    a.ph_lo = 0; a.ph_hi = N_PHASES;
    hipLaunchKernelGGL(enc_fwd, dim3(grid), dim3(NT), LDS_BYTES, stream, a);
#else
    for (int p = 0; p < N_PHASES; ++p) { a.ph_lo = p; a.ph_hi = p + 1; hipLaunchKernelGGL(enc_fwd, dim3(grid), dim3(NT), LDS_BYTES, stream, a); }
#endif
}
```

```cpp
#include <hip/hip_runtime.h>
#include <cstdio>
#include <cstdint>
namespace pg8 {
#define PG8_LAS __attribute__((address_space(3)))
typedef unsigned short bf16_t;
typedef short bf16x8 __attribute__((ext_vector_type(8)));
typedef float f32x4 __attribute__((ext_vector_type(4)));
typedef unsigned u32x4 __attribute__((ext_vector_type(4)));
constexpr int BM = 256, BK = 64, HALF = 128, HTB = HALF * BK * 2  , STAGE_BYTES = 8 * HTB, NXCD = 8, WGM = 8;

__host__ __device__ __forceinline__ int lds_byte(int r, int c) { const int st = (r >> 4) * 2 + (c >> 5), rr = r & 15, cc = c & 31, ob = rr * 64 + cc * 2; return st * 1024 + (ob ^ (((ob >> 9) & 1) << 5)); }
__host__ __device__ __forceinline__ void stage_rc(int b, int& R, int& C) { const int st = b / 1024, sb = b % 1024, swz = sb ^ (((sb >> 9) & 1) << 5); R = (st >> 1) * 16 + swz / 64; C = (st & 1) * 32 + (swz % 64) / 2; }
__host__ __device__ __forceinline__ int perm32(int rho) { const int n = rho >> 4, i = rho & 15; return 8 * (i >> 2) + 4 * n + (i & 3); }

struct Unit { int pm, pn; };
struct Gemm { const bf16_t* A; const bf16_t* Bt; int M, N, K; const int* rowtok; };

struct StaticOrder {
    int nM, nN, nwg, G, c;
    __host__ __device__ void init(int M, int N, int G_, int c_) { nM = M / BM; nN = N / BM; nwg = nM * nN; G = G_; c = c_; }
    __host__ __device__ bool next(int i, Unit& u) const {
        const long L = (long)i * G + c; if (L >= nwg) return false;
        int wgid = (int)L; { const int q = nwg / NXCD, r = nwg % NXCD, xcd = wgid % NXCD, off = wgid / NXCD; wgid = (xcd < r ? xcd * (q + 1) : r * (q + 1) + (xcd - r) * q) + off; }
        const int nig = WGM * nN, gid = wgid / nig, fm = gid * WGM, gsz = (nM - fm) < WGM ? (nM - fm) : WGM;
        u.pm = fm + ((wgid % nig) % gsz); u.pn = (wgid % nig) / gsz; return true;
    }
    __device__ __forceinline__ void a_ready(const Unit&) const {}
    __device__ __forceinline__ void done(const Unit&) const {}
};
__device__ __forceinline__ unsigned cvt_pk_bf16(float lo, float hi) { unsigned r; asm volatile("v_cvt_pk_bf16_f32 %0, %1, %2" : "=v"(r) : "v"(lo), "v"(hi)); return r; }
struct GroupedOrder : StaticOrder {
    int npg;
    __device__ __forceinline__ bool next(int i, Unit& u) const { if (!StaticOrder::next(i, u)) return false; u.pn += (u.pm >> 3) * npg; return true; }
};
typedef unsigned u32x2 __attribute__((ext_vector_type(2)));
typedef int i32x4_t __attribute__((ext_vector_type(4)));
typedef int i32x8_t __attribute__((ext_vector_type(8)));
__device__ __forceinline__ i32x8_t cat8(bf16x8 a, bf16x8 b) { return __builtin_shufflevector(__builtin_bit_cast(i32x4_t, a), __builtin_bit_cast(i32x4_t, b), 0, 1, 2, 3, 4, 5, 6, 7); }
typedef __bf16 bf16x2_t __attribute__((ext_vector_type(2)));
typedef float f32x2_t __attribute__((ext_vector_type(2)));
__device__ __forceinline__ unsigned pkbf(float a, float b) { f32x2_t v = {a, b}; bf16x2_t r = __builtin_convertvector(v, bf16x2_t); return __builtin_bit_cast(unsigned, r); }
__device__ __forceinline__ float clamp8(float x) { return fminf(fmaxf(x, -448.f), 448.f); }
__device__ __forceinline__ unsigned pk4_fp8(float a, float b, float c, float d) {
    unsigned w = (unsigned)__builtin_amdgcn_cvt_pk_fp8_f32(clamp8(a), clamp8(b), 0, false); return (unsigned)__builtin_amdgcn_cvt_pk_fp8_f32(clamp8(c), clamp8(d), (int)w, true); }
__device__ __forceinline__ float bflo(unsigned w) { return __builtin_bit_cast(float, w << 16); }
__device__ __forceinline__ float bfhi(unsigned w) { return __builtin_bit_cast(float, w & 0xffff0000u); }
__device__ __forceinline__ float sigmoidf_(float v) { return __builtin_amdgcn_rcpf(1.f + __expf(-v)); }
__device__ __forceinline__ float gelu_tanh(float x) { const float u = x * (1.5957691216f + 0.0713548163f * x * x); return x * sigmoidf_(u); }
typedef float f2v __attribute__((ext_vector_type(2)));
__device__ __forceinline__ f2v gelu_tanh2(f2v x) {
    const f2v x2 = x * x, u = x * (x2 * (-0.1029432397f) + (-2.3022082480f));
    f2v e; e.x = __builtin_amdgcn_exp2f(u.x); e.y = __builtin_amdgcn_exp2f(u.y);
    const f2v d = e + 1.0f; f2v r; r.x = __builtin_amdgcn_rcpf(d.x); r.y = __builtin_amdgcn_rcpf(d.y);
    return x * r;
}
__device__ __forceinline__ f2v swiglu2(f2v a, f2v b, float c1, float c2) {
    const f2v t = a * c1; f2v e; e.x = __builtin_amdgcn_exp2f(t.x); e.y = __builtin_amdgcn_exp2f(t.y);
    const f2v d = e + 1.0f; f2v r; r.x = __builtin_amdgcn_rcpf(d.x); r.y = __builtin_amdgcn_rcpf(d.y);
    return (a * b) * (r * c2);
}

struct EpiStore {
    static constexpr bool PERM = true, AFTER_DRAIN = false;
    bf16_t* O; int ldc; int npn; float osc;
    __device__ __forceinline__ void operator()(const f32x4 (&acc)[2][2][4][2], const Unit& u, int wr, int wc, int fr, int fq) const {
        const int row0 = u.pm * BM + wr * 64 + fr, col0 = (u.pn % npn) * BM + wc * 32 + 8 * fq;
#pragma unroll
        for (int ai = 0; ai < 2; ++ai)
#pragma unroll
            for (int m = 0; m < 4; ++m) { bf16_t* rowp = O + (size_t)(row0 + ai * HALF + m * 16) * ldc + col0;
#pragma unroll
                for (int bj = 0; bj < 2; ++bj) { const f32x4 v0 = acc[ai][bj][m][0] * osc, v1 = acc[ai][bj][m][1] * osc;
                    u32x4 w; w.x = pkbf(v0[0], v0[1]); w.y = pkbf(v0[2], v0[3]); w.z = pkbf(v1[0], v1[1]); w.w = pkbf(v1[2], v1[3]);
                    *(u32x4*)(rowp + bj * HALF) = w; } }
    }
};
struct EpiStoreRes {
    static constexpr bool PERM = true, AFTER_DRAIN = false;
    bf16_t* O; int ldc; int npn; const bf16_t* R;
    __device__ __forceinline__ void operator()(const f32x4 (&acc)[2][2][4][2], const Unit& u, int wr, int wc, int fr, int fq) const {
        const int row0 = u.pm * BM + wr * 64 + fr, col0 = (u.pn % npn) * BM + wc * 32 + 8 * fq;
        u32x4 res[2][4][2];
#pragma unroll
        for (int ai = 0; ai < 2; ++ai)
#pragma unroll
            for (int m = 0; m < 4; ++m)
#pragma unroll
                for (int bj = 0; bj < 2; ++bj) res[ai][m][bj] = *(const u32x4*)(R + (size_t)(row0 + ai * HALF + m * 16) * ldc + col0 + bj * HALF);
#pragma unroll
        for (int ai = 0; ai < 2; ++ai)
#pragma unroll
            for (int m = 0; m < 4; ++m) { bf16_t* rowp = O + (size_t)(row0 + ai * HALF + m * 16) * ldc + col0;
#pragma unroll
                for (int bj = 0; bj < 2; ++bj) { const f32x4 v0 = acc[ai][bj][m][0], v1 = acc[ai][bj][m][1]; const u32x4 r = res[ai][m][bj];
                    u32x4 w; w.x = pkbf(v0[0] + bflo(r.x), v0[1] + bfhi(r.x)); w.y = pkbf(v0[2] + bflo(r.y), v0[3] + bfhi(r.y)); w.z = pkbf(v1[0] + bflo(r.z), v1[1] + bfhi(r.z)); w.w = pkbf(v1[2] + bflo(r.w), v1[3] + bfhi(r.w));
                    *(u32x4*)(rowp + bj * HALF) = w; } }
    }
};
struct EpiStoreRS {
    static constexpr bool PERM = true, AFTER_DRAIN = false;
    bf16_t* O; int ldc; int npn; const float* rs;
    __device__ __forceinline__ void operator()(const f32x4 (&acc)[2][2][4][2], const Unit& u, int wr, int wc, int fr, int fq) const {
        const int row0 = u.pm * BM + wr * 64 + fr, col0 = (u.pn % npn) * BM + wc * 32 + 8 * fq;
        float rsall[2][4];
#pragma unroll
        for (int ai = 0; ai < 2; ++ai)
#pragma unroll
            for (int m = 0; m < 4; ++m) rsall[ai][m] = rs[row0 + ai * HALF + m * 16];
#pragma unroll
        for (int ai = 0; ai < 2; ++ai)
#pragma unroll
            for (int m = 0; m < 4; ++m) { const int row = row0 + ai * HALF + m * 16; bf16_t* rowp = O + (size_t)row * ldc + col0; const float osc = rsall[ai][m];
#pragma unroll
                for (int bj = 0; bj < 2; ++bj) { const f32x4 v0 = acc[ai][bj][m][0] * osc, v1 = acc[ai][bj][m][1] * osc;
                    u32x4 w; w.x = pkbf(v0[0], v0[1]); w.y = pkbf(v0[2], v0[3]); w.z = pkbf(v1[0], v1[1]); w.w = pkbf(v1[2], v1[3]);
                    *(u32x4*)(rowp + bj * HALF) = w; } }
    }
};
struct EpiStore8 {
    static constexpr bool PERM = true, AFTER_DRAIN = false;
    unsigned char* O; int ldc; int npn; float osc;
    __device__ __forceinline__ void operator()(const f32x4 (&acc)[2][2][4][2], const Unit& u, int wr, int wc, int fr, int fq) const {
        const int row0 = u.pm * BM + wr * 64 + fr, col0 = (u.pn % npn) * BM + wc * 32 + 8 * fq;
#pragma unroll
        for (int ai = 0; ai < 2; ++ai)
#pragma unroll
            for (int m = 0; m < 4; ++m) { unsigned char* rowp = O + (size_t)(row0 + ai * HALF + m * 16) * ldc + col0;
#pragma unroll
                for (int bj = 0; bj < 2; ++bj) { const f32x4 v0 = acc[ai][bj][m][0] * osc, v1 = acc[ai][bj][m][1] * osc;
                    u32x2 w; w.x = pk4_fp8(v0[0], v0[1], v0[2], v0[3]); w.y = pk4_fp8(v1[0], v1[1], v1[2], v1[3]);
                    *(u32x2*)(rowp + bj * HALF) = w; } }
    }
};
struct EpiGelu {
    static constexpr bool PERM = true, AFTER_DRAIN = false;
    bf16_t* O; int ldc; float* stat; int vtile0; const float* rs; PG8_LAS float* red; int nrows;
    __device__ __forceinline__ void operator()(const f32x4 (&acc)[2][2][4][2], const Unit& u, int wr, int wc, int fr, int fq) const {
        const int row0 = u.pm * BM + wr * 64 + fr, col0 = u.pn * BM + wc * 32 + 8 * fq;
        const bool isv = u.pn >= vtile0;
        float rsall[2][4];
#pragma unroll
        for (int ai = 0; ai < 2; ++ai)
#pragma unroll
            for (int m = 0; m < 4; ++m) rsall[ai][m] = rs[row0 + ai * HALF + m * 16];
#pragma unroll
        for (int ai = 0; ai < 2; ++ai)
#pragma unroll
            for (int m = 0; m < 4; ++m) { const int row = row0 + ai * HALF + m * 16; bf16_t* rowp = O + (size_t)row * ldc + col0; float s1 = 0.f, s2 = 0.f; const float rsc = rsall[ai][m];
                f2v s1v = (f2v){0.f, 0.f}, s2v = (f2v){0.f, 0.f};
#pragma unroll
                for (int bj = 0; bj < 2; ++bj) { const f32x4 v0 = acc[ai][bj][m][0] * rsc, v1 = acc[ai][bj][m][1] * rsc;
                    const f2v g0 = gelu_tanh2((f2v){v0[0], v0[1]}), g1 = gelu_tanh2((f2v){v0[2], v0[3]}), g2 = gelu_tanh2((f2v){v1[0], v1[1]}), g3 = gelu_tanh2((f2v){v1[2], v1[3]});
                    s1v += (g0 + g1) + (g2 + g3); s2v += g0 * g0; s2v += g1 * g1; s2v += g2 * g2; s2v += g3 * g3;
                    u32x4 w; w.x = pkbf(g0.x, g0.y); w.y = pkbf(g1.x, g1.y); w.z = pkbf(g2.x, g2.y); w.w = pkbf(g3.x, g3.y);
                    *(u32x4*)(rowp + bj * HALF) = w; }
                s1 = s1v.x + s1v.y; s2 = s2v.x + s2v.y;
                if (isv) { s1 += __shfl_xor(s1, 16); s1 += __shfl_xor(s1, 32); s2 += __shfl_xor(s2, 16); s2 += __shfl_xor(s2, 32);
                    if (fq == 0) { PG8_LAS float* rp = red + (((wr * 4 + wc) * 128 + ai * 64 + m * 16 + fr) << 1); rp[0] = s1; rp[1] = s2; } } }
        if (isv) {
            asm volatile("s_waitcnt lgkmcnt(0)" ::: "memory"); __builtin_amdgcn_s_barrier(); asm volatile("" ::: "memory");
            if (wc == 0) {
#pragma unroll
                for (int k = 0; k < 2; ++k) { const int rl = fq * 16 + fr + 64 * k; float t1 = 0.f, t2 = 0.f;
#pragma unroll
                    for (int w = 0; w < 4; ++w) { const PG8_LAS float* rp = red + (((wr * 4 + w) * 128 + rl) << 1); t1 += rp[0]; t2 += rp[1]; }
                    const int row = u.pm * BM + (rl >> 6) * HALF + wr * 64 + (rl & 63);
                    f2v o; o.x = t1; o.y = t2; *(f2v*)(stat + ((size_t)(u.pn - vtile0) * nrows + row) * 2) = o; } }
        }
    }
};
struct EpiGlu {
    static constexpr bool PERM = true, AFTER_DRAIN = false;
    const bf16_t* G; int ldg; bf16_t* O; int ldo; int ocol0; const float* bias;
    __device__ __forceinline__ void operator()(const f32x4 (&acc)[2][2][4][2], const Unit& u, int wr, int wc, int fr, int fq) const {
        const int row0 = u.pm * BM + wr * 64 + fr, col0 = u.pn * BM + wc * 32 + 8 * fq;
        f32x4 bv[2][2];
#pragma unroll
        for (int bj = 0; bj < 2; ++bj)
#pragma unroll
            for (int n = 0; n < 2; ++n) bv[bj][n] = *(const f32x4*)(bias + col0 + bj * HALF + 4 * n);
        u32x4 gall[2][4][2];
#pragma unroll
        for (int ai = 0; ai < 2; ++ai)
#pragma unroll
            for (int m = 0; m < 4; ++m)
#pragma unroll
                for (int bj = 0; bj < 2; ++bj) gall[ai][m][bj] = *(const u32x4*)(G + (size_t)(row0 + ai * HALF + m * 16) * ldg + col0 + bj * HALF);
#pragma unroll
        for (int ai = 0; ai < 2; ++ai)
#pragma unroll
            for (int m = 0; m < 4; ++m) { const int row = row0 + ai * HALF + m * 16;
#pragma unroll
                for (int bj = 0; bj < 2; ++bj) { const f32x4 v0 = acc[ai][bj][m][0] + bv[bj][0], v1 = acc[ai][bj][m][1] + bv[bj][1];
                    const u32x4 gw = gall[ai][m][bj];
                    u32x4 w;
                    w.x = pkbf(bflo(gw.x) * sigmoidf_(v0[0]), bfhi(gw.x) * sigmoidf_(v0[1]));
                    w.y = pkbf(bflo(gw.y) * sigmoidf_(v0[2]), bfhi(gw.y) * sigmoidf_(v0[3]));
                    w.z = pkbf(bflo(gw.z) * sigmoidf_(v1[0]), bfhi(gw.z) * sigmoidf_(v1[1]));
                    w.w = pkbf(bflo(gw.w) * sigmoidf_(v1[2]), bfhi(gw.w) * sigmoidf_(v1[3]));
                    *(u32x4*)(O + (size_t)row * ldo + ocol0 + col0 + bj * HALF) = w; } }
    }
};
struct EpiSwiglu8 {
    static constexpr bool PERM = true, AFTER_DRAIN = false;
    unsigned char* O; int ldc; int npn; float osc, hsc; int guard;
    __device__ __forceinline__ void operator()(const f32x4 (&acc)[2][2][4][2], const Unit& u, int wr, int wc, int fr, int fq) const {
        const int row0 = (guard == 12346 ? (int)blockIdx.x : u.pm) * BM + wr * 64 + fr, col0 = (guard == 12346 ? 0 : (u.pn % npn)) * HALF + wc * 32 + 8 * fq;
#pragma unroll
        for (int ai = 0; ai < 2; ++ai)
#pragma unroll
            for (int m = 0; m < 4; ++m) { const f32x4 a0 = acc[ai][0][m][0], a1 = acc[ai][0][m][1], b0 = acc[ai][1][m][0], b1 = acc[ai][1][m][1];
                const float c1 = osc * (-1.4426950408889634f), c2 = osc * osc * hsc;
                const f2v h0 = swiglu2((f2v){a0[0], a0[1]}, (f2v){b0[0], b0[1]}, c1, c2), h1 = swiglu2((f2v){a0[2], a0[3]}, (f2v){b0[2], b0[3]}, c1, c2);
                const f2v h2 = swiglu2((f2v){a1[0], a1[1]}, (f2v){b1[0], b1[1]}, c1, c2), h3 = swiglu2((f2v){a1[2], a1[3]}, (f2v){b1[2], b1[3]}, c1, c2);
                u32x2 w; w.x = pk4_fp8(h0.x, h0.y, h1.x, h1.y); w.y = pk4_fp8(h2.x, h2.y, h3.x, h3.y);
                if (guard != 12345 || wr == 1) *(u32x2*)(O + (size_t)(row0 + ai * HALF + m * 16) * ldc + col0) = w; }
    }
};
struct EpiRes {
    static constexpr bool PERM = false, AFTER_DRAIN = false;
    const float* base; float* out; int ldc;
    __device__ __forceinline__ void operator()(const f32x4 (&acc)[2][2][4][2], const Unit& u, int wr, int wc, int fr, int fq) const {
        const int row0 = u.pm * BM + wr * 64 + fr, col0 = u.pn * BM + wc * 32 + 4 * fq;
#pragma unroll
        for (int ai = 0; ai < 2; ++ai)
#pragma unroll
            for (int m = 0; m < 4; ++m) { const size_t off = (size_t)(row0 + ai * HALF + m * 16) * ldc + col0;
#pragma unroll
                for (int bj = 0; bj < 2; ++bj)
#pragma unroll
                    for (int n = 0; n < 2; ++n) { const f32x4 bs = *(const f32x4*)(base + off + bj * HALF + n * 16); *(f32x4*)(out + off + bj * HALF + n * 16) = bs + acc[ai][bj][m][n]; } }
    }
};
template <class Epi, class Sched, bool ALIGN_EPI = false, bool SP2 = false, bool F8 = false, bool GATHER = false>
__device__ __forceinline__ void gemm_phase(PG8_LAS unsigned char* lds, const Gemm g, const Sched& S, const Epi& E) {
    int tid_ = threadIdx.x; asm volatile("" : "+v"(tid_));
    const int tid = tid_, wid = __builtin_amdgcn_readfirstlane(tid >> 6), lane = tid & 63, wr = wid >> 2, wc = wid & 3, fr = lane & 15, fq = lane >> 4;
    const int K = g.K, nt = K / BK;
    unsigned voffA[2], voffB[2];
#pragma unroll
    for (int i = 0; i < 2; ++i) { int R, C; stage_rc(tid * 16 + i * 8192, R, C); const int Rb = Epi::PERM ? ((R & ~31) + perm32(R & 31)) : R;
        voffA[i] = (unsigned)(R * K + C) * 2u; voffB[i] = (unsigned)(Rb * K + C) * 2u; }
    PG8_LAS int* rowtab = (PG8_LAS int*)(lds + STAGE_BYTES);
    unsigned vAc[2][2] = {{0u, 0u}, {0u, 0u}};
#define PG8_ROWDMA(pm_) do { if (wid < 4) __builtin_amdgcn_global_load_lds((const unsigned*)(g.rowtok + (pm_) * BM + wid * 64 + lane), (PG8_LAS unsigned*)(rowtab + wid * 64), 4, 0, 0); } while (0)
#define PG8_ROWREAD(dst) do { int tt_ = tid; asm volatile("" : "+v"(tt_));   \
        _Pragma("unroll") for (int i_ = 0; i_ < 2; ++i_) { int R_, C_; stage_rc(tt_ * 16 + i_ * 8192, R_, C_); \
            _Pragma("unroll") for (int h_ = 0; h_ < 2; ++h_) dst[h_][i_] = (unsigned)rowtab[h_ * HALF + R_] * (unsigned)(K * 2) + (unsigned)C_ * 2u; } } while (0)
#define PG8_STAGE_A(bufoff, gbase, half, usenext) do { if constexpr (GATHER) { PG8_STAGE(bufoff, gbase, vAc[half]); } \
        else { PG8_STAGE(bufoff, (gbase) + ((half) ? hstep : (size_t)0), voffA); } } while (0)
    const size_t kstep = (size_t)(BK * 2);
    const size_t hstep = (size_t)HALF * K * 2;
    const size_t tstep = 2 * hstep;
    const unsigned ldsw = (unsigned)wid * 1024u;
    const int aoff = lds_byte(wr * 64 + fr, fq * 8), boff = lds_byte(wc * 32 + fr, fq * 8);
#define PG8_SA(b, h) (((b) * 2 + (h)) * HTB)
#define PG8_SB(b, h) ((4 + (b) * 2 + (h)) * HTB)
#define PG8_STAGE(bufoff, gbase, voff) do { _Pragma("unroll") for (int _i = 0; _i < 2; ++_i) \
        __builtin_amdgcn_global_load_lds((const unsigned*)((const char*)(gbase) + (voff)[_i]), (PG8_LAS unsigned*)(lds + (bufoff) + ldsw + _i * 8192), 16, 0, 0); } while (0)
#define PG8_LDA(dst, b, h) do { _Pragma("unroll") for (int m = 0; m < 4; ++m) _Pragma("unroll") for (int k = 0; k < 2; ++k) dst[m][k] = *(const PG8_LAS bf16x8*)(lds + PG8_SA(b, h) + aoff + m * 2048 + k * 1024); } while (0)
#define PG8_LDB(dst, b, h) do { _Pragma("unroll") for (int n = 0; n < 2; ++n) _Pragma("unroll") for (int k = 0; k < 2; ++k) dst[n][k] = *(const PG8_LAS bf16x8*)(lds + PG8_SB(b, h) + boff + n * 2048 + k * 1024); } while (0)
#define PG8_MMA(ai, bj, At, Bt) do { __builtin_amdgcn_s_setprio(1); \
        if constexpr (F8) { _Pragma("unroll") for (int m = 0; m < 4; ++m) _Pragma("unroll") for (int n = 0; n < 2; ++n) \
            asm volatile("v_mfma_scale_f32_16x16x128_f8f6f4 %0, %1, %2, %0, %3, %3 op_sel_hi:[0,0,0]" : "+v"(acc[ai][bj][m][n]) : "v"(cat8(Bt[n][0], Bt[n][1])), "v"(cat8(At[m][0], At[m][1])), "v"(0x7f7f7f7f)); } \
        else { _Pragma("unroll") for (int m = 0; m < 4; ++m) _Pragma("unroll") for (int n = 0; n < 2; ++n) _Pragma("unroll") for (int k = 0; k < 2; ++k) \
            acc[ai][bj][m][n] = __builtin_amdgcn_mfma_f32_16x16x32_bf16(Bt[n][k], At[m][k], acc[ai][bj][m][n], 0, 0, 0); } \
        __builtin_amdgcn_s_setprio(0); } while (0)
#define PG8_WAIT_V(n) asm volatile("s_waitcnt vmcnt(" #n ")" ::: "memory")
#define PG8_WAIT_L(n) asm volatile("s_waitcnt lgkmcnt(" #n ")" ::: "memory")
#define PG8_BAR __builtin_amdgcn_s_barrier()
#define PG8_SCHED __builtin_amdgcn_sched_barrier(0)
#define PG8_ACCFENCE(NOPS) do { if constexpr (F8) { _Pragma("unroll") for (int a_ = 0; a_ < 2; ++a_) _Pragma("unroll") for (int b_ = 0; b_ < 2; ++b_) \
        asm volatile(NOPS : "+v"(acc[a_][b_][0][0]), "+v"(acc[a_][b_][0][1]), "+v"(acc[a_][b_][1][0]), "+v"(acc[a_][b_][1][1]), "+v"(acc[a_][b_][2][0]), "+v"(acc[a_][b_][2][1]), "+v"(acc[a_][b_][3][0]), "+v"(acc[a_][b_][3][1])); } } while (0)
    Unit cur, nxt; int ui = 0;
    if (!S.next(0, cur)) return;
    f32x4 acc[2][2][4][2];
#pragma unroll
    for (int a = 0; a < 2; ++a)
#pragma unroll
        for (int b = 0; b < 2; ++b)
#pragma unroll
            for (int m = 0; m < 4; ++m)
#pragma unroll
                for (int n = 0; n < 2; ++n) acc[a][b][m][n] = (f32x4){0.f, 0.f, 0.f, 0.f};
    PG8_ACCFENCE("s_nop 1");
    bf16x8 At[4][2], B0[2][2], B1[2][2];
    const char* cA = GATHER ? (const char*)g.A : (const char*)g.A + (size_t)cur.pm * tstep; const char* cB = (const char*)g.Bt + (size_t)cur.pn * tstep;
    S.a_ready(cur);
    if constexpr (GATHER) { PG8_ROWDMA(cur.pm); PG8_WAIT_V(0); PG8_BAR; PG8_ROWREAD(vAc); PG8_WAIT_L(0); PG8_BAR; }
    if constexpr (SP2) {
        PG8_STAGE(PG8_SB(0, 0), cB, voffB); PG8_STAGE(PG8_SB(0, 1), cB + hstep, voffB); PG8_STAGE_A(PG8_SA(0, 0), cA, 0, false); PG8_STAGE_A(PG8_SA(0, 1), cA, 1, false);
        if (wr == 1) PG8_BAR;
        PG8_WAIT_V(2); PG8_BAR;
        PG8_STAGE(PG8_SB(1, 0), cB + kstep, voffB); PG8_STAGE_A(PG8_SA(1, 0), cA + kstep, 0, false); PG8_STAGE(PG8_SB(1, 1), cB + hstep + kstep, voffB);
        PG8_WAIT_V(6); PG8_BAR;
    } else {
        PG8_STAGE(PG8_SB(0, 0), cB, voffB); PG8_STAGE(PG8_SA(0, 0), cA, voffA); PG8_STAGE(PG8_SB(0, 1), cB + hstep, voffB); PG8_STAGE(PG8_SA(0, 1), cA + hstep, voffA);
        if (wr == 1) PG8_BAR;
        PG8_WAIT_V(4); PG8_BAR;
        PG8_STAGE(PG8_SB(1, 0), cB + kstep, voffB); PG8_STAGE(PG8_SA(1, 0), cA + kstep, voffA); PG8_STAGE(PG8_SB(1, 1), cB + hstep + kstep, voffB);
        PG8_WAIT_V(6); PG8_BAR;
    }
    for (;;) {
        const bool has_next = S.next(ui + 1, nxt);
        const char* nA = (has_next && !GATHER) ? (const char*)g.A + (size_t)nxt.pm * tstep : cA;
        if constexpr (GATHER) { if (has_next) PG8_ROWDMA(nxt.pm); } const char* nB = has_next ? (const char*)g.Bt + (size_t)nxt.pn * tstep : cB;
        for (int t = 0; t < nt; t += 2) {
            const bool last = (t == nt - 2);
            const char* a1 = cA + (size_t)(t + 1) * kstep;
            const char* a2 = last ? nA : cA + (size_t)(t + 2) * kstep; const char* b2 = last ? nB : cB + (size_t)(t + 2) * kstep;
            const char* a3 = a2 + kstep; const char* b3 = b2 + kstep;
            if (last && has_next) S.a_ready(nxt);

            if constexpr (SP2) {
            PG8_LDB(B0, 0, 0); PG8_LDB(B1, 0, 1); PG8_SCHED; PG8_LDA(At, 0, 0); PG8_STAGE_A(PG8_SA(1, 1), a1, 1, false);
            if constexpr (GATHER) { if (last && has_next) PG8_ROWREAD(vAc); }
            PG8_WAIT_V(8); PG8_WAIT_L(0); PG8_BAR; PG8_MMA(0, 0, At, B0); PG8_MMA(0, 1, At, B1); PG8_BAR; PG8_SCHED;
            PG8_LDA(At, 0, 1); PG8_STAGE(PG8_SB(0, 0), b2, voffB); PG8_STAGE(PG8_SB(0, 1), b2 + hstep, voffB); PG8_STAGE_A(PG8_SA(0, 0), a2, 0, last);
            PG8_WAIT_V(8); PG8_WAIT_L(0); PG8_BAR; PG8_MMA(1, 0, At, B0); PG8_MMA(1, 1, At, B1); PG8_BAR; PG8_SCHED;
            PG8_LDB(B0, 1, 0); PG8_LDB(B1, 1, 1); PG8_SCHED; PG8_LDA(At, 1, 0); PG8_STAGE_A(PG8_SA(0, 1), a2, 1, last);
            PG8_WAIT_V(8); PG8_WAIT_L(0); PG8_BAR; PG8_MMA(0, 0, At, B0); PG8_MMA(0, 1, At, B1); PG8_BAR; PG8_SCHED;
            PG8_LDA(At, 1, 1); PG8_STAGE(PG8_SB(1, 0), b3, voffB); PG8_STAGE(PG8_SB(1, 1), b3 + hstep, voffB); PG8_STAGE_A(PG8_SA(1, 0), a3, 0, last);
            PG8_WAIT_V(8); PG8_WAIT_L(0); PG8_BAR; PG8_MMA(1, 0, At, B0); PG8_MMA(1, 1, At, B1); PG8_BAR; PG8_SCHED;
            } else {
            PG8_LDB(B0, 0, 0); PG8_SCHED; PG8_LDA(At, 0, 0); PG8_STAGE(PG8_SA(1, 1), a1 + hstep, voffA);
            PG8_WAIT_L(8); PG8_BAR; PG8_WAIT_L(0); PG8_MMA(0, 0, At, B0); PG8_BAR; PG8_SCHED;
            PG8_LDB(B1, 0, 1); PG8_STAGE(PG8_SB(0, 0), b2, voffB);
            PG8_BAR; PG8_WAIT_L(0); PG8_MMA(0, 1, At, B1); PG8_BAR;
            PG8_LDA(At, 0, 1); PG8_STAGE(PG8_SA(0, 0), a2, voffA);
            PG8_BAR; PG8_WAIT_L(0); PG8_MMA(1, 0, At, B0); PG8_BAR; PG8_SCHED;
            PG8_STAGE(PG8_SB(0, 1), b2 + hstep, voffB);
            PG8_WAIT_V(6); PG8_BAR; PG8_MMA(1, 1, At, B1); PG8_BAR;
            PG8_LDB(B0, 1, 0); PG8_SCHED; PG8_LDA(At, 1, 0); PG8_STAGE(PG8_SA(0, 1), a2 + hstep, voffA);
            PG8_WAIT_L(8); PG8_BAR; PG8_WAIT_L(0); PG8_MMA(0, 0, At, B0); PG8_BAR; PG8_SCHED;
            PG8_LDB(B1, 1, 1); PG8_STAGE(PG8_SB(1, 0), b3, voffB);
            PG8_BAR; PG8_WAIT_L(0); PG8_MMA(0, 1, At, B1); PG8_BAR;
            PG8_LDA(At, 1, 1); PG8_STAGE(PG8_SA(1, 0), a3, voffA);
            PG8_BAR; PG8_WAIT_L(0); PG8_MMA(1, 0, At, B0); PG8_BAR; PG8_SCHED;
            PG8_STAGE(PG8_SB(1, 1), b3 + hstep, voffB);
            PG8_WAIT_V(6); PG8_BAR; PG8_MMA(1, 1, At, B1); PG8_BAR;
            }
        }
        PG8_ACCFENCE("s_nop 15\n\ts_nop 7");
        if constexpr (ALIGN_EPI) { if (wr == 0) PG8_BAR; }
        if constexpr (!Epi::AFTER_DRAIN) { E(acc, cur, wr, wc, fr, fq); S.done(cur); }
        if (!has_next) break;
#pragma unroll
        for (int a = 0; a < 2; ++a)
#pragma unroll
            for (int b = 0; b < 2; ++b)
#pragma unroll
                for (int m = 0; m < 4; ++m)
#pragma unroll
                    for (int n = 0; n < 2; ++n) acc[a][b][m][n] = (f32x4){0.f, 0.f, 0.f, 0.f};
        PG8_ACCFENCE("s_nop 1");
        cur = nxt; cA = nA; cB = nB; ++ui;
        if constexpr (ALIGN_EPI) { if (wr == 1) PG8_BAR; }
    }
    PG8_WAIT_V(0);
    if constexpr (!ALIGN_EPI) { if (wr == 0) PG8_BAR; }
    PG8_BAR;
    if constexpr (Epi::AFTER_DRAIN) { E.fused(acc, cur, wr, wc, fr, fq, lds, wid, lane); S.done(cur); }
#undef PG8_SA
#undef PG8_SB
#undef PG8_STAGE
#undef PG8_LDA
#undef PG8_LDB
#undef PG8_MMA
#undef PG8_WAIT_V
#undef PG8_WAIT_L
#undef PG8_BAR
#undef PG8_SCHED
#undef PG8_ROWDMA
#undef PG8_ROWREAD
#undef PG8_STAGE_A
#undef PG8_ACCFENCE
}
}

constexpr int NWAVES = 8, NT = NWAVES * 64;
#ifndef MK_N_LAUNCHES
#define MK_N_LAUNCHES 1
#endif
constexpr int BATCH = 4, SEQ = 4096, D = 2048, M = BATCH * SEQ;
constexpr int AW = 1024, KVW = 256, SW = 1024, EIN = 2560;
constexpr int QOFF = 0, KOFF = 1024, VOFF = 1280, UOFF = 1536;
constexpr int NE = 16, CAP = 512, FF = 2048, MS = NE * BATCH * CAP;
constexpr int GW = 2048, ZW = 4096;
constexpr float EPS = 1e-6f;

constexpr size_t MiB = 1u << 20, KiB = 1u << 10;
constexpr size_t WS_CTL = 0, CTL_ZERO_BYTES = 1 * MiB;
constexpr int CW_TMO = 0, CW_CODE = 1, CW_BAR = 4096;
constexpr size_t WS_STAT = 256 * KiB;
constexpr size_t WS_LUT = 1 * MiB;
constexpr size_t WS_LAM = WS_LUT + 16 * KiB;
constexpr size_t WS_LAM512 = WS_LAM + 64 * KiB;
constexpr size_t WS_BB = WS_LAM512 + 64 * KiB;
constexpr size_t WS_CM = WS_BB + 512 * KiB;
constexpr size_t WS_SGU = WS_CM + 512 * KiB;
constexpr size_t WS_E = 4 * MiB;
constexpr size_t WS_AFF = 6 * MiB;
constexpr size_t WS_IDX = 7 * MiB;
constexpr size_t WS_GATE = WS_IDX + 128 * KiB;
constexpr size_t WS_TOK = WS_IDX + 256 * KiB;
constexpr size_t WS_INV = 8 * MiB;
constexpr size_t WS_STATP = 11 * MiB;
constexpr size_t WS_RSTD0 = 10 * MiB + 64 * KiB;
constexpr size_t WS_RSTD = 10 * MiB;
constexpr size_t WS_WIN0 = 16 * MiB, WS_GLU = 26 * MiB, WS_WOUT0 = 28 * MiB, WS_WIN1 = 36 * MiB, WS_WOUT1 = 52 * MiB;
constexpr size_t WS_W13 = 64 * MiB, WS_W2 = 576 * MiB;
constexpr float WSC = 256.f, HSC = 8.f, HIDSC = 8.f, YSC = 32.f;
constexpr size_t WS_H = 832 * MiB, WS_XA = 896 * MiB, WS_XB = 1024 * MiB;
constexpr size_t WS_X16 = WS_XB + 64 * MiB;
constexpr size_t WS_XS = 1152 * MiB, WS_HID = 1280 * MiB, WS_YS = 1408 * MiB;
constexpr size_t WS_PROJ = 1536 * MiB, WS_CAT = 1616 * MiB, WS_G = 1680 * MiB, WS_YF = 1712 * MiB;
constexpr size_t WS_Z = 1536 * MiB, WS_G2 = 1664 * MiB;
constexpr size_t WS_END = 1776 * MiB;

constexpr int SCR_BYTES = 143360;
constexpr int LDSCTL_OFF = SCR_BYTES, MISC_OFF = LDSCTL_OFF + 320;
constexpr int LDS_BYTES = 151552;
constexpr int EPI_STG_OFF = 131072 + 1024;
static_assert(EPI_STG_OFF + 2 * 32 * 136 <= SCR_BYTES, "epilogue staging");

#define GAS __attribute__((address_space(1)))
#define LAS __attribute__((address_space(3)))
typedef unsigned short bf16;
typedef unsigned v4u __attribute__((ext_vector_type(4)));
typedef unsigned v2u __attribute__((ext_vector_type(2)));
typedef float f32x4 __attribute__((ext_vector_type(4)));
typedef float f32x16 __attribute__((ext_vector_type(16)));
typedef short bf16x8 __attribute__((ext_vector_type(8)));
typedef short s16x4 __attribute__((ext_vector_type(4)));
typedef GAS unsigned gu32;
#define RLX_AGENT __ATOMIC_RELAXED, __HIP_MEMORY_SCOPE_AGENT
#define LDS_WAIT() asm volatile("s_waitcnt lgkmcnt(0)" ::: "memory")
#define VM_WAIT() asm volatile("s_waitcnt vmcnt(0)" ::: "memory")
using pg8::pkbf; using pg8::pk4_fp8; using pg8::bflo; using pg8::bfhi; using pg8::gelu_tanh;
__device__ __forceinline__ bf16 f2bf1(float f) { return (bf16)(pkbf(f, 0.f) & 0xffffu); }
__device__ __forceinline__ float bf2f(bf16 b) { return __builtin_bit_cast(float, ((unsigned)b) << 16); }
#define MFMA32(a, b, c) __builtin_amdgcn_mfma_f32_32x32x16_bf16((a), (b), (c), 0, 0, 0)
#define MFMA16(a, b, c) __builtin_amdgcn_mfma_f32_16x16x32_bf16((a), (b), (c), 0, 0, 0)
__device__ __forceinline__ int crow(int reg, int h) { return (reg & 3) + 8 * (reg >> 2) + 4 * h; }
__device__ __forceinline__ float wave_sum(float v) {
#pragma unroll
    for (int o = 1; o < 64; o <<= 1) v += __shfl_xor(v, o);
    return v;
}
#define XB_TMO      128
#define XB_XCNT(j)  (256  + 64 * (j))
#define XB_XSUB(j)  (1280 + 64 * (j))
#define XB_XGEN(j)  (2304 + 64 * (j))
#define XB_TOP      3328
#define XB_TOPGEN   3392
#define XCD_BAR_WORDS 3456
#define XB_SPIN_CAP (1u << 18)

__device__ __forceinline__ unsigned xb_ld(unsigned* p)              { return __hip_atomic_load(p, __ATOMIC_RELAXED, __HIP_MEMORY_SCOPE_AGENT); }
__device__ __forceinline__ unsigned xb_add(unsigned* p, unsigned v) { return __hip_atomic_fetch_add(p, v, __ATOMIC_RELAXED, __HIP_MEMORY_SCOPE_AGENT); }
__device__ __forceinline__ unsigned xb_xcc_id() { return (unsigned)__builtin_amdgcn_s_getreg((3 << 11) | 20) & 0xFu; }
#define XB_SPIN(cond, bar) do { unsigned _sp = 0; while (cond) { __builtin_amdgcn_s_sleep(1); \
    if ((++_sp & 255u) == 0u) { if (xb_ld(&(bar)[XB_TMO])) break; if (_sp > XB_SPIN_CAP) { atomicAdd(&(bar)[XB_TMO], 1u); break; } } } } while (0)

struct XcdBarrier {
    unsigned* bar; unsigned x;
    volatile LAS unsigned* st;
};

__device__ __forceinline__ XcdBarrier xcd_barrier_post(unsigned* bar, volatile LAS unsigned* st) {
    XcdBarrier b; b.bar = bar; b.x = xb_xcc_id(); b.st = st;
    if (threadIdx.x == 0) (void)xb_add(&bar[XB_XCNT(b.x)], 1u);
    return b;
}
__device__ __forceinline__ void xcd_barrier_complete(unsigned* bar, unsigned x, unsigned& nloc, unsigned& nx) {
    const unsigned G = gridDim.x * gridDim.y * gridDim.z;
    unsigned sum, cnt, mine, sp = 0u;
    for (;;) {
        sum = 0u; cnt = 0u; mine = 0u;
#pragma unroll
        for (unsigned j = 0; j < 16; ++j) { const unsigned c = xb_ld(&bar[XB_XCNT(j)]); sum += c; cnt += (c > 0u) ? 1u : 0u; mine = (j == x) ? c : mine; }
        if (sum == G) break;
        __builtin_amdgcn_s_sleep(1);
        if ((++sp & 255u) == 0u) { if (xb_ld(&bar[XB_TMO])) break; if (sp > XB_SPIN_CAP) { atomicAdd(&bar[XB_TMO], 1u); break; } }
    }
    nloc = mine > 0u ? mine : 1u; nx = cnt > 0u ? cnt : 1u;
}

__device__ __forceinline__ void xcd_barrier(const XcdBarrier& b) {
    asm volatile("s_waitcnt vmcnt(0)" ::: "memory");
    __syncthreads();
    if (threadIdx.x == 0) {
        unsigned* bar = b.bar;
        __builtin_amdgcn_s_waitcnt(0);
        unsigned nloc = b.st[0], nx = b.st[1];
        if (nloc == 0u) { xcd_barrier_complete(bar, b.x, nloc, nx); b.st[0] = nloc; b.st[1] = nx; }
        const unsigned old = xb_add(&bar[XB_XSUB(b.x)], 1u);
        const unsigned gen = old / nloc;
        if (old + 1u == (gen + 1u) * nloc) {
            __builtin_amdgcn_fence(__ATOMIC_RELEASE, "agent");
            asm volatile("s_waitcnt vmcnt(0)" ::: "memory");
            const unsigned og = xb_add(&bar[XB_TOP], 1u);
            const unsigned tg = og / nx;
            if (og + 1u == (tg + 1u) * nx) xb_add(&bar[XB_TOPGEN], 1u);
            else XB_SPIN(xb_ld(&bar[XB_TOPGEN]) == tg, bar);
            __builtin_amdgcn_fence(__ATOMIC_ACQUIRE, "agent");
            xb_add(&bar[XB_XGEN(b.x)], 1u);
            asm volatile("s_waitcnt vmcnt(0)" ::: "memory");
        } else {
            XB_SPIN(xb_ld(&bar[XB_XGEN(b.x)]) == gen, bar);
            __builtin_amdgcn_fence(__ATOMIC_ACQUIRE, "agent");
            asm volatile("s_waitcnt vmcnt(0)" ::: "memory");
        }
    }
    __syncthreads();
}

struct Frame {
    LAS unsigned char* lds;
    volatile LAS unsigned* MISC;
    gu32* ctl;
    unsigned char* ws;
    int tid, lane, wave, vcu, G;
    const float* in[28];
    float* out;
};
enum { I_X = 0, I_RELB, I_MIXN, I_FFNN, I_FINN, I_EWIN, I_SINK, I_ARE, I_AIM, I_LDT, I_BRE, I_BIM, I_CRE, I_CIM, I_SSMD, I_GLUW, I_GLUB, I_EWOUT,
       I_OWIN, I_LNG, I_LNB, I_SGUW, I_SGUB, I_OWOUT, I_ROUTER, I_W1, I_W3, I_W2 };

__device__ __forceinline__ void p0_transpose_item(const float* W, int K, int N, bf16* WT, int row_base, LAS float* scr, int k0, int n0, int lane, const float* kgain = nullptr) {
#pragma unroll 8
    for (int i = 0; i < 32; ++i) { const int kk = 2 * i + (lane >> 5); float w = W[(size_t)(k0 + kk) * N + n0 + (lane & 31)]; if (kgain) w *= kgain[k0 + kk]; scr[kk * 33 + (lane & 31)] = w; }
    LDS_WAIT(); asm volatile("" ::: "memory");
    const int c = lane & 7;
#pragma unroll
    for (int j = 0; j < 4; ++j) { const int n = (lane >> 3) + 8 * j; const LAS float* s = scr + (8 * c) * 33 + n;
        v4u o; o.x = pkbf(s[0 * 33], s[1 * 33]); o.y = pkbf(s[2 * 33], s[3 * 33]); o.z = pkbf(s[4 * 33], s[5 * 33]); o.w = pkbf(s[6 * 33], s[7 * 33]);
        *(GAS v4u*)(WT + (size_t)(row_base + n) * K + k0 + 8 * c) = o; }
    LDS_WAIT(); asm volatile("" ::: "memory");
}
__device__ __forceinline__ void p0_item8_load(const float* W, int N, int k0, int n0, int lane, f32x4 (&t)[16]) {
#pragma unroll
    for (int i = 0; i < 16; ++i) t[i] = *(const GAS f32x4*)(W + (size_t)(k0 + 8 * i + (lane >> 3)) * N + n0 + 4 * (lane & 7));
}
__device__ __forceinline__ unsigned bperm(unsigned hi, unsigned lo, unsigned sel) { return __builtin_amdgcn_perm(hi, lo, sel); }
__device__ __forceinline__ void p0_item8_finish(const f32x4 (&t)[16], int K, unsigned char* WT, int row_base, LAS float* scr, int k0, int lane, float sc) {
    LAS unsigned* tile = (LAS unsigned*)scr;
#pragma unroll
    for (int i = 0; i < 16; ++i) tile[(8 * i + (lane >> 3)) * 9 + (lane & 7)] = pk4_fp8(t[i].x * sc, t[i].y * sc, t[i].z * sc, t[i].w * sc);
    LDS_WAIT(); asm volatile("" ::: "memory");
    const int n4 = lane >> 3, kg = lane & 7;
    unsigned r[16];
#pragma unroll
    for (int j = 0; j < 16; ++j) r[j] = tile[(16 * kg + j) * 9 + n4];
    LDS_WAIT(); asm volatile("" ::: "memory");
    v4u o[4];
#pragma unroll
    for (int q = 0; q < 4; ++q) { const unsigned a = bperm(r[4 * q + 1], r[4 * q], 0x05010400u), b = bperm(r[4 * q + 1], r[4 * q], 0x07030602u), c = bperm(r[4 * q + 3], r[4 * q + 2], 0x05010400u), d = bperm(r[4 * q + 3], r[4 * q + 2], 0x07030602u);
        o[0][q] = bperm(c, a, 0x05040100u); o[1][q] = bperm(c, a, 0x07060302u); o[2][q] = bperm(d, b, 0x05040100u); o[3][q] = bperm(d, b, 0x07060302u); }
#pragma unroll
    for (int b = 0; b < 4; ++b) *(GAS v4u*)(WT + (size_t)(row_base + 4 * n4 + b) * K + k0 + 16 * kg) = o[b];
}
__device__ __forceinline__ int t5_bucket(int rel) {
    const int n = rel < 0 ? -rel : rel; int b;
    if (n < 8) b = n; else { b = 8 + (31 - __clz(n * n)) - 6; if (b > 15) b = 15; }
    return b + (rel > 0 ? 16 : 0);
}
__device__ __forceinline__ void sincos_d(double x, double& s, double& c) {
    const double q = __builtin_rint(x * 0.63661977236758134308);
    const double r = (x - q * 1.57079632673412561417) - q * 6.07710050650619224932e-11;
    const double r2 = r * r;
    const double sp = r * (1.0 + r2 * (-1.0 / 6 + r2 * (1.0 / 120 + r2 * (-1.0 / 5040 + r2 * (1.0 / 362880 + r2 * (-1.0 / 39916800 + r2 * (1.0 / 6227020800.0)))))));
    const double cp = 1.0 + r2 * (-0.5 + r2 * (1.0 / 24 + r2 * (-1.0 / 720 + r2 * (1.0 / 40320 + r2 * (-1.0 / 3628800 + r2 * (1.0 / 479001600.0 + r2 * (-1.0 / 87178291200.0)))))));
    const int qi = (int)((long long)q & 3);
    s = (qi == 0) ? sp : (qi == 1) ? cp : (qi == 2) ? -sp : -cp;
    c = (qi == 0) ? cp : (qi == 1) ? -sp : (qi == 2) ? -cp : sp;
}
constexpr int SS_C1_ = 12, SS_C2_ = 22;
constexpr int IPM = (D / 128) * (FF / 32);
constexpr int EXP_ITEMS = 3 * NE * IPM;
struct ExpItem { const float* W; unsigned char* WT; int row_base, k0, n0; };
__device__ __forceinline__ ExpItem expert_item_desc(Frame& F, int layer, int it) {
    const int which = it / (NE * IPM), r0 = it % (NE * IPM), mat = layer * NE + r0 / IPM, r = r0 % IPM, nb = FF / 32, k0 = 128 * (r / nb), n0 = 32 * (r % nb);
    const size_t moff = (size_t)mat * D * FF; ExpItem e; e.k0 = k0; e.n0 = n0;
    if (which == 0) { e.W = F.in[I_W1] + moff; e.WT = F.ws + WS_W13 + (size_t)mat * 2 * FF * D; e.row_base = (n0 >> 7) * 256 + (n0 & 127); }
    else if (which == 1) { e.W = F.in[I_W3] + moff; e.WT = F.ws + WS_W13 + (size_t)mat * 2 * FF * D; e.row_base = (n0 >> 7) * 256 + 128 + (n0 & 127); }
    else { e.W = F.in[I_W2] + moff; e.WT = F.ws + WS_W2 + (size_t)mat * FF * D; e.row_base = n0; }
    return e;
}
__device__ __forceinline__ void expert_items(Frame& F, LAS float* scr, int layer, int first, int step, int end) {
    for (int it = first; it < end; it += 2 * step) { f32x4 ta[16], tb[16]; const ExpItem ea = expert_item_desc(F, layer, it); const bool hb = it + step < end;
        const ExpItem eb = expert_item_desc(F, layer, hb ? it + step : it);
        p0_item8_load(ea.W, FF, ea.k0, ea.n0, F.lane, ta);
        if (hb) p0_item8_load(eb.W, FF, eb.k0, eb.n0, F.lane, tb);
        p0_item8_finish(ta, D, ea.WT, ea.row_base, scr, ea.k0, F.lane, WSC);
        if (hb) p0_item8_finish(tb, D, eb.WT, eb.row_base, scr, eb.k0, F.lane, WSC); }
}
constexpr int CW_Q = 2048, CW_DONE9 = 2112, CW_Q0 = 2176, CW_DONE1 = 2240, CW_DONE5 = 2304, CW_DONE10 = 2368, CW_DONE12 = 2432, QBATCH = 4;
__device__ __forceinline__ void conv_bg(Frame& F, int layer, gu32* stop, unsigned stopcount) {
    LAS float* scr = (LAS float*)(F.lds + F.wave * 17408);
    for (;;) {
        if (stop) { unsigned d = 0u; if (F.lane == 0) d = __hip_atomic_load(stop, RLX_AGENT); d = (unsigned)__builtin_amdgcn_readfirstlane((int)d); if (d >= stopcount) break; }
        unsigned it0 = 0u; if (F.lane == 0) it0 = __hip_atomic_fetch_add(F.ctl + (layer ? CW_Q : CW_Q0), (unsigned)QBATCH, RLX_AGENT); it0 = (unsigned)__builtin_amdgcn_readfirstlane((int)it0);
        if (layer == 0 && F.G * NWAVES == 2048) it0 += (unsigned)((SS_C1_ + SS_C2_) * 1024);
        if (it0 >= (unsigned)EXP_ITEMS) break;
        expert_items(F, scr, layer, (int)it0, 1, (int)it0 + QBATCH);
    }
}
__device__ __forceinline__ void p0_prologue(Frame& F) {
    LAS float* scr = (LAS float*)(F.lds + F.wave * 17408);
    const int gw = F.vcu * NWAVES + F.wave, NGW = F.G * NWAVES;
    bf16* WIN0 = (bf16*)(F.ws + WS_WIN0); bf16* GLU = (bf16*)(F.ws + WS_GLU); bf16* WOUT0 = (bf16*)(F.ws + WS_WOUT0); bf16* WIN1 = (bf16*)(F.ws + WS_WIN1); bf16* WOUT1 = (bf16*)(F.ws + WS_WOUT1);
    constexpr int I0 = (D / 64) * (EIN / 32), I1 = (SW / 64) * (SW / 32), I2 = (D / 64) * (D / 32), I3 = (D / 64) * (ZW / 32), I4 = I2;
    constexpr int NSM = I0 + I1 + I2 + I3 + I4;
    for (int it = gw; it < NSM; it += NGW) {
        int r = it;
        if (r < I0) { const int nb = EIN / 32; p0_transpose_item(F.in[I_EWIN], D, EIN, WIN0, 32 * (r % nb), scr, 64 * (r / nb), 32 * (r % nb), F.lane, F.in[I_MIXN]); continue; } r -= I0;
        if (r < I1) { const int nb = SW / 32; p0_transpose_item(F.in[I_GLUW], SW, SW, GLU, 32 * (r % nb), scr, 64 * (r / nb), 32 * (r % nb), F.lane); continue; } r -= I1;
        if (r < I2) { const int nb = D / 32; p0_transpose_item(F.in[I_EWOUT], D, D, WOUT0, 32 * (r % nb), scr, 64 * (r / nb), 32 * (r % nb), F.lane); continue; } r -= I2;
        if (r < I3) { const int nb = ZW / 32; p0_transpose_item(F.in[I_OWIN], D, ZW, WIN1, 32 * (r % nb), scr, 64 * (r / nb), 32 * (r % nb), F.lane, F.in[I_MIXN] + D); continue; } r -= I3;
        { const int nb = D / 32; p0_transpose_item(F.in[I_OWOUT], D, D, WOUT1, 32 * (r % nb), scr, 64 * (r / nb), 32 * (r % nb), F.lane); }
    }
    { bf16* SG = (bf16*)(F.ws + WS_SGU); const float* sw = F.in[I_SGUW];
      for (int i = (F.vcu * NT + F.tid) * 4; i < 16 * 128 * 128; i += F.G * NT * 4) { const f32x4 v = *(const f32x4*)(sw + i); v2u w; w.x = pkbf(v.x, v.y); w.y = pkbf(v.z, v.w); *(v2u*)(SG + i) = w; } }
    { float* LUT = (float*)(F.ws + WS_LUT); const float* rb = F.in[I_RELB];
      for (int i = F.vcu * NT + F.tid; i < 8 * 512; i += F.G * NT) { const int hd = i >> 9, rel = (i & 511) - 256; float v = -1e30f; if (rel >= -128 && rel <= 128) v = rb[t5_bucket(rel) * 8 + hd]; LUT[i] = v; } }
    { float* LAM = (float*)(F.ws + WS_LAM); float* LAM512 = (float*)(F.ws + WS_LAM512); bf16* BB = (bf16*)(F.ws + WS_BB); bf16* CM = (bf16*)(F.ws + WS_CM);
      for (int i = F.vcu * NT + F.tid; i < 2 * 64 * 64; i += F.G * NT) {
          const int p = i & 63, dg = i >> 6;
          const double dt = (double)expf(F.in[I_LDT][dg]); const double ar = (double)F.in[I_ARE][i], ai = (double)F.in[I_AIM][i];
          const double mag = (double)expf((float)(ar * dt)); double sn, cs; sincos_d(ai * dt, sn, cs);
          const double lbr = mag * cs, lbi = mag * sn, den = ar * ar + ai * ai, nr = lbr - 1.0;
          const double cr = (nr * ar + lbi * ai) / den, ci = (lbi * ar - nr * ai) / den;
          LAM[2 * i] = (float)lbr; LAM[2 * i + 1] = (float)lbi;
          const double mag5 = (double)expf((float)(512.0 * ar * dt)); double s5, c5; sincos_d(512.0 * ai * dt, s5, c5);
          LAM512[2 * i] = (float)(mag5 * c5); LAM512[2 * i + 1] = (float)(mag5 * s5);
#pragma unroll
          for (int c = 0; c < 16; ++c) { const double br = (double)F.in[I_BRE][(size_t)i * 16 + c], bi = (double)F.in[I_BIM][(size_t)i * 16 + c];
              BB[((size_t)dg * 128 + 2 * p) * 16 + c] = f2bf1((float)(cr * br - ci * bi)); BB[((size_t)dg * 128 + 2 * p + 1) * 16 + c] = f2bf1((float)(cr * bi + ci * br));
              CM[((size_t)dg * 16 + c) * 128 + 2 * p] = f2bf1(F.in[I_CRE][((size_t)dg * 16 + c) * 64 + p]); CM[((size_t)dg * 16 + c) * 128 + 2 * p + 1] = f2bf1(-F.in[I_CIM][((size_t)dg * 16 + c) * 64 + p]); }
      } }
    { bf16* X16 = (bf16*)(F.ws + WS_X16); float* RS0 = (float*)(F.ws + WS_RSTD0);
      for (int m = gw; m < M; m += NGW) { const GAS f32x4* xr = (const GAS f32x4*)(F.in[I_X] + (size_t)m * D) + F.lane; f32x4 v[8]; float s = 0.f;
#pragma unroll
          for (int j = 0; j < 8; ++j) { v[j] = xr[64 * j]; s += (v[j].x * v[j].x + v[j].y * v[j].y) + (v[j].z * v[j].z + v[j].w * v[j].w); }
#pragma unroll
          for (int j = 0; j < 8; ++j) { v2u w; w.x = pkbf(v[j].x, v[j].y); w.y = pkbf(v[j].z, v[j].w); *((GAS v2u*)(X16 + (size_t)m * D) + F.lane + 64 * j) = w; }
          const float rstd = 1.0f / sqrtf(wave_sum(s) * (1.f / D) + EPS); if (F.lane == 0) RS0[m] = rstd; } }
}

constexpr int AT_P = 272;
constexpr int AT_K = 0, AT_VT = 128 * AT_P, AT_LUT = 2 * 128 * AT_P;
__device__ __forceinline__ void attn_unit(Frame& F, int unit) {
    const bf16* PROJ = (const bf16*)(F.ws + WS_PROJ); bf16* CAT = (bf16*)(F.ws + WS_CAT); const float* LUTG = (const float*)(F.ws + WS_LUT);
    const int hp = unit & 1, kvh = (unit >> 1) & 1, blk = (unit >> 2) & 31, b = unit >> 7;
    const int lane = F.lane, r = lane & 31, h = lane >> 5, hh = F.wave >> 2, head = kvh * 4 + hp * 2 + hh, qrow0 = (F.wave & 3) * 32;
    LAS unsigned char* lds = F.lds; LAS float* LUT = (LAS float*)(lds + AT_LUT);
    __syncthreads();
    for (int i = F.tid; i < 1024; i += NT) LUT[i] = LUTG[(kvh * 4 + hp * 2 + (i >> 9)) * 512 + (i & 511)] * 1.4426950408889634f;
    const size_t tq = (size_t)b * SEQ + blk * 128 + qrow0 + r;
    bf16x8 qf[8];
#pragma unroll
    for (int s = 0; s < 8; ++s) qf[s] = *(const bf16x8*)(PROJ + tq * EIN + QOFF + head * 128 + 16 * s + 8 * h);
    float mrun = F.in[I_SINK][head] * 1.4426950408889634f, lrun = 1.0f;
    f32x16 oacc[4];
#pragma unroll
    for (int dt = 0; dt < 4; ++dt)
#pragma unroll
        for (int i = 0; i < 16; ++i) oacc[dt][i] = 0.f;
    const int kb0 = blk > 0 ? blk - 1 : 0, kb1 = blk < SEQ / 128 - 1 ? blk + 1 : SEQ / 128 - 1;
    v4u kreg[4], vreg[4];
#define AT_LOADKV(kb_) do { const size_t tok0_ = (size_t)b * SEQ + (kb_) * 128; _Pragma("unroll") for (int i = 0; i < 4; ++i) { const int c = F.tid + NT * i, row = c >> 4, ch = c & 15, row2 = c & 127, ch2 = c >> 7; \
        kreg[i] = *(const v4u*)(PROJ + (tok0_ + row) * EIN + KOFF + kvh * 128 + ch * 8); vreg[i] = *(const v4u*)(PROJ + (tok0_ + row2) * EIN + VOFF + kvh * 128 + ch2 * 8); } } while (0)
    AT_LOADKV(kb0);
    for (int kb = kb0; kb <= kb1; ++kb) {
        __syncthreads();
#pragma unroll
        for (int i = 0; i < 4; ++i) { const int c = F.tid + NT * i, row = c >> 4, ch = c & 15, row2 = c & 127, ch2 = c >> 7;
            const v4u kv = kreg[i], vv = vreg[i];
            *(LAS v4u*)(lds + AT_K + row * AT_P + ch * 16) = kv;
            LAS bf16* vt = (LAS bf16*)(lds + AT_VT + (ch2 * 8) * AT_P + row2 * 2);
            vt[0 * (AT_P / 2)] = (bf16)(vv.x & 0xffffu); vt[1 * (AT_P / 2)] = (bf16)(vv.x >> 16); vt[2 * (AT_P / 2)] = (bf16)(vv.y & 0xffffu); vt[3 * (AT_P / 2)] = (bf16)(vv.y >> 16);
            vt[4 * (AT_P / 2)] = (bf16)(vv.z & 0xffffu); vt[5 * (AT_P / 2)] = (bf16)(vv.z >> 16); vt[6 * (AT_P / 2)] = (bf16)(vv.w & 0xffffu); vt[7 * (AT_P / 2)] = (bf16)(vv.w >> 16); }
        if (kb < kb1) AT_LOADKV(kb + 1);
        __syncthreads();
#pragma unroll 1
        for (int kp = 0; kp < 2; ++kp) {
            if ((kb < blk && kp == 0 && qrow0 >= 64) || (kb > blk && kp == 1 && qrow0 < 64)) continue;
            f32x16 sacc[2];
#pragma unroll
            for (int q = 0; q < 2; ++q)
#pragma unroll
                for (int i = 0; i < 16; ++i) sacc[q][i] = 0.f;
#pragma unroll
            for (int s = 0; s < 8; ++s) {
                const bf16x8 a0 = *(const LAS bf16x8*)(lds + AT_K + (64 * kp + r) * AT_P + (16 * s + 8 * h) * 2);
                const bf16x8 a1 = *(const LAS bf16x8*)(lds + AT_K + (64 * kp + 32 + r) * AT_P + (16 * s + 8 * h) * 2);
                sacc[0] = MFMA32(a0, qf[s], sacc[0]); sacc[1] = MFMA32(a1, qf[s], sacc[1]); }
            const int relbase = (kb - blk) * 128 + 64 * kp + 4 * h - qrow0 - r + 256 + hh * 512;
            float x[32]; float tmax = -3.0e38f;
#pragma unroll
            for (int q = 0; q < 2; ++q)
#pragma unroll
                for (int i = 0; i < 16; ++i) { x[16 * q + i] = sacc[q][i] * (0.08838834764831845f * 1.4426950408889634f) + LUT[relbase + 32 * q + (i & 3) + 8 * (i >> 2)]; tmax = fmaxf(tmax, x[16 * q + i]); }
            tmax = fmaxf(tmax, __shfl_xor(tmax, 32));
            const float mnew = fmaxf(mrun, tmax);
            if (__ballot(mnew > mrun) != 0ull) {
                const float alpha = __builtin_amdgcn_exp2f(mrun - mnew); lrun *= alpha;
#pragma unroll
                for (int dt = 0; dt < 4; ++dt)
#pragma unroll
                    for (int i = 0; i < 16; ++i) oacc[dt][i] *= alpha;
            }
            mrun = mnew;
            float psum = 0.f;
#pragma unroll
            for (int i = 0; i < 32; ++i) { x[i] = __builtin_amdgcn_exp2f(x[i] - mnew); psum += x[i]; }
            psum += __shfl_xor(psum, 32);
            lrun += psum;
            bf16x8 pb[4];
#pragma unroll
            for (int s2 = 0; s2 < 4; ++s2) { v4u w; w.x = pkbf(x[8 * s2 + 0], x[8 * s2 + 1]); w.y = pkbf(x[8 * s2 + 2], x[8 * s2 + 3]); w.z = pkbf(x[8 * s2 + 4], x[8 * s2 + 5]); w.w = pkbf(x[8 * s2 + 6], x[8 * s2 + 7]); pb[s2] = __builtin_bit_cast(bf16x8, w); }
#pragma unroll
            for (int s2 = 0; s2 < 4; ++s2)
#pragma unroll
                for (int dt = 0; dt < 4; ++dt) { const LAS unsigned char* vp = lds + AT_VT + (32 * dt + r) * AT_P + (64 * kp + 16 * s2 + 4 * h) * 2;
                    const s16x4 lo = *(const LAS s16x4*)vp, hi = *(const LAS s16x4*)(vp + 16);
                    const bf16x8 a = __builtin_shufflevector(lo, hi, 0, 1, 2, 3, 4, 5, 6, 7);
                    oacc[dt] = MFMA32(a, pb[s2], oacc[dt]); }
        }
    }
#undef AT_LOADKV
    __syncthreads();
    const float inv = 1.0f / lrun;
    LAS unsigned char* ob = lds + F.wave * (32 * AT_P);
#pragma unroll
    for (int dt = 0; dt < 4; ++dt)
#pragma unroll
        for (int i = 0; i < 16; ++i) *(LAS bf16*)(ob + r * AT_P + (32 * dt + crow(i, h)) * 2) = f2bf1(oacc[dt][i] * inv);
    LDS_WAIT(); asm volatile("" ::: "memory");
    const size_t trow0 = (size_t)b * SEQ + blk * 128 + qrow0;
#pragma unroll
    for (int i = 0; i < 8; ++i) { const int c = lane + 64 * i, row = c >> 4, ch = c & 15;
        const v4u v = *(const LAS v4u*)(ob + row * AT_P + ch * 16);
        *(GAS v4u*)(CAT + (trow0 + row) * D + head * 128 + ch * 8) = v; }
}

constexpr int SS_XP = 66;
constexpr int SS_HP = 272;
constexpr int SS_SP = 20;
constexpr int SS_TILE8 = 64 * 36;
constexpr int SS_WAVE_BYTES = 32 * SS_HP + 32 * SS_SP * 4 + SS_TILE8;
constexpr int SS_C1 = SS_C1_, SS_C2 = SS_C2_;
struct HalfItem { const float* W; unsigned char* WT; int row_base, k0, n0; };
__device__ __forceinline__ HalfItem half_item_desc(Frame& F, int hid) { const ExpItem e = expert_item_desc(F, 0, hid >> 1); HalfItem h; h.W = e.W; h.WT = e.WT; h.row_base = e.row_base; h.k0 = e.k0 + 64 * (hid & 1); h.n0 = e.n0; return h; }
__device__ __forceinline__ void half_load(const HalfItem& h, int lane, f32x4 (&t)[8]) {
#pragma unroll
    for (int i = 0; i < 8; ++i) t[i] = *(const GAS f32x4*)(h.W + (size_t)(h.k0 + 8 * i + (lane >> 3)) * FF + h.n0 + 4 * (lane & 7));
}
__device__ __forceinline__ void half_finish(const HalfItem& h, const f32x4 (&t)[8], LAS unsigned* tile, int lane) {
#pragma unroll
    for (int i = 0; i < 8; ++i) tile[(8 * i + (lane >> 3)) * 9 + (lane & 7)] = pk4_fp8(t[i].x * WSC, t[i].y * WSC, t[i].z * WSC, t[i].w * WSC);
    LDS_WAIT(); asm volatile("" ::: "memory");
    const int kg = lane & 3, n4 = (lane >> 2) & 7, hf = lane >> 5;
    unsigned r[16];
#pragma unroll
    for (int j = 0; j < 16; ++j) r[j] = tile[(16 * kg + j) * 9 + n4];
    LDS_WAIT(); asm volatile("" ::: "memory");
    const unsigned selA = hf ? 0x07030602u : 0x05010400u;
    v4u o0, o1;
#pragma unroll
    for (int q = 0; q < 4; ++q) { const unsigned lo = bperm(r[4 * q + 1], r[4 * q], selA), hi = bperm(r[4 * q + 3], r[4 * q + 2], selA); o0[q] = bperm(hi, lo, 0x05040100u); o1[q] = bperm(hi, lo, 0x07060302u); }
    unsigned char* dst = h.WT + (size_t)(h.row_base + 4 * n4 + 2 * hf) * D + h.k0 + 16 * kg;
    *(GAS v4u*)dst = o0; *(GAS v4u*)(dst + D) = o1;
}
static_assert(NWAVES * SS_WAVE_BYTES <= SCR_BYTES && 32 * SS_XP * 4 <= 32 * SS_HP, "S5 scratch");

template <int DIR, int MODE>
__device__ __forceinline__ void ssm_superchunk(Frame& F, int b, int g, int sc, float& hre, float& him, int cv_first, int cv_n) {
    const bf16* PROJ = (const bf16*)(F.ws + WS_PROJ);
    const int lane = F.lane, r = lane & 31, h = lane >> 5, dg = DIR * 64 + g;
    LAS unsigned* XS = (LAS unsigned*)(F.lds + F.wave * SS_WAVE_BYTES); LAS unsigned char* HS = (LAS unsigned char*)XS;
    LAS float* ST = (LAS float*)(HS + 32 * SS_HP);
    LAS unsigned* tile8 = (LAS unsigned*)(HS + 32 * SS_HP + 32 * SS_SP * 4);
    const float2 lam = ((const float2*)(F.ws + WS_LAM))[dg * 64 + lane];
    bf16x8 bbf[4];
#pragma unroll
    for (int t = 0; t < 4; ++t) bbf[t] = *(const bf16x8*)((const bf16*)(F.ws + WS_BB) + ((size_t)dg * 128 + 32 * t + r) * 16 + 8 * h);
    const bf16* cmp_ = (const bf16*)(F.ws + WS_CM) + ((size_t)dg * 16 + (lane & 15)) * 128 + 8 * (lane >> 4);
    const size_t tsc = (size_t)b * SEQ + sc * 512;
    bf16* YF = (bf16*)(F.ws + WS_YF); bf16* G = (bf16*)(F.ws + WS_G);
    const int cb = g * 16 + 8 * h;
    f32x4 dsk0 = (f32x4){0.f, 0.f, 0.f, 0.f}, dsk1 = dsk0;
    if (MODE == 2) { dsk0 = *(const f32x4*)(F.in[I_SSMD] + cb); dsk1 = *(const f32x4*)(F.in[I_SSMD] + cb + 4); }
    const size_t tfirst = tsc + (DIR ? 15 : 0) * 32;
    bf16x8 uf = *(const bf16x8*)(PROJ + (tfirst + r) * EIN + UOFF + cb);
    v4u yfv = (v4u){0u, 0u, 0u, 0u};
    if (MODE == 2) yfv = *(const v4u*)(YF + (tfirst + r) * SW + cb);
    HalfItem cvh = {}; f32x4 cvt[8];
    if (cv_n > 0) { cvh = half_item_desc(F, cv_first); half_load(cvh, lane, cvt); }
#pragma unroll 1
    for (int ci = 0; ci < 16; ++ci) {
        const int ch = DIR ? 15 - ci : ci; const size_t t0 = tsc + ch * 32;
        const int chn = (ci < 15) ? (DIR ? ch - 1 : ch + 1) : ch; const size_t tn = tsc + chn * 32;
        const bf16x8 uf_n = *(const bf16x8*)(PROJ + (tn + r) * EIN + UOFF + cb);
        v4u yfn = (v4u){0u, 0u, 0u, 0u};
        if (MODE == 2) yfn = *(const v4u*)(YF + (tn + r) * SW + cb);

#pragma unroll
        for (int t = 0; t < 4; ++t) { f32x16 xa;
#pragma unroll
            for (int i = 0; i < 16; ++i) xa[i] = 0.f;
            xa = MFMA32(bbf[t], uf, xa);
#pragma unroll
            for (int k = 0; k < 4; ++k) { v2u w; w.x = pkbf(xa[4 * k], xa[4 * k + 1]); w.y = pkbf(xa[4 * k + 2], xa[4 * k + 3]);
                *(LAS v2u*)(XS + r * SS_XP + 16 * t + 4 * k + 2 * h) = w; } }
        LDS_WAIT(); asm volatile("" ::: "memory");
        float xr[32], xi[32];
#pragma unroll
        for (int s = 0; s < 32; ++s) { const unsigned x2 = XS[s * SS_XP + lane]; xr[s] = bflo(x2); xi[s] = bfhi(x2); }
        LDS_WAIT(); asm volatile("" ::: "memory");
#pragma unroll
        for (int st = 0; st < 32; ++st) { const int s = DIR ? 31 - st : st;
            const float nr = lam.x * hre - lam.y * him + xr[s], ni = lam.x * him + lam.y * hre + xi[s]; hre = nr; him = ni;
            if (MODE != 0) *(LAS unsigned*)(HS + s * SS_HP + lane * 4) = pkbf(nr, ni); }
        if (ci < cv_n) { half_finish(cvh, cvt, tile8, lane);
            if (ci + 1 < cv_n) { cvh = half_item_desc(F, cv_first + (ci + 1) * 2048); half_load(cvh, lane, cvt); } }
        if (MODE != 0) {
            LDS_WAIT(); asm volatile("" ::: "memory");
            f32x4 y[2]; bf16x8 cmf[4];
#pragma unroll
            for (int ks = 0; ks < 4; ++ks) cmf[ks] = *(const bf16x8*)(cmp_ + 32 * ks);
#pragma unroll
            for (int rt = 0; rt < 2; ++rt) { y[rt] = (f32x4){0.f, 0.f, 0.f, 0.f};
#pragma unroll
                for (int ks = 0; ks < 4; ++ks) { const bf16x8 a = *(const LAS bf16x8*)(HS + (16 * rt + (lane & 15)) * SS_HP + (32 * ks + 8 * (lane >> 4)) * 2); y[rt] = MFMA16(a, cmf[ks], y[rt]); } }
#pragma unroll
            for (int rt = 0; rt < 2; ++rt)
#pragma unroll
                for (int j = 0; j < 4; ++j) ST[(16 * rt + 4 * (lane >> 4) + j) * SS_SP + (lane & 15)] = y[rt][j];
            LDS_WAIT(); asm volatile("" ::: "memory");
            const f32x4 ya = *(const LAS f32x4*)(ST + r * SS_SP + 8 * h), yb = *(const LAS f32x4*)(ST + r * SS_SP + 8 * h + 4);
            LDS_WAIT(); asm volatile("" ::: "memory");
            v4u o;
            if (MODE == 1 || MODE == 3) { o.x = pkbf(ya.x, ya.y); o.y = pkbf(ya.z, ya.w); o.z = pkbf(yb.x, yb.y); o.w = pkbf(yb.z, yb.w); if (MODE == 1 || F.G == 12345) *(v4u*)(YF + (t0 + r) * SW + cb) = o; }
            else {
                const v4u uw = __builtin_bit_cast(v4u, uf);
                const float v0 = ya.x + bflo(yfv.x) + dsk0.x * bflo(uw.x), v1 = ya.y + bfhi(yfv.x) + dsk0.y * bfhi(uw.x), v2 = ya.z + bflo(yfv.y) + dsk0.z * bflo(uw.y), v3 = ya.w + bfhi(yfv.y) + dsk0.w * bfhi(uw.y);
                const float v4 = yb.x + bflo(yfv.z) + dsk1.x * bflo(uw.z), v5 = yb.y + bfhi(yfv.z) + dsk1.y * bfhi(uw.z), v6 = yb.z + bflo(yfv.w) + dsk1.z * bflo(uw.w), v7 = yb.w + bfhi(yfv.w) + dsk1.w * bfhi(uw.w);
                o.x = pkbf(gelu_tanh(v0), gelu_tanh(v1)); o.y = pkbf(gelu_tanh(v2), gelu_tanh(v3)); o.z = pkbf(gelu_tanh(v4), gelu_tanh(v5)); o.w = pkbf(gelu_tanh(v6), gelu_tanh(v7));
                *(v4u*)(G + (t0 + r) * SW + cb) = o; }
        }
        uf = uf_n; yfv = yfn;
    }
}
__device__ __forceinline__ void ssm_pass1(Frame& F) {
    float* E = (float*)(F.ws + WS_E);
    const bool cvon = F.G * NWAVES == 2048; const int wg = F.vcu * NWAVES + F.wave; int li0 = 0;
    for (int task = F.vcu * NWAVES + F.wave; task < BATCH * 64 * 2 * 8; task += F.G * NWAVES, li0 += 16) {
        const int sc = task & 7, dir = (task >> 3) & 1, g = (task >> 4) & 63, b = task >> 10;
        float hre = 0.f, him = 0.f;
        const int cn = cvon ? (SS_C1 - li0 < 0 ? 0 : (SS_C1 - li0 > 16 ? 16 : SS_C1 - li0)) : 0, cf = li0 * 2048 + wg;
        if (dir == 0) ssm_superchunk<0, 0>(F, b, g, sc, hre, him, cf, cn); else ssm_superchunk<1, 0>(F, b, g, sc, hre, him, cf, cn);
        E[(size_t)task * 128 + F.lane] = hre; E[(size_t)task * 128 + 64 + F.lane] = him;
    }
}
__device__ __forceinline__ void ssm_pass2(Frame& F) {
    const float* E = (const float*)(F.ws + WS_E);
    const bool cvon = F.G * NWAVES == 2048; const int wg = F.vcu * NWAVES + F.wave;
    for (int task = F.vcu * NWAVES + F.wave; task < BATCH * 64 * 8; task += F.G * NWAVES) {
        const int sc = task & 7, g = (task >> 3) & 63, b = task >> 9;
        const int c0 = cvon ? (SS_C2 > 16 ? 16 : SS_C2) : 0, c1n = cvon ? (SS_C2 > 16 ? SS_C2 - 16 : 0) : 0;
        { const float2 l5 = ((const float2*)(F.ws + WS_LAM512))[(0 * 64 + g) * 64 + F.lane]; float cr = 0.f, ci = 0.f;
          float er[7], ei[7];
#pragma unroll
          for (int s2 = 0; s2 < 7; ++s2) { const float* e = E + ((size_t)(((b * 64 + g) * 2 + 0) * 8 + s2)) * 128; er[s2] = e[F.lane]; ei[s2] = e[64 + F.lane]; }
#pragma unroll
          for (int s2 = 0; s2 < 7; ++s2) if (s2 < sc) { const float nr = l5.x * cr - l5.y * ci + er[s2], ni = l5.x * ci + l5.y * cr + ei[s2]; cr = nr; ci = ni; }
#if defined(PROBE_SSM_M1)
          { float c2r = cr, c2i = ci; ssm_superchunk<0, 1>(F, b, g, sc, c2r, c2i, 0, 0); }
#endif
#if defined(PROBE_SSM_M3)
          { float c2r = cr, c2i = ci; ssm_superchunk<0, 3>(F, b, g, sc, c2r, c2i, 0, 0); }
#endif
          ssm_superchunk<0, 1>(F, b, g, sc, cr, ci, SS_C1 * 2048 + wg, c0); }
        { const float2 l5 = ((const float2*)(F.ws + WS_LAM512))[(1 * 64 + g) * 64 + F.lane]; float cr = 0.f, ci = 0.f;
          float er[7], ei[7];
#pragma unroll
          for (int q = 0; q < 7; ++q) { const float* e = E + ((size_t)(((b * 64 + g) * 2 + 1) * 8 + 7 - q)) * 128; er[q] = e[F.lane]; ei[q] = e[64 + F.lane]; }
#pragma unroll
          for (int q = 0; q < 7; ++q) if (7 - q > sc) { const float nr = l5.x * cr - l5.y * ci + er[q], ni = l5.x * ci + l5.y * cr + ei[q]; cr = nr; ci = ni; }
          ssm_superchunk<1, 2>(F, b, g, sc, cr, ci, (SS_C1 + 16) * 2048 + wg, c1n); }
    }
}

__device__ __forceinline__ void router_phase(Frame& F, const bf16* X16, const float* gain, const float* router) {
    unsigned char* H = F.ws + WS_H; float* AFF = (float*)(F.ws + WS_AFF);
    LAS f32x4* RL = (LAS f32x4*)F.lds;
    __syncthreads();
    for (int q = F.tid; q < 2048 * 4; q += NT) { const int d = q >> 2, e4 = q & 3; const f32x4 v = *(const f32x4*)(router + d * 16 + e4 * 4);
        RL[(((d >> 8) * 4 + (d & 3)) * 4 + e4) * 64 + ((d & 255) >> 2)] = v; }
    __syncthreads();
    const int lane = F.lane;
    f32x4 gn[8];
#pragma unroll
    for (int j = 0; j < 8; ++j) gn[j] = *((const GAS f32x4*)gain + lane + 64 * j);
    for (int pr = F.vcu * NWAVES + F.wave; pr < M / 2; pr += F.G * NWAVES) {
        const size_t t0 = (size_t)pr * 2;
        f32x4 v0[8], v1[8]; float s0 = 0.f, s1 = 0.f;
#pragma unroll
        for (int j = 0; j < 8; ++j) {
            { const v2u x0 = *((const GAS v2u*)(X16 + t0 * D) + lane + 64 * j), x1 = *((const GAS v2u*)(X16 + (t0 + 1) * D) + lane + 64 * j);
                v0[j] = (f32x4){bflo(x0.x), bfhi(x0.x), bflo(x0.y), bfhi(x0.y)}; v1[j] = (f32x4){bflo(x1.x), bfhi(x1.x), bflo(x1.y), bfhi(x1.y)}; }
            s0 += (v0[j].x * v0[j].x + v0[j].y * v0[j].y) + (v0[j].z * v0[j].z + v0[j].w * v0[j].w); s1 += (v1[j].x * v1[j].x + v1[j].y * v1[j].y) + (v1[j].z * v1[j].z + v1[j].w * v1[j].w); }
        const float r0 = 1.0f / sqrtf(wave_sum(s0) * (1.f / D) + EPS), r1 = 1.0f / sqrtf(wave_sum(s1) * (1.f / D) + EPS);
        f32x4 a0[4], a1[4];
#pragma unroll
        for (int e4 = 0; e4 < 4; ++e4) { a0[e4] = (f32x4){0.f, 0.f, 0.f, 0.f}; a1[e4] = (f32x4){0.f, 0.f, 0.f, 0.f}; }
#pragma unroll
        for (int j = 0; j < 8; ++j) { v0[j] = v0[j] * r0 * gn[j]; v1[j] = v1[j] * r1 * gn[j];
            *((GAS unsigned*)(H + t0 * D) + lane + 64 * j) = pk4_fp8(v0[j].x * HSC, v0[j].y * HSC, v0[j].z * HSC, v0[j].w * HSC);
            *((GAS unsigned*)(H + (t0 + 1) * D) + lane + 64 * j) = pk4_fp8(v1[j].x * HSC, v1[j].y * HSC, v1[j].z * HSC, v1[j].w * HSC);
#pragma unroll
            for (int i = 0; i < 4; ++i) {
#pragma unroll
                for (int e4 = 0; e4 < 4; ++e4) { const f32x4 w = RL[((j * 4 + i) * 4 + e4) * 64 + lane]; a0[e4] += w * v0[j][i]; a1[e4] += w * v1[j][i]; }
                if (i & 1) asm volatile("" ::: "memory"); } }
        int ln = lane; asm volatile("" : "+v"(ln));
        float lg[2];
#pragma unroll
        for (int t = 0; t < 2; ++t) { float v[16];
#pragma unroll
            for (int e4 = 0; e4 < 4; ++e4)
#pragma unroll
                for (int c = 0; c < 4; ++c) v[e4 * 4 + c] = t ? a1[e4][c] : a0[e4][c];
#pragma unroll
            for (int s = 0; s < 4; ++s) { const int m = 1 << s, half = 8 >> s; const bool up = (ln & m) != 0;
#pragma unroll
                for (int i = 0; i < half; ++i) { const float send = up ? v[i] : v[i + half], keep = up ? v[i + half] : v[i]; v[i] = keep + __shfl_xor(send, m); } }
            float r2 = v[0]; r2 += __shfl_xor(r2, 16); r2 += __shfl_xor(r2, 32); lg[t] = r2; }
        const int ee = ((ln & 1) << 3) | ((ln & 2) << 1) | ((ln & 4) >> 1) | ((ln & 8) >> 3);
        float mx0 = lg[0], mx1 = lg[1];
#pragma unroll
        for (int m = 1; m < 16; m <<= 1) { mx0 = fmaxf(mx0, __shfl_xor(mx0, m)); mx1 = fmaxf(mx1, __shfl_xor(mx1, m)); }
        const float ex0 = expf(lg[0] - mx0), ex1 = expf(lg[1] - mx1); float z0 = ex0, z1 = ex1;
#pragma unroll
        for (int m = 1; m < 16; m <<= 1) { z0 += __shfl_xor(z0, m); z1 += __shfl_xor(z1, m); }
        const int bb = (int)(t0 / SEQ), ss = (int)(t0 % SEQ);
        if (ln < 16) { AFF[((size_t)bb * NE + ee) * SEQ + ss] = ex0 / z0; AFF[((size_t)bb * NE + ee) * SEQ + ss + 1] = ex1 / z1; }
    }
    __syncthreads();
}

__device__ __forceinline__ void topk_unit(Frame& F, int unit) {
    const float* AFF = (const float*)(F.ws + WS_AFF) + (size_t)unit * SEQ;
    int* IDX = (int*)(F.ws + WS_IDX) + (size_t)unit * CAP; float* GATE = (float*)(F.ws + WS_GATE) + (size_t)unit * CAP; int* INV = (int*)(F.ws + WS_INV);
    const int b = unit >> 4, e = unit & 15, tid = F.tid, lane = F.lane;
    int* TOK = (int*)(F.ws + WS_TOK) + e * 2048 + b * 512;
    LAS unsigned* hist = (LAS unsigned*)F.lds;
    LAS unsigned* misc = hist + 256;
    unsigned v[8];
    { const v4u a = *(const v4u*)(AFF + tid * 8), c = *(const v4u*)(AFF + tid * 8 + 4); v[0] = a.x; v[1] = a.y; v[2] = a.z; v[3] = a.w; v[4] = c.x; v[5] = c.y; v[6] = c.z; v[7] = c.w; }
    unsigned prefix = 0u, need = CAP;
#pragma unroll 1
    for (int pass = 0; pass < 4; ++pass) {
        const int shift = 24 - 8 * pass;
        __syncthreads();
        if (tid < 256) hist[tid] = 0u;
        __syncthreads();
#pragma unroll
        for (int k = 0; k < 8; ++k) { const bool match = (pass == 0) || ((v[k] >> (shift + 8)) == prefix); if (match) (void)__hip_atomic_fetch_add(&hist[(v[k] >> shift) & 255u], 1u, __ATOMIC_RELAXED, __HIP_MEMORY_SCOPE_WORKGROUP); }
        __syncthreads();
        if (F.wave == 0) {
            const unsigned c0 = hist[4 * lane], c1 = hist[4 * lane + 1], c2 = hist[4 * lane + 2], c3 = hist[4 * lane + 3];
            unsigned suf = c0 + c1 + c2 + c3;
#pragma unroll
            for (int o = 1; o < 64; o <<= 1) { const unsigned t = __shfl_down(suf, o); if (lane + o < 64) suf += t; }
            const unsigned long long mask = __ballot(suf >= need);
            const int L = 63 - __builtin_clzll(mask);
            if (lane == L) { unsigned run = suf - (c0 + c1 + c2 + c3); unsigned dig, nd;
                if (run + c3 >= need) { dig = 3; nd = need - run; } else { run += c3;
                if (run + c2 >= need) { dig = 2; nd = need - run; } else { run += c2;
                if (run + c1 >= need) { dig = 1; nd = need - run; } else { run += c1; dig = 0; nd = need - run; } } }
                misc[0] = 4u * (unsigned)lane + dig; misc[1] = nd; }
        }
        __syncthreads();
        prefix = (prefix << 8) | misc[0]; need = misc[1];
    }
    const unsigned T = prefix;
    unsigned neq = 0u;
#pragma unroll
    for (int k = 0; k < 8; ++k) neq += (v[k] == T) ? 1u : 0u;
    unsigned inc = neq;
#pragma unroll
    for (int o = 1; o < 64; o <<= 1) { const unsigned t = __shfl_up(inc, o); if (lane >= o) inc += t; }
    __syncthreads();
    if (lane == 63) misc[16 + F.wave] = inc;
    __syncthreads();
    unsigned woff = 0u;
#pragma unroll
    for (int w = 0; w < NWAVES; ++w) woff += (w < F.wave) ? misc[16 + w] : 0u;
    unsigned eqrank = woff + inc - neq;
    unsigned sel = 0u; unsigned selm = 0u;
#pragma unroll
    for (int k = 0; k < 8; ++k) { bool s = v[k] > T; if (v[k] == T) { s = eqrank < need; ++eqrank; } if (s) { selm |= 1u << k; ++sel; } }
    unsigned inc2 = sel;
#pragma unroll
    for (int o = 1; o < 64; o <<= 1) { const unsigned t = __shfl_up(inc2, o); if (lane >= o) inc2 += t; }
    if (lane == 63) misc[32 + F.wave] = inc2;
    __syncthreads();
    unsigned woff2 = 0u;
#pragma unroll
    for (int w = 0; w < NWAVES; ++w) woff2 += (w < F.wave) ? misc[32 + w] : 0u;
    unsigned slot = woff2 + inc2 - sel;
#pragma unroll
    for (int k = 0; k < 8; ++k) { const int s = tid * 8 + k; int sl = -1;
        if (selm & (1u << k)) { sl = (int)slot; ++slot; IDX[sl] = s; TOK[sl] = b * SEQ + s; GATE[sl] = __builtin_bit_cast(float, v[k]); }
        INV[((size_t)b * SEQ + s) * NE + e] = sl; }
}

__device__ __forceinline__ void gather_phase(Frame& F) {
    const unsigned char* H = F.ws + WS_H; unsigned char* XS = F.ws + WS_XS; const int* IDX = (const int*)(F.ws + WS_IDX);
    for (int row = F.vcu * NWAVES + F.wave; row < MS; row += F.G * NWAVES) {
        const int e = row >> 11, b = (row >> 9) & 3, c = row & 511; const int s = IDX[(b * NE + e) * CAP + c];
        const GAS v4u* src = (const GAS v4u*)(H + ((size_t)b * SEQ + s) * D) + F.lane; GAS v4u* dst = (GAS v4u*)(XS + (size_t)row * D) + F.lane;
        const v4u t0 = src[0], t1 = src[64];
        dst[0] = t0; dst[64] = t1;
    }
}
template <bool FINAL>
__device__ __forceinline__ void combine_phase(Frame& F, const bf16* Xin, bf16* Xout, const float* gain) {
    const unsigned char* YS = F.ws + WS_YS; const int* INV = (const int*)(F.ws + WS_INV); const float* GATE = (const float*)(F.ws + WS_GATE);
    const int lane = F.lane;
    const int tstep = F.G * NWAVES; int t = F.vcu * NWAVES + F.wave;
    typedef float f2 __attribute__((ext_vector_type(2)));
#define CB_FIRST(inv_, tok_, W0, W1, G0, G1) do { const unsigned m_ = (unsigned)(__ballot((inv_) >= 0) & 0xffffull); \
        if (m_) { const int b_ = (tok_) / SEQ; const int e0_ = __builtin_ctz(m_); const unsigned mr_ = m_ & (m_ - 1u); const bool two_ = mr_ != 0u; const int e1_ = two_ ? __builtin_ctz(mr_) : e0_; \
            const int s0_ = __builtin_amdgcn_readlane((inv_), e0_), s1_ = __builtin_amdgcn_readlane((inv_), e1_); \
            G0 = GATE[(b_ * NE + e0_) * CAP + s0_] * (1.f / YSC); G1 = two_ ? GATE[(b_ * NE + e1_) * CAP + s1_] * (1.f / YSC) : 0.f; \
            const size_t r0_ = (size_t)e0_ * 2048 + b_ * 512 + s0_, r1_ = (size_t)e1_ * 2048 + b_ * 512 + s1_; \
            _Pragma("unroll") for (int j = 0; j < 8; ++j) { W0[j] = *((const GAS unsigned*)(YS + r0_ * D) + lane + 64 * j); W1[j] = *((const GAS unsigned*)(YS + r1_ * D) + lane + 64 * j); } } } while (0)
#define CB_ACC(W0, W1, G0, G1) do { _Pragma("unroll") for (int j = 0; j < 8; ++j) { \
            const f2 a0 = __builtin_amdgcn_cvt_pk_f32_fp8((int)W0[j], false), a1 = __builtin_amdgcn_cvt_pk_f32_fp8((int)W0[j], true), b0 = __builtin_amdgcn_cvt_pk_f32_fp8((int)W1[j], false), b1 = __builtin_amdgcn_cvt_pk_f32_fp8((int)W1[j], true); \
            v[j].x += G0 * a0.x + G1 * b0.x; v[j].y += G0 * a0.y + G1 * b0.y; v[j].z += G0 * a1.x + G1 * b1.x; v[j].w += G0 * a1.y + G1 * b1.y; } } while (0)
    f32x4 v[8]; int myinv = -1, inv1 = -1; unsigned pw0[8], pw1[8]; float pg0 = 0.f, pg1 = 0.f;
    f32x4 gn[8];
    if (FINAL) {
#pragma unroll
        for (int j = 0; j < 8; ++j) gn[j] = *((const GAS f32x4*)gain + lane + 64 * j);
    }
    if (t < M) {
        const int tn = (t + tstep < M) ? t + tstep : t;
#pragma unroll
        for (int j = 0; j < 8; ++j) { const v2u x = *((const GAS v2u*)(Xin + (size_t)t * D) + lane + 64 * j); v[j] = (f32x4){bflo(x.x), bfhi(x.x), bflo(x.y), bfhi(x.y)}; }
        myinv = INV[(size_t)t * NE + (lane & 15)]; inv1 = INV[(size_t)tn * NE + (lane & 15)];
        CB_FIRST(myinv, t, pw0, pw1, pg0, pg1);
    }
    for (; t < M; t += tstep) {
        const int b = t / SEQ; const int tn = (t + tstep < M) ? t + tstep : t, tn2 = (tn + tstep < M) ? tn + tstep : tn;
        v2u vnp[8];
#pragma unroll
        for (int j = 0; j < 8; ++j) vnp[j] = *((const GAS v2u*)(Xin + (size_t)tn * D) + lane + 64 * j);
        const int inv2 = INV[(size_t)tn2 * NE + (lane & 15)];
        unsigned w0n[8], w1n[8]; float g0n = 0.f, g1n = 0.f;
        CB_FIRST(inv1, tn, w0n, w1n, g0n, g1n);
        unsigned m = (unsigned)(__ballot(myinv >= 0) & 0xffffull);
        if (m) { CB_ACC(pw0, pw1, pg0, pg1); m &= m - 1u; m &= m - 1u; }
        while (m) {
            const int e0 = __builtin_ctz(m); m &= m - 1u; const bool two = m != 0u; const int e1 = two ? __builtin_ctz(m) : e0; m &= m - 1u;
            const int s0 = __builtin_amdgcn_readlane(myinv, e0), s1 = __builtin_amdgcn_readlane(myinv, e1);
            const float g0 = GATE[(b * NE + e0) * CAP + s0] * (1.f / YSC), g1 = two ? GATE[(b * NE + e1) * CAP + s1] * (1.f / YSC) : 0.f;
            const size_t r0 = (size_t)e0 * 2048 + b * 512 + s0, r1 = (size_t)e1 * 2048 + b * 512 + s1;
            unsigned w0[8], w1[8];
#pragma unroll
            for (int j = 0; j < 8; ++j) { w0[j] = *((const GAS unsigned*)(YS + r0 * D) + lane + 64 * j); w1[j] = *((const GAS unsigned*)(YS + r1 * D) + lane + 64 * j); }
            CB_ACC(w0, w1, g0, g1);
        }
        float s = 0.f;
#pragma unroll
        for (int j = 0; j < 8; ++j) { if (!FINAL) { v2u w; w.x = pkbf(v[j].x, v[j].y); w.y = pkbf(v[j].z, v[j].w); *((GAS v2u*)(Xout + (size_t)t * D) + lane + 64 * j) = w; } s += (v[j].x * v[j].x + v[j].y * v[j].y) + (v[j].z * v[j].z + v[j].w * v[j].w); }
        const float rstd = 1.0f / sqrtf(wave_sum(s) * (1.f / D) + EPS);
        if (FINAL) {
#pragma unroll
            for (int j = 0; j < 8; ++j) *((GAS f32x4*)(F.out + (size_t)t * D) + lane + 64 * j) = v[j] * rstd * gn[j];
        } else if (lane == 0) ((float*)(F.ws + WS_RSTD))[t] = rstd;
#pragma unroll
        for (int j = 0; j < 8; ++j) { v[j] = (f32x4){bflo(vnp[j].x), bfhi(vnp[j].x), bflo(vnp[j].y), bfhi(vnp[j].y)}; pw0[j] = w0n[j]; pw1[j] = w1n[j]; }
        myinv = inv1; inv1 = inv2; pg0 = g0n; pg1 = g1n;
    }
#undef CB_FIRST
#undef CB_ACC
}

constexpr int SG_VT = 0, SG_MX = 128 * AT_P, SG_MP = 132;
static_assert(SG_MX + 128 * SG_MP * 4 <= SCR_BYTES, "sgu scratch");
__device__ __forceinline__ void sgu_phase(Frame& F) {
    const bf16* Z = (const bf16*)(F.ws + WS_Z); bf16* G2 = (bf16*)(F.ws + WS_G2); const float* STAT = (const float*)(F.ws + WS_STATP);   const bf16* SG = (const bf16*)(F.ws + WS_SGU);
    int hd = F.vcu & 15; const int nunits = (M / 128) * 16;
    const int lane = F.lane, r = lane & 31, h = lane >> 5;
    LAS unsigned char* lds = F.lds; LAS float* MX = (LAS float*)(lds + SG_MX);
    const int rt = F.wave >> 1, dt0 = (F.wave & 1) * 2;
    bf16x8 af[8]; float sb[16];
#define SG_CONSTS() do { _Pragma("unroll") for (int ks = 0; ks < 8; ++ks) af[ks] = *(const bf16x8*)(SG + ((size_t)hd * 128 + 32 * rt + r) * 128 + 16 * ks + 8 * h); \
        _Pragma("unroll") for (int i = 0; i < 16; ++i) sb[i] = F.in[I_SGUB][hd * 128 + 32 * rt + crow(i, h)]; } while (0)
    SG_CONSTS();
    v4u uuN[4], vvN[4]; float2 stN[8];
    int unit = F.vcu;
    if (unit < nunits) { const size_t t0 = (size_t)(unit >> 4) * 128;
#pragma unroll
        for (int i = 0; i < 4; ++i) { const int c = F.tid + NT * i; uuN[i] = *(const v4u*)(Z + (t0 + (c >> 4)) * ZW + hd * 128 + (c & 15) * 8);
            vvN[i] = *(const v4u*)(Z + (t0 + (c & 127)) * ZW + GW + hd * 128 + (c >> 7) * 8); }
#pragma unroll
        for (int q = 0; q < 8; ++q) stN[q] = *(const float2*)(STAT + ((size_t)q * M + t0 + (F.tid & 127)) * 2); }
    for (; unit < nunits; unit += F.G) {
        const size_t t0 = (size_t)(unit >> 4) * 128;
        if ((unit & 15) != hd) { hd = unit & 15; SG_CONSTS(); }
        v4u uu[4];
#pragma unroll
        for (int i = 0; i < 4; ++i) uu[i] = uuN[i];
        __syncthreads();
        float sum1 = 0.f, sum2 = 0.f;
#pragma unroll
        for (int q = 0; q < 8; ++q) { sum1 += stN[q].x; sum2 += stN[q].y; }
        const float mu = sum1 * (1.f / GW); const float var = fmaxf(sum2 * (1.f / GW) - mu * mu, 0.f); const float rstd = 1.0f / sqrtf(var + EPS);
#pragma unroll
        for (int i = 0; i < 4; ++i) { const int c = F.tid + NT * i, row = c & 127, ch = c >> 7;
            const v4u vv = vvN[i];
            const f32x4 g0 = *(const f32x4*)(F.in[I_LNG] + hd * 128 + ch * 8), g1 = *(const f32x4*)(F.in[I_LNG] + hd * 128 + ch * 8 + 4);
            const f32x4 b0 = *(const f32x4*)(F.in[I_LNB] + hd * 128 + ch * 8), b1 = *(const f32x4*)(F.in[I_LNB] + hd * 128 + ch * 8 + 4);
            LAS bf16* vt = (LAS bf16*)(lds + SG_VT + (ch * 8) * AT_P + row * 2);
            vt[0 * (AT_P / 2)] = f2bf1((bflo(vv.x) - mu) * rstd * g0.x + b0.x); vt[1 * (AT_P / 2)] = f2bf1((bfhi(vv.x) - mu) * rstd * g0.y + b0.y);
            vt[2 * (AT_P / 2)] = f2bf1((bflo(vv.y) - mu) * rstd * g0.z + b0.z); vt[3 * (AT_P / 2)] = f2bf1((bfhi(vv.y) - mu) * rstd * g0.w + b0.w);
            vt[4 * (AT_P / 2)] = f2bf1((bflo(vv.z) - mu) * rstd * g1.x + b1.x); vt[5 * (AT_P / 2)] = f2bf1((bfhi(vv.z) - mu) * rstd * g1.y + b1.y);
            vt[6 * (AT_P / 2)] = f2bf1((bflo(vv.w) - mu) * rstd * g1.z + b1.z); vt[7 * (AT_P / 2)] = f2bf1((bfhi(vv.w) - mu) * rstd * g1.w + b1.w); }
        if (unit + F.G < nunits) { const size_t t1 = (size_t)((unit + F.G) >> 4) * 128; const int h1 = (unit + F.G) & 15;
#pragma unroll
            for (int i = 0; i < 4; ++i) { const int c = F.tid + NT * i; uuN[i] = *(const v4u*)(Z + (t1 + (c >> 4)) * ZW + h1 * 128 + (c & 15) * 8);
                vvN[i] = *(const v4u*)(Z + (t1 + (c & 127)) * ZW + GW + h1 * 128 + (c >> 7) * 8); }
#pragma unroll
            for (int q = 0; q < 8; ++q) stN[q] = *(const float2*)(STAT + ((size_t)q * M + t1 + (F.tid & 127)) * 2); }
        __syncthreads();
        f32x16 acc[2];
#pragma unroll
        for (int q = 0; q < 2; ++q)
#pragma unroll
            for (int i = 0; i < 16; ++i) acc[q][i] = 0.f;
#pragma unroll
        for (int ks = 0; ks < 8; ++ks) {
#pragma unroll
            for (int q = 0; q < 2; ++q) { const bf16x8 bv = *(const LAS bf16x8*)(lds + SG_VT + (32 * (dt0 + q) + r) * AT_P + (16 * ks + 8 * h) * 2); acc[q] = MFMA32(af[ks], bv, acc[q]); } }
#pragma unroll
        for (int q = 0; q < 2; ++q)
#pragma unroll
            for (int i = 0; i < 16; ++i) { const int t = 32 * rt + crow(i, h); MX[t * SG_MP + 32 * (dt0 + q) + r] = acc[q][i] + sb[i]; }
        __syncthreads();
#pragma unroll
        for (int i = 0; i < 4; ++i) { const int c = F.tid + NT * i, row = c >> 4, ch = c & 15;
            const f32x4 m0 = *(const LAS f32x4*)(MX + row * SG_MP + ch * 8), m1 = *(const LAS f32x4*)(MX + row * SG_MP + ch * 8 + 4);
            v4u o; o.x = pkbf(bflo(uu[i].x) * m0.x, bfhi(uu[i].x) * m0.y); o.y = pkbf(bflo(uu[i].y) * m0.z, bfhi(uu[i].y) * m0.w);
            o.z = pkbf(bflo(uu[i].z) * m1.x, bfhi(uu[i].z) * m1.y); o.w = pkbf(bflo(uu[i].w) * m1.z, bfhi(uu[i].w) * m1.w);
            *(GAS v4u*)(G2 + (t0 + row) * GW + hd * 128 + ch * 8) = o; }
    }
#undef SG_CONSTS
}

constexpr int N_PHASES = 21;
struct Args { const float* in[28]; float* out; unsigned char* ws; int ph_lo, ph_hi; };
static_assert(sizeof(Args) == 28 * 8 + 8 + 8 + 8, "Args has no padding");

__global__ void __launch_bounds__(NT, 2) enc_fwd(Args args) {
    extern __shared__ __attribute__((aligned(16))) unsigned char lds[];
    Frame F;
    F.lds = (LAS unsigned char*)lds;
    F.MISC = (volatile LAS unsigned*)(F.lds + MISC_OFF);
    F.tid = threadIdx.x; F.lane = F.tid & 63; F.wave = __builtin_amdgcn_readfirstlane(F.tid >> 6);
    F.G = gridDim.x; { const int bx = blockIdx.x; F.vcu = (F.G % 8 == 0) ? (bx % 8) * (F.G / 8) + bx / 8 : bx; }
    F.ws = args.ws; F.ctl = (gu32*)(args.ws + WS_CTL); F.out = args.out;
#pragma unroll
    for (int i = 0; i < 28; ++i) F.in[i] = args.in[i];
    for (int u = F.tid; u < (LDS_BYTES - LDSCTL_OFF) / 4; u += NT) ((LAS unsigned*)(F.lds + LDSCTL_OFF))[u] = 0u;
    __syncthreads();
    const int lo = args.ph_lo, hi = args.ph_hi;
    const bool multi = (hi - lo) > 1;
    XcdBarrier bar; bar.bar = (unsigned*)(F.ctl + CW_BAR); bar.x = 0; bar.st = nullptr;
    if (multi) bar = xcd_barrier_post((unsigned*)(F.ctl + CW_BAR), F.MISC + 8);
#ifdef ONLY_PHASE
#define IN(k) ((k) == ONLY_PHASE && lo <= (k) && (k) < hi)
#else
#define IN(k) (lo <= (k) && (k) < hi)
#endif
#ifndef PROBE_DUP_MASK
#define PROBE_DUP_MASK 0u
#endif
#define PH(k) for (int _r = 0; _r < (((PROBE_DUP_MASK >> (k)) & 1u) ? 2 : 1); ++_r) if (IN(k))
#define STOP_THR(nunits, gw) ((unsigned)(((nunits) % (gw)) ? ((gw) - (nunits) % (gw) + 1) : 1))
#ifdef PROBE_DBLBAR
#define SEAM(k) do { if (IN((k) + 1)) { xcd_barrier(bar); xcd_barrier(bar); } } while (0)
#else
#define SEAM(k) do { if (IN((k) + 1)) xcd_barrier(bar); } while (0)
#endif
    LAS unsigned char* ring = F.lds;
    bf16* const H = (bf16*)(F.ws + WS_H); bf16* const DL = (bf16*)(F.ws + WS_XA);     bf16* const XB = (bf16*)(F.ws + WS_XB);
    unsigned char* const HID = F.ws + WS_HID; unsigned char* const YS = F.ws + WS_YS;

    PH(0) { p0_prologue(F);
#if defined(PROBE_P0)
        __syncthreads(); p0_prologue(F);
#endif
        SEAM(0); }
    PH(1) {
        const int NC1 = (F.G >= 64) ? ((F.G * 5 / 32) & ~7) : 0, GW1 = F.G - NC1;
        if ((int)blockIdx.x >= GW1) conv_bg(F, 0, F.ctl + CW_DONE1, STOP_THR((M / 256) * (EIN / 256), GW1));
        else {
        pg8::Gemm g{(const bf16*)(F.ws + WS_X16), (const bf16*)(F.ws + WS_WIN0), M, EIN, D}; pg8::StaticOrder S; S.init(M, EIN, GW1, (int)blockIdx.x);
        pg8::EpiStoreRS E{(bf16*)(F.ws + WS_PROJ), EIN, EIN / 256, (const float*)(F.ws + WS_RSTD0)};
        pg8::gemm_phase<pg8::EpiStoreRS, pg8::StaticOrder, true, true>(ring, g, S, E);
        __syncthreads(); if (F.tid == 0) (void)__hip_atomic_fetch_add(F.ctl + CW_DONE1, 1u, RLX_AGENT);
        conv_bg(F, 0, F.ctl + CW_DONE1, STOP_THR((M / 256) * (EIN / 256), GW1));
        }
        SEAM(1);
    }
    PH(2) {
        for (int u = F.vcu; u < BATCH * 32 * 2 * 2; u += F.G) attn_unit(F, u);
        __syncthreads();
        ssm_pass1(F);
#if defined(PROBE_SSM1)
        __syncthreads(); ssm_pass1(F);
#endif
#if defined(PROBE_ATTN)
        __syncthreads(); for (int u = blockIdx.x; u < BATCH * 32 * 2 * 2; u += F.G) attn_unit(F, u);
#endif
        SEAM(2);
    }
    PH(3) { ssm_pass2(F);
#if defined(PROBE_P3)
        __syncthreads(); ssm_pass2(F);
#endif
        SEAM(3); }
    PH(4) {
        pg8::Gemm g{(const bf16*)(F.ws + WS_G), (const bf16*)(F.ws + WS_GLU), M, SW, SW}; pg8::StaticOrder S; S.init(M, SW, F.G, (int)blockIdx.x);
        pg8::EpiGlu E{(const bf16*)(F.ws + WS_G), SW, (bf16*)(F.ws + WS_CAT), D, AW, F.in[I_GLUB]};
        pg8::gemm_phase<pg8::EpiGlu, pg8::StaticOrder, true, true>(ring, g, S, E);
#if defined(PROBE_G4)
        pg8::gemm_phase<pg8::EpiGlu, pg8::StaticOrder, true, true>(ring, g, S, E);
#endif
        SEAM(4);
    }
    PH(5) {
        pg8::Gemm g{(const bf16*)(F.ws + WS_CAT), (const bf16*)(F.ws + WS_WOUT0), M, D, D}; pg8::StaticOrder S; S.init(M, D, F.G, (int)blockIdx.x);
        pg8::EpiStoreRes E{DL, D, D / 256, (const bf16*)(F.ws + WS_X16)};
        pg8::gemm_phase<pg8::EpiStoreRes, pg8::StaticOrder, true, true>(ring, g, S, E);
        SEAM(5);
    }
    PH(6) { router_phase(F, DL, F.in[I_FFNN], F.in[I_ROUTER]);
        SEAM(6); }
    PH(7) { for (int u = blockIdx.x; u < BATCH * NE; u += F.G) topk_unit(F, u);
        __syncthreads(); conv_bg(F, 0, nullptr, 0u);
#if defined(PROBE_P7)
        __syncthreads(); for (int u = blockIdx.x; u < BATCH * NE; u += F.G) topk_unit(F, u);
#endif
        if (IN(9)) xcd_barrier(bar); }
    #ifndef NCONV_NUM
#define NCONV_NUM 3
#endif
    const int NCONV = (F.G >= 64) ? ((F.G * NCONV_NUM / 16) & ~7) : 0, GWG = F.G - NCONV; const bool is_conv = (int)blockIdx.x >= GWG;
    PH(9) {
        if (is_conv) conv_bg(F, 1, F.ctl + CW_DONE9, STOP_THR((MS / 256) * (2 * FF / 256), GWG));
        else {
        pg8::Gemm g{(const bf16*)(F.ws + WS_H), (const bf16*)(F.ws + WS_W13), MS, 2 * FF, D / 2, (const int*)(F.ws + WS_TOK)}; pg8::GroupedOrder S; S.init(MS, 2 * FF, GWG, (int)blockIdx.x); S.npg = 2 * FF / 256;
        pg8::EpiSwiglu8 E{HID, FF, 2 * FF / 256, 1.f / (HSC * WSC), HIDSC, 0};
        pg8::gemm_phase<pg8::EpiSwiglu8, pg8::GroupedOrder, true, true, true, true>(ring, g, S, E);
        __syncthreads(); if (F.tid == 0) (void)__hip_atomic_fetch_add(F.ctl + CW_DONE9, 1u, RLX_AGENT);
        conv_bg(F, 1, F.ctl + CW_DONE9, STOP_THR((MS / 256) * (2 * FF / 256), GWG));
        }
        SEAM(9);
    }
    PH(10) {
        if (!is_conv) {
        pg8::Gemm g{(const bf16*)HID, (const bf16*)(F.ws + WS_W2), MS, D, FF / 2}; pg8::GroupedOrder S; S.init(MS, D, GWG, (int)blockIdx.x); S.npg = D / 256;
        pg8::EpiStore8 E{YS, D, D / 256, YSC / (HIDSC * WSC)};
        pg8::gemm_phase<pg8::EpiStore8, pg8::GroupedOrder, true, true, true>(ring, g, S, E);
        __syncthreads();
        }
        conv_bg(F, 1, nullptr, 0u);
        SEAM(10);
    }
    PH(11) { combine_phase<false>(F, DL, XB, F.in[I_MIXN] + D);
        SEAM(11); }
    PH(12) {
        pg8::Gemm g{XB, (const bf16*)(F.ws + WS_WIN1), M, ZW, D}; pg8::StaticOrder S; S.init(M, ZW, F.G, (int)blockIdx.x);
        pg8::EpiGelu E{(bf16*)(F.ws + WS_Z), ZW, (float*)(F.ws + WS_STATP), GW / 256, (const float*)(F.ws + WS_RSTD), (LAS float*)(F.lds + 131072 + 1024), M};
        pg8::gemm_phase<pg8::EpiGelu, pg8::StaticOrder, true, true>(ring, g, S, E);
#if defined(PROBE_G12)
        { pg8::EpiGelu E2{(bf16*)(F.ws + WS_Z), ZW, (float*)(F.ws + WS_XS), GW / 256, (const float*)(F.ws + WS_RSTD), (LAS float*)(F.lds + 131072 + 1024), M}; pg8::gemm_phase<pg8::EpiGelu, pg8::StaticOrder, true, true>(ring, g, S, E2); }
#endif
        SEAM(12);
    }
    PH(13) { sgu_phase(F); SEAM(13); }
    PH(14) {
        pg8::Gemm g{(const bf16*)(F.ws + WS_G2), (const bf16*)(F.ws + WS_WOUT1), M, D, GW}; pg8::StaticOrder S; S.init(M, D, F.G, (int)blockIdx.x);
        pg8::EpiStoreRes E{DL, D, D / 256, XB};
        pg8::gemm_phase<pg8::EpiStoreRes, pg8::StaticOrder, true, true>(ring, g, S, E);
        SEAM(14);
    }
    PH(15) { router_phase(F, DL, F.in[I_FFNN] + D, F.in[I_ROUTER] + D * NE); SEAM(15); }
    PH(16) { for (int u = blockIdx.x; u < BATCH * NE; u += F.G) topk_unit(F, u); if (IN(18)) xcd_barrier(bar); }
    PH(18) {
        pg8::Gemm g{(const bf16*)(F.ws + WS_H), (const bf16*)(F.ws + WS_W13) + (size_t)NE * 2 * FF * D / 2, MS, 2 * FF, D / 2, (const int*)(F.ws + WS_TOK)}; pg8::GroupedOrder S; S.init(MS, 2 * FF, F.G, (int)blockIdx.x); S.npg = 2 * FF / 256;
        pg8::EpiSwiglu8 E{HID, FF, 2 * FF / 256, 1.f / (HSC * WSC), HIDSC, 0};
        pg8::gemm_phase<pg8::EpiSwiglu8, pg8::GroupedOrder, true, true, true, true>(ring, g, S, E);
#if defined(PROBE_G18H)
        { pg8::EpiSwiglu8 E2{HID, FF, 2 * FF / 256, 1.f / (HSC * WSC), HIDSC, F.G + 12089}; pg8::gemm_phase<pg8::EpiSwiglu8, pg8::GroupedOrder, true, true, true, true>(ring, g, S, E2); }
#endif
#if defined(PROBE_G18L)
        { pg8::EpiSwiglu8 E2{(unsigned char*)(F.ws + WS_XS), FF, 2 * FF / 256, 1.f / (HSC * WSC), HIDSC, F.G + 12090}; pg8::gemm_phase<pg8::EpiSwiglu8, pg8::GroupedOrder, true, true, true, true>(ring, g, S, E2); }
#endif
#if defined(PROBE_G18)
        pg8::gemm_phase<pg8::EpiSwiglu8, pg8::GroupedOrder, true, true, true, true>(ring, g, S, E);
#endif
        SEAM(18);
    }
    PH(19) {
        pg8::Gemm g{(const bf16*)HID, (const bf16*)(F.ws + WS_W2) + (size_t)NE * FF * D / 2, MS, D, FF / 2}; pg8::GroupedOrder S; S.init(MS, D, F.G, (int)blockIdx.x); S.npg = D / 256;
        pg8::EpiStore8 E{YS, D, D / 256, YSC / (HIDSC * WSC)};
        pg8::gemm_phase<pg8::EpiStore8, pg8::GroupedOrder, true, true, true>(ring, g, S, E);
        SEAM(19);
    }
    PH(20) { combine_phase<true>(F, DL, nullptr, F.in[I_FINN]); }
#undef IN
#undef SEAM
}

extern "C" void kernel_launch(void* const* d_in, const int* in_sizes, int n_in, void* d_out, int out_size, void* d_ws, size_t ws_size, hipStream_t stream) {
    static int grid = 0;
    if (grid == 0) {
        if (n_in != 28 || in_sizes[0] != M * D || out_size != M * D || ws_size < WS_END) { fprintf(stderr, "kernel_launch: shape/workspace mismatch (n_in %d, in0 %d, out %d, ws %zu, need %zu)\n", n_in, n_in > 0 ? in_sizes[0] : -1, out_size, ws_size, (size_t)WS_END); grid = -1; return; }
        int dev = 0, cus = 0, per_cu = 0;
        if (hipGetDevice(&dev) != hipSuccess || hipDeviceGetAttribute(&cus, hipDeviceAttributeMultiprocessorCount, dev) != hipSuccess) { grid = -1; return; }
        if (hipFuncSetAttribute((const void*)enc_fwd, hipFuncAttributeMaxDynamicSharedMemorySize, LDS_BYTES) != hipSuccess) { fprintf(stderr, "kernel_launch: hipFuncSetAttribute failed\n"); grid = -1; return; }
        if (hipOccupancyMaxActiveBlocksPerMultiprocessor(&per_cu, (const void*)enc_fwd, NT, LDS_BYTES) != hipSuccess || per_cu < 1) fprintf(stderr, "kernel_launch: occupancy query reports %d\n", per_cu);
        (void)hipGetLastError();
        grid = cus;
    }
    if (grid < 0) return;
    (void)hipMemsetAsync((char*)d_ws + WS_CTL, 0, CTL_ZERO_BYTES, stream);
    Args a{};
    for (int i = 0; i < 28; ++i) a.in[i] = (const float*)d_in[i];
    a.out = (float*)d_out; a.ws = (unsigned char*)d_ws;
#if MK_N_LAUNCHES == 1
    a.ph_lo = 0; a.ph_hi = N_PHASES;
    hipLaunchKernelGGL(enc_fwd, dim3(grid), dim3(NT), LDS_BYTES, stream, a);
#else
    for (int p = 0; p < N_PHASES; ++p) { a.ph_lo = p; a.ph_hi = p + 1; hipLaunchKernelGGL(enc_fwd, dim3(grid), dim3(NT), LDS_BYTES, stream, a); }
#endif
}
```
